# Optimizing an MI355X kernel written in HIP

```python
import math
import jax, jax.numpy as jnp
from jax import lax
import numpy as np

D_MODEL = 1024
BATCH = 16
SEQ = 4096
DEPTH = 1

D_MIX = D_MODEL
D_SSM = D_MIX // 2
SSM_GROUP = 16
N_SSM_GROUPS = D_SSM // SSM_GROUP
SSM_STATE = 64
D_DN = D_MIX - D_SSM
DN_HEAD_DIM = 128
N_DN_HEADS = D_DN // DN_HEAD_DIM
CONV_K = 5
CHUNK = 64
NORM_EPS = 1e-6
DT_MIN = 1e-3
DT_MAX = 1e-1
IN_COLS = 2 * D_SSM + 4 * D_DN + 4 * N_DN_HEADS

kernel_name = "hybrid_s5_gdn_adaln_block"


def rms_norm(x, w):
    x32 = x.astype(jnp.float32)
    y = x32 * lax.rsqrt(jnp.mean(x32 * x32, axis=-1, keepdims=True) + NORM_EPS)
    return (y * w.astype(jnp.float32)).astype(x.dtype)


def l2_normalize(t):
    return t * lax.rsqrt(jnp.sum(t * t, axis=-1, keepdims=True) + NORM_EPS)


def centred_depthwise_conv(t, w):
    ch = t.shape[-1]
    return lax.conv_general_dilated(
        t, w[:, None, :].astype(t.dtype), window_strides=(1,),
        padding=[(CONV_K // 2, CONV_K // 2)],
        dimension_numbers=("NWC", "WIO", "NWC"), feature_group_count=ch)


def s5_discretize(lam_re, lam_im, log_step, b_re, b_im):
    f32 = jnp.float32
    dt = jnp.exp(log_step.astype(f32))[:, None]
    lr, li = lam_re.astype(f32), lam_im.astype(f32)
    mag = jnp.exp(lr * dt)
    ab_re, ab_im = mag * jnp.cos(li * dt), mag * jnp.sin(li * dt)
    nr, ni = ab_re - 1.0, ab_im
    den = lr * lr + li * li
    f_re = (nr * lr + ni * li) / den
    f_im = (ni * lr - nr * li) / den
    br, bi = b_re.astype(f32), b_im.astype(f32)
    bb_re = f_re[..., None] * br - f_im[..., None] * bi
    bb_im = f_re[..., None] * bi + f_im[..., None] * br
    return ab_re, ab_im, bb_re, bb_im


def s5_direction(u, lam_re, lam_im, log_step, b_re, b_im, c_re, c_im, reverse):
    ab_re, ab_im, bb_re, bb_im = s5_discretize(lam_re, lam_im, log_step, b_re, b_im)
    bu_re = jnp.einsum("blgp,gnp->blgn", u, bb_re)
    bu_im = jnp.einsum("blgp,gnp->blgn", u, bb_im)
    seq = u.shape[1]
    a_re = jnp.broadcast_to(ab_re, (1, seq) + ab_re.shape)
    a_im = jnp.broadcast_to(ab_im, (1, seq) + ab_im.shape)

    def combine(e1, e2):
        a1r, a1i, b1r, b1i = e1
        a2r, a2i, b2r, b2i = e2
        return (a1r * a2r - a1i * a2i,
                a1r * a2i + a1i * a2r,
                a2r * b1r - a2i * b1i + b2r,
                a2r * b1i + a2i * b1r + b2i)

    _, _, xr, xi = lax.associative_scan(combine, (a_re, a_im, bu_re, bu_im),
                                        reverse=reverse, axis=1)
    cr, ci = c_re.astype(jnp.float32), c_im.astype(jnp.float32)
    return jnp.einsum("blgn,gpn->blgp", xr, cr) - jnp.einsum("blgn,gpn->blgp", xi, ci)


def gated_delta_chunked(q, k, v, g, beta):
    bsz, nh, seq, dk = q.shape
    dv = v.shape[-1]
    n = seq // CHUNK
    rs = lambda t: t.reshape((bsz, nh, n, CHUNK) + t.shape[3:])
    q, k, v, g, beta = rs(q), rs(k), rs(v), rs(g), rs(beta)
    g = jnp.cumsum(g, axis=-1)
    idx = jnp.arange(CHUNK)
    lower = idx[:, None] >= idx[None, :]
    strict = idx[:, None] > idx[None, :]
    diff = g[..., :, None] - g[..., None, :]
    decay = jnp.where(lower, jnp.exp(jnp.where(lower, diff, 0.0)), 0.0)
    k_beta = k * beta[..., None]
    lmat = jnp.where(strict, jnp.einsum("bhnid,bhnjd->bhnij", k_beta, k) * decay, 0.0)
    tri = lmat + jnp.eye(CHUNK, dtype=lmat.dtype)
    rhs = jnp.concatenate([v * beta[..., None], k_beta * jnp.exp(g)[..., None]], axis=-1)
    sol = lax.linalg.triangular_solve(tri, rhs, left_side=True, lower=True,
                                      unit_diagonal=True)
    u_c, w_c = sol[..., :dv], sol[..., dv:]
    attn = jnp.where(lower, jnp.einsum("bhnid,bhnjd->bhnij", q, k) * decay, 0.0)
    g_last = g[..., -1]
    k_tail = k * jnp.exp(g_last[..., None] - g)[..., None]
    q_dec = q * jnp.exp(g)[..., None]

    def step(state, inp):
        qd, w, u, a, kt, gl = inp
        v_new = u - jnp.einsum("bhcd,bhde->bhce", w, state)
        o = jnp.einsum("bhcd,bhde->bhce", qd, state) + jnp.einsum("bhij,bhje->bhie", a, v_new)
        state = state * jnp.exp(gl)[..., None, None] + jnp.einsum("bhcd,bhce->bhde", kt, v_new)
        return state, o

    mv = lambda t: jnp.moveaxis(t, 2, 0)
    xs = (mv(q_dec), mv(w_c), mv(u_c), mv(attn), mv(k_tail), mv(g_last))
    s0 = jnp.zeros((bsz, nh, dk, dv), jnp.float32)
    _, o = lax.scan(step, s0, xs)
    return jnp.moveaxis(o, 0, 2).reshape(bsz, nh, seq, dv)


def hybrid_layer(x, c, ada_w, ada_b, norm_w, w_in, conv_w,
                 dn_a_log_f, dn_dt_bias_f, dn_a_log_b, dn_dt_bias_b, dn_norm_w,
                 lam_re_f, lam_im_f, log_step_f, b_re_f, b_im_f, c_re_f, c_im_f,
                 lam_re_b, lam_im_b, log_step_b, b_re_b, b_im_b, c_re_b, c_im_b,
                 s5_d, glu_w, glu_b, w_out):
    f32 = jnp.float32
    dt = x.dtype
    bsz, seq, _ = x.shape
    mod = jax.nn.silu(c) @ ada_w + ada_b
    shift, scale, gate = jnp.split(mod, 3, axis=-1)
    h = rms_norm(x, norm_w) * (1.0 + scale[:, None, :]) + shift[:, None, :]
    proj = h @ w_in
    o1 = D_SSM
    o2 = o1 + D_SSM
    o3 = o2 + 3 * D_DN
    o4 = o3 + D_DN
    o5 = o4 + 2 * N_DN_HEADS
    u_a, z_a, qkv, z_b, beta_fb, alpha_fb = jnp.split(proj, [o1, o2, o3, o4, o5], axis=-1)

    u = u_a.astype(f32).reshape(bsz, seq, N_SSM_GROUPS, SSM_GROUP)
    y = (s5_direction(u, lam_re_f, lam_im_f, log_step_f, b_re_f, b_im_f, c_re_f, c_im_f, False)
         + s5_direction(u, lam_re_b, lam_im_b, log_step_b, b_re_b, b_im_b, c_re_b, c_im_b, True)
         + s5_d.astype(f32).reshape(N_SSM_GROUPS, SSM_GROUP) * u)
    y = jax.nn.gelu(y.reshape(bsz, seq, D_SSM)).astype(dt)
    glu = y @ glu_w + glu_b
    y_a = glu[..., :D_SSM] * jax.nn.sigmoid(glu[..., D_SSM:])
    y_a = y_a * jax.nn.silu(z_a)

    qkv = jax.nn.silu(centred_depthwise_conv(qkv, conv_w))
    q, k, v = jnp.split(qkv, 3, axis=-1)
    to_heads = lambda t: t.reshape(bsz, seq, N_DN_HEADS, DN_HEAD_DIM).transpose(0, 2, 1, 3).astype(f32)
    q = l2_normalize(to_heads(q)) * (DN_HEAD_DIM ** -0.5)
    k = l2_normalize(to_heads(k))
    v = to_heads(v)
    beta = jax.nn.sigmoid(beta_fb.astype(f32)).transpose(0, 2, 1)
    alpha = alpha_fb.astype(f32).transpose(0, 2, 1)
    g_f = -jnp.exp(dn_a_log_f.astype(f32))[None, :, None] * jax.nn.softplus(
        alpha[:, :N_DN_HEADS] + dn_dt_bias_f.astype(f32)[None, :, None])
    g_b = -jnp.exp(dn_a_log_b.astype(f32))[None, :, None] * jax.nn.softplus(
        alpha[:, N_DN_HEADS:] + dn_dt_bias_b.astype(f32)[None, :, None])
    o_f = gated_delta_chunked(q, k, v, g_f, beta[:, :N_DN_HEADS])
    flip = lambda t: jnp.flip(t, axis=2)
    o_b = flip(gated_delta_chunked(flip(q), flip(k), flip(v), flip(g_b),
                                   flip(beta[:, N_DN_HEADS:])))
    o = (o_f + o_b).transpose(0, 2, 1, 3)
    o = o * lax.rsqrt(jnp.mean(o * o, axis=-1, keepdims=True) + NORM_EPS) * dn_norm_w.astype(f32)
    o = o * jax.nn.silu(z_b.astype(f32).reshape(bsz, seq, N_DN_HEADS, DN_HEAD_DIM))
    y_b = o.reshape(bsz, seq, D_DN).astype(dt)

    mix = jnp.concatenate([y_a, y_b], axis=-1) @ w_out
    return x + gate[:, None, :] * mix


def setup_inputs(seed: int = 0) -> dict:
    key = jax.random.key(seed)
    ks = iter(jax.random.split(key, 40))
    f32 = jnp.float32
    nrm = lambda shape, s: jax.random.normal(next(ks), shape, f32) * s
    G, N, P, H = N_SSM_GROUPS, SSM_STATE, SSM_GROUP, N_DN_HEADS

    def s5_params():
        lam_re = -0.5 + nrm((DEPTH, G, N), 0.01)
        lam_im = jnp.pi * jnp.arange(N, dtype=f32)[None, None, :] + nrm((DEPTH, G, N), 0.01)
        log_step = jax.random.uniform(next(ks), (DEPTH, G), f32, math.log(DT_MIN), math.log(DT_MAX))
        b_re = nrm((DEPTH, G, N, P), (2.0 * P) ** -0.5)
        b_im = nrm((DEPTH, G, N, P), (2.0 * P) ** -0.5)
        c_re = nrm((DEPTH, G, P, N), (2.0 * N) ** -0.5)
        c_im = nrm((DEPTH, G, P, N), (2.0 * N) ** -0.5)
        return lam_re, lam_im, log_step, b_re, b_im, c_re, c_im

    def dn_decay_params():
        a_log = jnp.log(jax.random.uniform(next(ks), (DEPTH, H), f32, 1.0, 16.0))
        dts = jnp.exp(jax.random.uniform(next(ks), (DEPTH, H), f32, math.log(DT_MIN), math.log(DT_MAX)))
        dt_bias = dts + jnp.log(-jnp.expm1(-dts))
        return a_log, dt_bias

    x = jax.random.normal(next(ks), (BATCH, SEQ, D_MODEL), f32)
    c = jax.random.normal(next(ks), (BATCH, D_MODEL), f32)
    ada_w = nrm((DEPTH, D_MODEL, 3 * D_MODEL), 0.5 * D_MODEL ** -0.5)
    ada_b = nrm((DEPTH, 3 * D_MODEL), 0.02)
    norm_w = 1.0 + nrm((DEPTH, D_MODEL), 0.02)
    w_in = nrm((DEPTH, D_MODEL, IN_COLS), D_MODEL ** -0.5)
    conv_w = nrm((DEPTH, CONV_K, 3 * D_DN), CONV_K ** -0.5)
    dn_a_log_f, dn_dt_bias_f = dn_decay_params()
    dn_a_log_b, dn_dt_bias_b = dn_decay_params()
    dn_norm_w = 1.0 + nrm((DEPTH, DN_HEAD_DIM), 0.02)
    lam_re_f, lam_im_f, log_step_f, b_re_f, b_im_f, c_re_f, c_im_f = s5_params()
    lam_re_b, lam_im_b, log_step_b, b_re_b, b_im_b, c_re_b, c_im_b = s5_params()
    s5_d = nrm((DEPTH, D_SSM), 1.0)
    glu_w = nrm((DEPTH, D_SSM, 2 * D_SSM), D_SSM ** -0.5)
    glu_b = nrm((DEPTH, 2 * D_SSM), 0.01)
    w_out = nrm((DEPTH, D_MIX, D_MODEL), D_MIX ** -0.5)
    final_norm_w = 1.0 + nrm((D_MODEL,), 0.02)
    return {"x": x, "c": c, "ada_w": ada_w, "ada_b": ada_b, "norm_w": norm_w,
            "w_in": w_in, "conv_w": conv_w,
            "dn_a_log_f": dn_a_log_f, "dn_dt_bias_f": dn_dt_bias_f,
            "dn_a_log_b": dn_a_log_b, "dn_dt_bias_b": dn_dt_bias_b, "dn_norm_w": dn_norm_w,
            "lam_re_f": lam_re_f, "lam_im_f": lam_im_f, "log_step_f": log_step_f,
            "b_re_f": b_re_f, "b_im_f": b_im_f, "c_re_f": c_re_f, "c_im_f": c_im_f,
            "lam_re_b": lam_re_b, "lam_im_b": lam_im_b, "log_step_b": log_step_b,
            "b_re_b": b_re_b, "b_im_b": b_im_b, "c_re_b": c_re_b, "c_im_b": c_im_b,
            "s5_d": s5_d, "glu_w": glu_w, "glu_b": glu_b, "w_out": w_out,
            "final_norm_w": final_norm_w}


def reference(x, c, ada_w, ada_b, norm_w, w_in, conv_w,
              dn_a_log_f, dn_dt_bias_f, dn_a_log_b, dn_dt_bias_b, dn_norm_w,
              lam_re_f, lam_im_f, log_step_f, b_re_f, b_im_f, c_re_f, c_im_f,
              lam_re_b, lam_im_b, log_step_b, b_re_b, b_im_b, c_re_b, c_im_b,
              s5_d, glu_w, glu_b, w_out, final_norm_w):
    for layer in range(DEPTH):
        x = hybrid_layer(
            x, c, ada_w[layer], ada_b[layer], norm_w[layer], w_in[layer], conv_w[layer],
            dn_a_log_f[layer], dn_dt_bias_f[layer], dn_a_log_b[layer], dn_dt_bias_b[layer],
            dn_norm_w[layer],
            lam_re_f[layer], lam_im_f[layer], log_step_f[layer], b_re_f[layer], b_im_f[layer],
            c_re_f[layer], c_im_f[layer],
            lam_re_b[layer], lam_im_b[layer], log_step_b[layer], b_re_b[layer], b_im_b[layer],
            c_re_b[layer], c_im_b[layer],
            s5_d[layer], glu_w[layer], glu_b[layer], w_out[layer])
    return rms_norm(x, final_norm_w)
```

```cpp
#include <hip/hip_runtime.h>
#include <hip/hip_cooperative_groups.h>
#include <cstdio>
#include <cstdint>
namespace cg = cooperative_groups;

#ifndef N_LAUNCH_MODE
#define N_LAUNCH_MODE 0
#endif
#ifndef REP_PHASE
#define REP_PHASE -1
#endif

#define DUPST 0
#ifndef DUPL
#define DUPL 0
#endif
#define DI __device__ __forceinline__
#define LAS __attribute__((address_space(3)))
constexpr int NTHR = 512, NWV = 8;
typedef unsigned short bf16_t;
typedef short bf16x8 __attribute__((ext_vector_type(8)));
typedef float f32x4 __attribute__((ext_vector_type(4)));
typedef float f32x2 __attribute__((ext_vector_type(2)));
typedef float f32x16 __attribute__((ext_vector_type(16)));
typedef unsigned u32x4 __attribute__((ext_vector_type(4)));
typedef unsigned u32x2 __attribute__((ext_vector_type(2)));
typedef __bf16 bf2_t __attribute__((ext_vector_type(2)));

constexpr int DM = 1024, NB = 16, SEQ = 4096, NTOK = NB * SEQ;
constexpr int INC = 3088, INP = 3328;
constexpr size_t MiB = 1u << 20;
constexpr size_t OFF_HB = 0;
constexpr size_t OFF_QKVRAW = 128 * MiB;
constexpr size_t OFF_WC = 0;
constexpr size_t OFF_UT = 128 * MiB;
constexpr size_t OFF_ATT = 256 * MiB;
constexpr size_t OFF_Y5 = 656 * MiB;
constexpr size_t OFF_U5 = 320 * MiB;
constexpr size_t OFF_ZA = 400 * MiB;
constexpr size_t OFF_ZB = 464 * MiB;
constexpr size_t OFF_QN = 528 * MiB;
constexpr size_t OFF_KN = 592 * MiB;
constexpr size_t OFF_VN = 656 * MiB;
constexpr size_t OFF_YAB = 528 * MiB;
constexpr size_t OFF_MY = 720 * MiB;
constexpr size_t OFF_MS = 800 * MiB;
constexpr size_t OFF_KTT = 816 * MiB;
constexpr size_t OFF_WINT = 944 * MiB;
constexpr size_t OFF_GLUWT = 952 * MiB;
constexpr size_t OFF_WOUTT = 953 * MiB;
constexpr size_t OFF_BA = 955 * MiB;
constexpr size_t OFF_GC = 959 * MiB;
constexpr size_t OFF_KTAB = 961 * MiB;
constexpr size_t OFF_PW = 965 * MiB;
constexpr size_t OFF_FB = 968 * MiB;
constexpr size_t OFF_MOD = 969 * MiB;
constexpr size_t OFF_CTR = 969 * MiB + 512 * 1024;
constexpr size_t WS_END = 970 * MiB;

struct Params {
  const float *x, *c, *ada_w, *ada_b, *norm_w, *w_in, *conv_w;
  const float *a_log[2], *dt_bias[2], *dn_norm_w;
  const float *lam_re[2], *lam_im[2], *log_step[2], *b_re[2], *b_im[2], *c_re[2], *c_im[2];
  const float *s5_d, *glu_w, *glu_b, *w_out, *final_norm_w;
  float* out;
  char* ws;
  int p_lo, p_hi;
};

DI unsigned pk2(float a, float b) { f32x2 v = {a, b}; bf2_t r = __builtin_convertvector(v, bf2_t); return __builtin_bit_cast(unsigned, r); }
DI bf16_t f2bf(float a) { return (bf16_t)(pk2(a, 0.f) & 0xffffu); }
DI float bf2f(bf16_t v) { return __uint_as_float(((unsigned)v) << 16); }
DI float bflo(unsigned u) { return __uint_as_float(u << 16); }
DI float bfhi(unsigned u) { return __uint_as_float(u & 0xffff0000u); }
DI float sigmoidf_(float x) { return 1.f / (1.f + __expf(-x)); }
DI float siluf_(float x) { return x / (1.f + __expf(-x)); }
DI float gelu_tanh(float x) { float u = 0.7978845608028654f * (x + 0.044715f * x * x * x); float e = __expf(2.f * u); float t = 1.f - 2.f / (e + 1.f); return 0.5f * x * (1.f + t); }
DI float softplusf_(float x) { return x > 15.f ? x : log1pf(expf(x)); }
DI float wave_sum(float v) {
#pragma unroll
  for (int o = 1; o < 64; o <<= 1) v += __shfl_xor(v, o);
  return v;
}
DI void lds_barrier() { asm volatile("s_waitcnt lgkmcnt(0)" ::: "memory"); __builtin_amdgcn_s_barrier(); asm volatile("" ::: "memory"); }
typedef unsigned long long u64_t;
DI u64_t ld8_pinned(const void* p) { return __hip_atomic_load((const u64_t*)p, __ATOMIC_RELAXED, __HIP_MEMORY_SCOPE_WORKGROUP); }
DI float ld4_pinned(const void* p) { return __builtin_bit_cast(float, __hip_atomic_load((const unsigned*)p, __ATOMIC_RELAXED, __HIP_MEMORY_SCOPE_WORKGROUP)); }
DI int crow(int reg, int h) { return (reg & 3) + 8 * (reg >> 2) + 4 * h; }
DI bf16x8 pack8(const f32x16& x, int s) {
  u32x4 p;
  p[0] = pk2(x[8 * s + 0], x[8 * s + 1]); p[1] = pk2(x[8 * s + 2], x[8 * s + 3]);
  p[2] = pk2(x[8 * s + 4], x[8 * s + 5]); p[3] = pk2(x[8 * s + 6], x[8 * s + 7]);
  return __builtin_bit_cast(bf16x8, p);
}
DI bf16x8 ldfrag(const bf16_t* base, int row, int stride, int col) {
  const bf16_t* p = base + row * stride + col;
  u32x2 lo = *(const u32x2*)p, hi = *(const u32x2*)(p + 8);
  u32x4 v = {lo[0], lo[1], hi[0], hi[1]};
  return __builtin_bit_cast(bf16x8, v);
}
DI bf16x8 ldfrag16(const bf16_t* base, int row, int stride, int ks, int hh) { return *(const bf16x8*)(base + row * stride + 16 * ks + 8 * hh); }
#define MFMA32(a, b, c) __builtin_amdgcn_mfma_f32_32x32x16_bf16((a), (b), (c), 0, 0, 0)
#define MFMA16(a, b, c) __builtin_amdgcn_mfma_f32_16x16x32_bf16((a), (b), (c), 0, 0, 0)

constexpr int G_HTB = 128 * 64 * 2;
DI int lds_byte(int r, int c) { const int st = (r >> 4) * 2 + (c >> 5), rr = r & 15, cc = c & 31, ob = rr * 64 + cc * 2; return st * 1024 + (ob ^ (((ob >> 9) & 1) << 5)); }
DI void stage_rc(int b, int& R, int& C) { const int st = b / 1024, sb = b % 1024, swz = sb ^ (((sb >> 9) & 1) << 5); R = (st >> 1) * 16 + swz / 64; C = (st & 1) * 32 + (swz % 64) / 2; }
template <bool TRANS, bool PERM = false>
DI void gemm256(const bf16_t* __restrict__ A, int lda, const bf16_t* __restrict__ Bt, int ldb, int K, LAS unsigned char* lds, f32x4 (&acc)[2][2][4][2]) {
  const int tid = threadIdx.x, wid = __builtin_amdgcn_readfirstlane(tid >> 6), lane = tid & 63, wr = wid >> 2, wc = wid & 3, fr = lane & 15, fq = lane >> 4;
  unsigned voffA[2], voffB[2];
#pragma unroll
  for (int i = 0; i < 2; ++i) {
    int R, C; stage_rc(tid * 16 + i * 8192, R, C);
    const int Rb = PERM ? ((R & ~31) + 8 * ((R & 15) >> 2) + 4 * ((R >> 4) & 1) + (R & 3)) : R;
    voffA[i] = (unsigned)(R * lda + C) * 2u; voffB[i] = (unsigned)(Rb * ldb + C) * 2u;
  }
  const unsigned ldsw = (unsigned)wid * 1024u;
  const int aoff = lds_byte(wr * 64 + fr, fq * 8), boff = lds_byte(wc * 32 + fr, fq * 8);
  const char* cA0 = (const char*)A; const char* cA1 = cA0 + (size_t)128 * lda * 2;
  const char* cB0 = (const char*)Bt; const char* cB1 = cB0 + (size_t)128 * ldb * 2;
#define G_SA(b, h) (((b) * 2 + (h)) * G_HTB)
#define G_SB(b, h) ((4 + (b) * 2 + (h)) * G_HTB)
#define G_STAGE(bufoff, gbase, voff, kt) do { _Pragma("unroll") for (int _i = 0; _i < 2; ++_i) \
    __builtin_amdgcn_global_load_lds((const unsigned*)((gbase) + (size_t)(kt) * 128 + (voff)[_i]), (LAS unsigned*)(lds + (bufoff) + ldsw + _i * 8192), 16, 0, 0); } while (0)
#define G_LDA(dst, b, h) do { _Pragma("unroll") for (int m = 0; m < 4; ++m) _Pragma("unroll") for (int k = 0; k < 2; ++k) dst[m][k] = *(const LAS bf16x8*)(lds + G_SA(b, h) + aoff + m * 2048 + k * 1024); } while (0)
#define G_LDB(dst, b, h) do { _Pragma("unroll") for (int n = 0; n < 2; ++n) _Pragma("unroll") for (int k = 0; k < 2; ++k) dst[n][k] = *(const LAS bf16x8*)(lds + G_SB(b, h) + boff + n * 2048 + k * 1024); } while (0)
#define G_MMA(ai, bj, At_, Bt_) do { __builtin_amdgcn_s_setprio(1); _Pragma("unroll") for (int m = 0; m < 4; ++m) _Pragma("unroll") for (int n = 0; n < 2; ++n) _Pragma("unroll") for (int k = 0; k < 2; ++k) \
    acc[ai][bj][m][n] = TRANS ? MFMA16(Bt_[n][k], At_[m][k], acc[ai][bj][m][n]) : MFMA16(At_[m][k], Bt_[n][k], acc[ai][bj][m][n]); __builtin_amdgcn_s_setprio(0); } while (0)
#define G_WAIT_V(n) asm volatile("s_waitcnt vmcnt(" #n ")" ::: "memory")
#define G_WAIT_L(n) asm volatile("s_waitcnt lgkmcnt(" #n ")" ::: "memory")
#define G_BAR __builtin_amdgcn_s_barrier()
#define G_SCHED __builtin_amdgcn_sched_barrier(0)
#pragma unroll
  for (int a = 0; a < 2; ++a)
#pragma unroll
    for (int b = 0; b < 2; ++b)
#pragma unroll
      for (int m = 0; m < 4; ++m)
#pragma unroll
        for (int n = 0; n < 2; ++n) acc[a][b][m][n] = f32x4{0.f, 0.f, 0.f, 0.f};
  bf16x8 At[4][2], B0[2][2], B1[2][2];
  const int nt = K / 64;
  G_WAIT_V(0); G_WAIT_L(0); G_BAR;
  G_STAGE(G_SB(0, 0), cB0, voffB, 0); G_STAGE(G_SA(0, 0), cA0, voffA, 0);
  G_STAGE(G_SB(0, 1), cB1, voffB, 0); G_STAGE(G_SA(0, 1), cA1, voffA, 0);
  if (wr == 1) G_BAR;
  G_WAIT_V(4); G_BAR;
  G_STAGE(G_SB(1, 0), cB0, voffB, 1); G_STAGE(G_SA(1, 0), cA0, voffA, 1); G_STAGE(G_SB(1, 1), cB1, voffB, 1);
  G_WAIT_V(6); G_BAR;
  for (int t = 0; t < nt - 2; t += 2) {
    G_LDB(B0, 0, 0); G_SCHED; G_LDA(At, 0, 0); G_STAGE(G_SA(1, 1), cA1, voffA, t + 1);
    G_WAIT_L(8); G_BAR; G_WAIT_L(0); G_MMA(0, 0, At, B0); G_BAR; G_SCHED;
    G_LDB(B1, 0, 1); G_STAGE(G_SB(0, 0), cB0, voffB, t + 2);
    G_BAR; G_WAIT_L(0); G_MMA(0, 1, At, B1); G_BAR;
    G_LDA(At, 0, 1); G_STAGE(G_SA(0, 0), cA0, voffA, t + 2);
    G_BAR; G_WAIT_L(0); G_MMA(1, 0, At, B0); G_BAR; G_SCHED;
    G_STAGE(G_SB(0, 1), cB1, voffB, t + 2);
    G_WAIT_V(6); G_BAR; G_MMA(1, 1, At, B1); G_BAR;
    G_LDB(B0, 1, 0); G_SCHED; G_LDA(At, 1, 0); G_STAGE(G_SA(0, 1), cA1, voffA, t + 2);
    G_WAIT_L(8); G_BAR; G_WAIT_L(0); G_MMA(0, 0, At, B0); G_BAR; G_SCHED;
    G_LDB(B1, 1, 1); G_STAGE(G_SB(1, 0), cB0, voffB, t + 3);
    G_BAR; G_WAIT_L(0); G_MMA(0, 1, At, B1); G_BAR;
    G_LDA(At, 1, 1); G_STAGE(G_SA(1, 0), cA0, voffA, t + 3);
    G_BAR; G_WAIT_L(0); G_MMA(1, 0, At, B0); G_BAR; G_SCHED;
    G_STAGE(G_SB(1, 1), cB1, voffB, t + 3);
    G_WAIT_V(6); G_BAR; G_MMA(1, 1, At, B1); G_BAR;
  }
  { G_LDB(B0, 0, 0); G_LDA(At, 0, 0); G_STAGE(G_SA(1, 1), cA1, voffA, nt - 1);
    G_BAR; G_WAIT_L(0); G_MMA(0, 0, At, B0); G_BAR;
    G_LDB(B1, 0, 1); G_BAR; G_WAIT_L(0); G_MMA(0, 1, At, B1); G_BAR;
    G_LDA(At, 0, 1); G_WAIT_V(4); G_BAR; G_WAIT_L(0); G_MMA(1, 0, At, B0); G_MMA(1, 1, At, B1); G_BAR; }
  { G_LDB(B0, 1, 0); G_LDA(At, 1, 0); G_WAIT_V(2); G_BAR; G_WAIT_L(0); G_MMA(0, 0, At, B0); G_BAR;
    G_LDB(B1, 1, 1); G_WAIT_V(0); G_BAR; G_WAIT_L(0); G_MMA(0, 1, At, B1); G_BAR;
    G_LDA(At, 1, 1); G_BAR; G_WAIT_L(0); G_MMA(1, 0, At, B0); G_MMA(1, 1, At, B1); G_BAR; }
  if (wr == 0) G_BAR;
}

template <bool TRANS, bool PERM, class TileFn, class EpiFn>
DI void gemm256_stream(int nj, int nt, int lda, int ldb, TileFn tilefn, EpiFn epifn, LAS unsigned char* lds) {
  if (nj <= 0) return;
  const int tid = threadIdx.x, wid = __builtin_amdgcn_readfirstlane(tid >> 6), lane = tid & 63, wr = wid >> 2, wc = wid & 3, fr = lane & 15, fq = lane >> 4;
  unsigned voffA[2], voffB[2];
#pragma unroll
  for (int i = 0; i < 2; ++i) {
    int R, C; stage_rc(tid * 16 + i * 8192, R, C);
    const int Rb = PERM ? ((R & ~31) + 8 * ((R & 15) >> 2) + 4 * ((R >> 4) & 1) + (R & 3)) : R;
    voffA[i] = (unsigned)(R * lda + C) * 2u; voffB[i] = (unsigned)(Rb * ldb + C) * 2u;
  }
  const unsigned ldsw = (unsigned)wid * 1024u;
  const int aoff = lds_byte(wr * 64 + fr, fq * 8), boff = lds_byte(wc * 32 + fr, fq * 8);
  const size_t hA = (size_t)128 * lda * 2, hB = (size_t)128 * ldb * 2;
  const char *cA, *cB, *nA, *nB;
  { const bf16_t *a, *b; tilefn(0, a, b); cA = (const char*)a; cB = (const char*)b; nA = cA; nB = cB; if (nj > 1) { tilefn(1, a, b); nA = (const char*)a; nB = (const char*)b; } }
  int j = 0, tbeg = 0, tend = nt;
#define GS_A(g, h) (((g) < tend ? cA + (size_t)((g) - tbeg) * 128 : nA + (size_t)((g) - tend) * 128) + (h) * hA)
#define GS_B(g, h) (((g) < tend ? cB + (size_t)((g) - tbeg) * 128 : nB + (size_t)((g) - tend) * 128) + (h) * hB)
#define GS_STAGE(bufoff, gptr, voff) do { const char* _p = (gptr); _Pragma("unroll") for (int _i = 0; _i < 2; ++_i) \
    __builtin_amdgcn_global_load_lds((const unsigned*)(_p + (voff)[_i]), (LAS unsigned*)(lds + (bufoff) + ldsw + _i * 8192), 16, 0, 0); } while (0)
  f32x4 acc[2][2][4][2];
#pragma unroll
  for (int a = 0; a < 2; ++a)
#pragma unroll
    for (int b = 0; b < 2; ++b)
#pragma unroll
      for (int m = 0; m < 4; ++m)
#pragma unroll
        for (int n = 0; n < 2; ++n) acc[a][b][m][n] = f32x4{0.f, 0.f, 0.f, 0.f};
  bf16x8 At[4][2], B0[2][2], B1[2][2];
  const int total = nj * nt;
  G_WAIT_V(0); G_WAIT_L(0); G_BAR;
  GS_STAGE(G_SB(0, 0), GS_B(0, 0), voffB); GS_STAGE(G_SA(0, 0), GS_A(0, 0), voffA);
  GS_STAGE(G_SB(0, 1), GS_B(0, 1), voffB); GS_STAGE(G_SA(0, 1), GS_A(0, 1), voffA);
  if (wr == 1) G_BAR;
  G_WAIT_V(4); G_BAR;
  GS_STAGE(G_SB(1, 0), GS_B(1, 0), voffB); GS_STAGE(G_SA(1, 0), GS_A(1, 0), voffA); GS_STAGE(G_SB(1, 1), GS_B(1, 1), voffB);
  G_WAIT_V(6); G_BAR;
  for (int t = 0; t < total - 2; t += 2) {
    G_LDB(B0, 0, 0); G_SCHED; G_LDA(At, 0, 0); GS_STAGE(G_SA(1, 1), GS_A(t + 1, 1), voffA);
    G_WAIT_L(8); G_BAR; G_WAIT_L(0); G_MMA(0, 0, At, B0); G_BAR; G_SCHED;
    G_LDB(B1, 0, 1); GS_STAGE(G_SB(0, 0), GS_B(t + 2, 0), voffB);
    G_BAR; G_WAIT_L(0); G_MMA(0, 1, At, B1); G_BAR;
    G_LDA(At, 0, 1); GS_STAGE(G_SA(0, 0), GS_A(t + 2, 0), voffA);
    G_BAR; G_WAIT_L(0); G_MMA(1, 0, At, B0); G_BAR; G_SCHED;
    GS_STAGE(G_SB(0, 1), GS_B(t + 2, 1), voffB);
    G_WAIT_V(6); G_BAR; G_MMA(1, 1, At, B1); G_BAR;
    G_LDB(B0, 1, 0); G_SCHED; G_LDA(At, 1, 0); GS_STAGE(G_SA(0, 1), GS_A(t + 2, 1), voffA);
    G_WAIT_L(8); G_BAR; G_WAIT_L(0); G_MMA(0, 0, At, B0); G_BAR; G_SCHED;
    G_LDB(B1, 1, 1); GS_STAGE(G_SB(1, 0), GS_B(t + 3, 0), voffB);
    G_BAR; G_WAIT_L(0); G_MMA(0, 1, At, B1); G_BAR;
    G_LDA(At, 1, 1); GS_STAGE(G_SA(1, 0), GS_A(t + 3, 0), voffA);
    G_BAR; G_WAIT_L(0); G_MMA(1, 0, At, B0); G_BAR; G_SCHED;
    GS_STAGE(G_SB(1, 1), GS_B(t + 3, 1), voffB);
    G_WAIT_V(6); G_BAR; G_MMA(1, 1, At, B1); G_BAR;
    if (t + 2 == tend) {
      epifn(j, acc);
#pragma unroll
      for (int a = 0; a < 2; ++a)
#pragma unroll
        for (int b = 0; b < 2; ++b)
#pragma unroll
          for (int m = 0; m < 4; ++m)
#pragma unroll
            for (int n = 0; n < 2; ++n) acc[a][b][m][n] = f32x4{0.f, 0.f, 0.f, 0.f};
      ++j; tbeg = tend; tend += nt; cA = nA; cB = nB;
      if (j + 1 < nj) { const bf16_t *a, *b; tilefn(j + 1, a, b); nA = (const char*)a; nB = (const char*)b; }
    }
  }
  { G_LDB(B0, 0, 0); G_LDA(At, 0, 0); GS_STAGE(G_SA(1, 1), GS_A(total - 1, 1), voffA);
    G_BAR; G_WAIT_L(0); G_MMA(0, 0, At, B0); G_BAR;
    G_LDB(B1, 0, 1); G_BAR; G_WAIT_L(0); G_MMA(0, 1, At, B1); G_BAR;
    G_LDA(At, 0, 1); G_WAIT_V(4); G_BAR; G_WAIT_L(0); G_MMA(1, 0, At, B0); G_MMA(1, 1, At, B1); G_BAR; }
  { G_LDB(B0, 1, 0); G_LDA(At, 1, 0); G_WAIT_V(2); G_BAR; G_WAIT_L(0); G_MMA(0, 0, At, B0); G_BAR;
    G_LDB(B1, 1, 1); G_WAIT_V(0); G_BAR; G_WAIT_L(0); G_MMA(0, 1, At, B1); G_BAR;
    G_LDA(At, 1, 1); G_BAR; G_WAIT_L(0); G_MMA(1, 0, At, B0); G_MMA(1, 1, At, B1); G_BAR; }
  if (wr == 0) G_BAR;
  epifn(j, acc);
}

DI void p0_mod_item(const Params& P, char* smem, int it) {
  float* ssil = (float*)smem;
  float* sred = ssil + 16 * 1024;
  const int tid = threadIdx.x, cl = tid & 31, ks = tid >> 5, col = it * 32 + cl;
  __syncthreads();
  for (int e = tid; e < 16 * 1024; e += NTHR) ssil[e] = siluf_(P.c[e]);
  __syncthreads();
  float acc[16];
#pragma unroll
  for (int b = 0; b < 16; ++b) acc[b] = 0.f;
  for (int k = ks * 64; k < ks * 64 + 64; ++k) {
    const float w = P.ada_w[(size_t)k * 3072 + col];
#pragma unroll
    for (int b = 0; b < 16; ++b) acc[b] += ssil[b * 1024 + k] * w;
  }
#pragma unroll
  for (int b = 0; b < 16; ++b) sred[(ks * 16 + b) * 32 + cl] = acc[b];
  __syncthreads();
  {
    const int b = tid >> 5;
    float s = P.ada_b[col];
#pragma unroll
    for (int k2 = 0; k2 < 16; ++k2) s += sred[(k2 * 16 + b) * 32 + cl];
    ((float*)(P.ws + OFF_MOD))[b * 3072 + col] = s;
  }
}
DI void p0_transpose_item(const float* __restrict__ src, int N, int K, int k0, int srcn0, int nvalid, bf16_t* __restrict__ dst, int dstn0, float* s, int tid) {
  const int n = tid & 31, kr = tid >> 5;
#pragma unroll
  for (int i = 0; i < 8; ++i) { const int k = kr + 8 * i; s[k * 33 + n] = (n < nvalid) ? src[(size_t)(k0 + k) * N + srcn0 + n] : 0.f; }
  __syncthreads();
  const int on = tid >> 3, kc = tid & 7;
  u32x4 o;
  o[0] = pk2(s[(kc * 8 + 0) * 33 + on], s[(kc * 8 + 1) * 33 + on]); o[1] = pk2(s[(kc * 8 + 2) * 33 + on], s[(kc * 8 + 3) * 33 + on]);
  o[2] = pk2(s[(kc * 8 + 4) * 33 + on], s[(kc * 8 + 5) * 33 + on]); o[3] = pk2(s[(kc * 8 + 6) * 33 + on], s[(kc * 8 + 7) * 33 + on]);
  *(u32x4*)(dst + (size_t)(dstn0 + on) * K + k0 + kc * 8) = o;
  __syncthreads();
}
DI void s5_lambda(const Params& P, int g, int dir, int n, float& dt, float& lr, float& li) {
  dt = expf(P.log_step[dir][g]); lr = P.lam_re[dir][g * 64 + n]; li = P.lam_im[dir][g * 64 + n];
}
DI void cpow(float dt, float lr, float li, float e, float& re, float& im) {
  const float mag = expf(lr * dt * e); float s, c; sincosf(li * dt * e, &s, &c); re = mag * c; im = mag * s;
}
DI void s5_f(float dt, float lr, float li, float& fre, float& fim) {
  float ar, ai; cpow(dt, lr, li, 1.f, ar, ai);
  const float nr = ar - 1.f, ni = ai, den = lr * lr + li * li;
  fre = (nr * lr + ni * li) / den; fim = (ni * lr - nr * li) / den;
}
DI void p0_ktab_item(const Params& P, float* sm, int it, int tid) {
  const int tau = it & 63, dir = (it >> 6) & 1, g = it >> 7;
  float* sw = sm;
  float* sG = sw + 128;
  float* sC = sG + 2048;
  if (tid < 64) {
    float dt, lr, li; s5_lambda(P, g, dir, tid, dt, lr, li);
    float fr_, fi_, ar, ai; s5_f(dt, lr, li, fr_, fi_); cpow(dt, lr, li, (float)tau, ar, ai);
    sw[tid * 2] = fr_ * ar - fi_ * ai; sw[tid * 2 + 1] = fr_ * ai + fi_ * ar;
  }
  for (int e = tid; e < 1024; e += 256) { sC[e * 2] = P.c_re[dir][g * 1024 + e]; sC[e * 2 + 1] = P.c_im[dir][g * 1024 + e]; }
  __syncthreads();
  for (int e = tid; e < 1024; e += 256) {
    const int n = e >> 4;
    const float br = P.b_re[dir][g * 1024 + e], bi = P.b_im[dir][g * 1024 + e], wr_ = sw[n * 2], wi_ = sw[n * 2 + 1];
    sG[e * 2] = wr_ * br - wi_ * bi; sG[e * 2 + 1] = wr_ * bi + wi_ * br;
  }
  __syncthreads();
  const int p = tid >> 4, q = tid & 15;
  float acc = 0.f;
  for (int n = 0; n < 64; ++n) acc += sC[(p * 64 + n) * 2] * sG[(n * 16 + q) * 2] - sC[(p * 64 + n) * 2 + 1] * sG[(n * 16 + q) * 2 + 1];
  ((float*)(P.ws + OFF_KTAB))[(size_t)it * 256 + tid] = acc;
  __syncthreads();
}
DI void phase0(const Params& P, char* smem) {
  const int bid = blockIdx.x, nb = gridDim.x, tid = threadIdx.x, hb = tid >> 8, t2 = tid & 255;
  {
    f32x2* PW = (f32x2*)(P.ws + OFF_PW); f32x2* FB = (f32x2*)(P.ws + OFF_FB);
    const int total = 32 * 2 * 65 * 64;
    for (int e = bid * NTHR + tid; e < total; e += nb * NTHR) {
      const int n = e & 63, ex = (e >> 6) % 65, gd = (e >> 6) / 65, dir = gd & 1, g = gd >> 1;
      float dt, lr, li; s5_lambda(P, g, dir, n, dt, lr, li);
      float re, im; cpow(dt, lr, li, (float)ex, re, im);
      PW[e] = f32x2{re, im};
      if (ex == 0) { float fr_, fi_; s5_f(dt, lr, li, fr_, fi_); FB[gd * 64 + n] = f32x2{fr_, fi_}; }
    }
  }
  if (bid == 0 && tid < 16) ((unsigned*)(P.ws + OFF_CTR))[tid] = 0u;
  for (int it = bid; it < 96; it += nb) p0_mod_item(P, smem, it);
  __syncthreads();
  constexpr int I1 = 1664, I2 = 256, I3 = 512;
  float* str = (float*)smem + hb * (64 * 33);
  for (int it = bid * 2 + hb; it < I1 + I2 + I3; it += nb * 2) {
    int r = it;
    if (r < I1) {
      const int kb = r / 104, nt = r % 104, n0 = nt * 32; int nvalid = INC - n0; nvalid = nvalid < 0 ? 0 : (nvalid > 32 ? 32 : nvalid);
      p0_transpose_item(P.w_in, INC, DM, kb * 64, n0, nvalid, (bf16_t*)(P.ws + OFF_WINT), n0, str, t2); continue;
    } r -= I1;
    if (r < I2) {
      const int kb = r / 32, nt = r % 32, n0 = nt * 32, t = n0 >> 8, i = n0 & 255;
      const int src0 = (i < 128) ? t * 128 + i : 512 + t * 128 + (i - 128);
      p0_transpose_item(P.glu_w, 1024, 512, kb * 64, src0, 32, (bf16_t*)(P.ws + OFF_GLUWT), n0, str, t2); continue;
    } r -= I2;
    { const int kb = r / 32, nt = r % 32; p0_transpose_item(P.w_out, 1024, 1024, kb * 64, nt * 32, 32, (bf16_t*)(P.ws + OFF_WOUTT), nt * 32, str, t2); }
  }
  __syncthreads();
  float* skt = (float*)smem + hb * 4352;
  for (int it = bid * 2 + hb; it < 4096; it += nb * 2) p0_ktab_item(P, skt, it, t2);
}

DI void phase1(const Params& P, char* smem) {
  const int bid = blockIdx.x, nb = gridDim.x, tid = threadIdx.x, lane = tid & 63, wid = tid >> 6;
  const float* mod = (const float*)(P.ws + OFF_MOD);
  bf16_t* hB = (bf16_t*)(P.ws + OFF_HB);
  for (int row0 = (bid * NWV + wid) * 4; row0 < NTOK; row0 += nb * NWV * 4) {
    f32x4 v[4][4];
#pragma unroll
    for (int u = 0; u < 4; ++u) {
      const f32x4* xr = (const f32x4*)(P.x + (size_t)(row0 + u) * DM) + lane;
#pragma unroll
      for (int j = 0; j < 4; ++j) v[u][j] = xr[64 * j];
    }
#pragma unroll
    for (int u = 0; u < 4; ++u) {
      const int row = row0 + u, b = row >> 12;
      float s = 0.f;
#pragma unroll
      for (int j = 0; j < 4; ++j) s += v[u][j][0] * v[u][j][0] + v[u][j][1] * v[u][j][1] + v[u][j][2] * v[u][j][2] + v[u][j][3] * v[u][j][3];
      const float rstd = rsqrtf(wave_sum(s) * (1.f / DM) + 1e-6f);
#pragma unroll
      for (int j = 0; j < 4; ++j) {
        const int col = lane * 4 + 256 * j;
        const f32x4 nw = *(const f32x4*)(P.norm_w + col), sh = *(const f32x4*)(mod + b * 3072 + col), sc = *(const f32x4*)(mod + b * 3072 + 1024 + col);
        float h[4];
#pragma unroll
        for (int e = 0; e < 4; ++e) h[e] = v[u][j][e] * rstd * nw[e] * (1.f + sc[e]) + sh[e];
        u32x2 o = {pk2(h[0], h[1]), pk2(h[2], h[3])};
        *(u32x2*)(hB + (size_t)row * DM + col) = o;
      }
    }
  }
  const float* KT = (const float*)(P.ws + OFF_KTAB);
  const f32x2* PW = (const f32x2*)(P.ws + OFF_PW); const f32x2* FB = (const f32x2*)(P.ws + OFF_FB);
  bf16_t* MY = (bf16_t*)(P.ws + OFF_MY); bf16_t* MS = (bf16_t*)(P.ws + OFF_MS);
  const int totalY = 32 * 1024 * 160;
  for (int e = bid * NTHR + tid; e < totalY; e += nb * NTHR) {
    const int kc = e % 160, row = (e / 160) & 1023, g = e / (160 * 1024), t = row >> 4, p = row & 15;
    float o[8];
    if (kc < 128) {
      const int s = kc >> 1, q0 = (kc & 1) * 8;
      if (t == s) {
        const float* k0 = KT + ((size_t)((g * 2 + 0) * 64 + 0) * 256 + p * 16 + q0); const float* k1 = KT + ((size_t)((g * 2 + 1) * 64 + 0) * 256 + p * 16 + q0);
#pragma unroll
        for (int j = 0; j < 8; ++j) o[j] = k0[j] + k1[j] + ((q0 + j == p) ? P.s5_d[g * 16 + p] : 0.f);
      } else {
        const int dir = t > s ? 0 : 1, tau = t > s ? t - s : s - t;
        const float* k0 = KT + ((size_t)((g * 2 + dir) * 64 + tau) * 256 + p * 16 + q0);
#pragma unroll
        for (int j = 0; j < 8; ++j) o[j] = k0[j];
      }
    } else {
      const int c2 = (kc - 128) * 8, dir = c2 >> 7, part = (c2 >> 6) & 1, n0 = c2 & 63;
      const int ex = dir == 0 ? t + 1 : 64 - t;
#pragma unroll
      for (int j = 0; j < 8; ++j) {
        const int n = n0 + j; const f32x2 a = PW[((g * 2 + dir) * 65 + ex) * 64 + n];
        const float cr = P.c_re[dir][(g * 16 + p) * 64 + n], ci = P.c_im[dir][(g * 16 + p) * 64 + n];
        o[j] = part == 0 ? (cr * a[0] - ci * a[1]) : -(cr * a[1] + ci * a[0]);
      }
    }
    u32x4 ov = {pk2(o[0], o[1]), pk2(o[2], o[3]), pk2(o[4], o[5]), pk2(o[6], o[7])};
    *(u32x4*)(MY + ((size_t)(g * 1024 + row) * 1280 + kc * 8)) = ov;
  }
  const int totalS = 32 * 256 * 128;
  for (int e = bid * NTHR + tid; e < totalS; e += nb * NTHR) {
    const int kc = e & 127, row = (e >> 7) & 255, g = e >> 15, dir = row >> 7, part = (row >> 6) & 1, n = row & 63;
    const int s = kc >> 1, q0 = (kc & 1) * 8, ex = dir == 0 ? 63 - s : s;
    const f32x2 a = PW[((g * 2 + dir) * 65 + ex) * 64 + n], f = FB[(g * 2 + dir) * 64 + n];
    const float wr_ = a[0] * f[0] - a[1] * f[1], wi_ = a[0] * f[1] + a[1] * f[0];
    float o[8];
#pragma unroll
    for (int j = 0; j < 8; ++j) {
      const float br = P.b_re[dir][(g * 64 + n) * 16 + q0 + j], bi = P.b_im[dir][(g * 64 + n) * 16 + q0 + j];
      o[j] = part == 0 ? (wr_ * br - wi_ * bi) : (wr_ * bi + wi_ * br);
    }
    u32x4 ov = {pk2(o[0], o[1]), pk2(o[2], o[3]), pk2(o[4], o[5]), pk2(o[6], o[7])};
    *(u32x4*)(MS + ((size_t)(g * 256 + row) * 1024 + kc * 8)) = ov;
  }
}

DI void phase2(const Params& P, LAS unsigned char* lds) {
  const int tid = threadIdx.x, lane = tid & 63, wid = tid >> 6, wr = wid >> 2, wc = wid & 3, fr = lane & 15, fq = lane >> 4;
  const bf16_t* hB = (const bf16_t*)(P.ws + OFF_HB); const bf16_t* W = (const bf16_t*)(P.ws + OFF_WINT);
  bf16_t* U5 = (bf16_t*)(P.ws + OFF_U5); bf16_t* ZA = (bf16_t*)(P.ws + OFF_ZA); bf16_t* ZB = (bf16_t*)(P.ws + OFF_ZB);
  bf16_t* QKV = (bf16_t*)(P.ws + OFF_QKVRAW); float* BA = (float*)(P.ws + OFF_BA);
  constexpr int NT = 13, NTILES = 256 * NT;
  const int bid = blockIdx.x, nbk = gridDim.x, nj = bid < NTILES ? (NTILES - bid + nbk - 1) / nbk : 0;
  auto tile_of = [&](int j, int& tm, int& tn) { const int id = bid + j * nbk, grp = id / (8 * NT), ig = id % (8 * NT); tm = grp * 8 + (ig & 7); tn = ig >> 3; };
  gemm256_stream<true, true>(nj, DM / 64, DM, DM,
    [&](int j, const bf16_t*& A, const bf16_t*& Bt) { int tm, tn; tile_of(j, tm, tn); A = hB + (size_t)tm * 256 * DM; Bt = W + (size_t)tn * 256 * DM; },
    [&](int j, f32x4 (&acc)[2][2][4][2]) {
      int tm, tn; tile_of(j, tm, tn);
#pragma unroll
      for (int ai = 0; ai < 2; ++ai)
#pragma unroll
        for (int m = 0; m < 4; ++m) {
          const int t = tm * 256 + ai * 128 + wr * 64 + m * 16 + fr;
#pragma unroll
          for (int bj = 0; bj < 2; ++bj) {
            const int col = tn * 256 + bj * 128 + wc * 32 + fq * 8;
            const f32x4 v0 = acc[ai][bj][m][0], v1 = acc[ai][bj][m][1];
            if (tn == 12) { if (col < INC) { *(f32x4*)(BA + (size_t)t * 16 + (col - 3072)) = v0; *(f32x4*)(BA + (size_t)t * 16 + (col - 3072) + 4) = v1; } continue; }
            const u32x4 o = {pk2(v0[0], v0[1]), pk2(v0[2], v0[3]), pk2(v1[0], v1[1]), pk2(v1[2], v1[3])};
            if (tn < 2) { const int g = col >> 4, q = col & 15; *(u32x4*)(U5 + ((size_t)(g * 1024 + (t >> 6)) * 1280 + (t & 63) * 16 + q)) = o; }
            else if (tn < 4) *(u32x4*)(ZA + (size_t)t * 512 + (col - 512)) = o;
            else if (tn < 10) *(u32x4*)(QKV + (size_t)t * 1536 + (col - 1024)) = o;
            else *(u32x4*)(ZB + (size_t)t * 512 + (col - 2560)) = o;
          }
        }
    }, lds);
}

DI void phase3(const Params& P, LAS unsigned char* lds) {
  const int tid = threadIdx.x, lane = tid & 63, wid = tid >> 6, wr = wid >> 2, wc = wid & 3, fr = lane & 15, fq = lane >> 4;
  const bf16_t* MS = (const bf16_t*)(P.ws + OFF_MS); const bf16_t* U5 = (const bf16_t*)(P.ws + OFF_U5);
  float* SC = P.out;
  const int nrep3a_ = (REP_PHASE == 30) ? P.p_hi - 7 : 1;
  for (int rep3a_ = 0; rep3a_ < nrep3a_; ++rep3a_)
  for (int id = blockIdx.x; id < 128; id += gridDim.x) {
    const int g = id >> 2, tn = id & 3;
    f32x4 acc[2][2][4][2];
    gemm256<false>(MS + (size_t)(g * 256) * 1024, 1024, U5 + (size_t)(g * 1024 + tn * 256) * 1280, 1280, 1024, lds, acc);
#pragma unroll
    for (int ai = 0; ai < 2; ++ai)
#pragma unroll
      for (int bj = 0; bj < 2; ++bj)
#pragma unroll
        for (int m = 0; m < 4; ++m)
#pragma unroll
          for (int n = 0; n < 2; ++n) {
            const int row0 = ai * 128 + wr * 64 + m * 16 + fq * 4, col = tn * 256 + bj * 128 + wc * 32 + n * 16 + fr;
            *(f32x4*)(SC + ((size_t)(g * 1024 + col) * 256 + row0)) = acc[ai][bj][m][n];
          }
  }
  const bf16_t* QKV = (const bf16_t*)(P.ws + OFF_QKVRAW);
  const int nbk = gridDim.x, vb = (blockIdx.x + nbk - (128 % nbk)) % nbk;
  const int nrep3b_ = (REP_PHASE == 31) ? P.p_hi - 7 : 1;
  for (int rep3b_ = 0; rep3b_ < nrep3b_; ++rep3b_)
  for (int it = vb * NWV + wid; it < 16 * 128 * 3; it += nbk * NWV) {
    const int part = it % 3, c = (it / 3) & 127, b = it / (3 * 128), h = lane >> 4;
    const int colq = part * 512 + lane * 8;
    float wt[5][8];
#pragma unroll
    for (int k = 0; k < 5; ++k) {
      const f32x4 wa = *(const f32x4*)(P.conv_w + k * 1536 + colq), wb = *(const f32x4*)(P.conv_w + k * 1536 + colq + 4);
#pragma unroll
      for (int e = 0; e < 4; ++e) { wt[k][e] = wa[e]; wt[k][4 + e] = wb[e]; }
    }
    bf16_t* dst = (bf16_t*)(P.ws + (part == 0 ? OFF_QN : part == 1 ? OFF_KN : OFF_VN)) + (size_t)(b * 4 + h) * SEQ * 128 + (lane & 15) * 8;
    const int l0 = c * 32;
#pragma unroll 1
    for (int i0 = 0; i0 < 32; i0 += 8) {
      u32x4 u[12];
#pragma unroll
      for (int k = 0; k < 12; ++k) {
        const int l = l0 + i0 - 2 + k;
        u[k] = (l >= 0 && l < SEQ) ? *(const u32x4*)(QKV + (size_t)(b * SEQ + l) * 1536 + colq) : u32x4{0u, 0u, 0u, 0u};
      }
#pragma unroll
      for (int i = 0; i < 8; ++i) {
        float y[8];
#pragma unroll
        for (int e = 0; e < 8; ++e) y[e] = 0.f;
#pragma unroll
        for (int k = 0; k < 5; ++k)
#pragma unroll
          for (int e = 0; e < 4; ++e) { y[2 * e] += wt[k][2 * e] * bflo(u[i + k][e]); y[2 * e + 1] += wt[k][2 * e + 1] * bfhi(u[i + k][e]); }
        float ss = 0.f;
#pragma unroll
        for (int e = 0; e < 8; ++e) { y[e] = siluf_(y[e]); ss += y[e] * y[e]; }
        if (part < 2) {
#pragma unroll
          for (int o = 1; o < 16; o <<= 1) ss += __shfl_xor(ss, o);
          float sc = rsqrtf(ss + 1e-6f); if (part == 0) sc *= 0.08838834764831845f;
#pragma unroll
          for (int e = 0; e < 8; ++e) y[e] *= sc;
        }
        *(u32x4*)(dst + (size_t)(l0 + i0 + i) * 128) = u32x4{pk2(y[0], y[1]), pk2(y[2], y[3]), pk2(y[4], y[5]), pk2(y[6], y[7])};
      }
    }
  }
}

struct PrepIn { u32x4 k[4], q[4], v[4]; float be, al; };
DI void dn_prep_issue(const Params& P, PrepIn& I, int item, int tid) {
  const int cc = item & 63, hd = (item >> 6) & 7, b = item >> 9, dir = hd >> 2, h = hd & 3;
  const size_t base = (size_t)(b * 4 + h) * SEQ * 128;
  const bf16_t* Qn = (const bf16_t*)(P.ws + OFF_QN) + base; const bf16_t* Kn = (const bf16_t*)(P.ws + OFF_KN) + base; const bf16_t* Vn = (const bf16_t*)(P.ws + OFF_VN) + base;
#pragma unroll
  for (int k = 0; k < 4; ++k) {
    const int idx = tid + 256 * k, row = idx >> 4, ch = idx & 15, p = cc * 64 + row, l = dir ? (SEQ - 1 - p) : p;
    I.k[k] = *(const u32x4*)(Kn + (size_t)l * 128 + ch * 8); I.q[k] = *(const u32x4*)(Qn + (size_t)l * 128 + ch * 8); I.v[k] = *(const u32x4*)(Vn + (size_t)l * 128 + ch * 8);
  }
  if (tid < 64) {
    const float* BA = (const float*)(P.ws + OFF_BA);
    const int p = cc * 64 + tid, l = dir ? (SEQ - 1 - p) : p; const size_t t = (size_t)b * SEQ + l;
    I.be = BA[t * 16 + dir * 4 + h]; I.al = BA[t * 16 + 8 + dir * 4 + h];
  }
}
DI void dn_prep_loop(const Params& P, char* sm, int first, int stride, int tid) {
  const int lane = tid & 63, w = tid >> 6, r = lane & 31, hh = lane >> 5;
  bf16_t* sK = (bf16_t*)sm;
  bf16_t* sQ = sK + 64 * 132;
  bf16_t* sRv = sQ;
  bf16_t* sLm = sQ + 128 * 68;
  bf16_t* sTt = sLm + 64 * 68;
  bf16_t* sRk = sLm;
  bf16_t* sT = sTt + 64 * 68;
  float* sg = (float*)(sT + 64 * 68);
  float* sbeta = sg + 64;
  float* seg = sbeta + 64;
  bf16_t* sV = (bf16_t*)(seg + 64);
  float* GC = (float*)(P.ws + OFF_GC);
  PrepIn I;
  if (first < 8192) dn_prep_issue(P, I, first, tid);
  for (int item = first; item < 8192; item += stride) {
  const int cc = item & 63, hd = (item >> 6) & 7, dir = hd >> 2, h = hd & 3;
  lds_barrier();
#pragma unroll
  for (int k = 0; k < 4; ++k) {
    const int idx = tid + 256 * k, row = idx >> 4, ch = idx & 15;
    *(u32x2*)(sK + row * 132 + ch * 8) = u32x2{I.k[k][0], I.k[k][1]}; *(u32x2*)(sK + row * 132 + ch * 8 + 4) = u32x2{I.k[k][2], I.k[k][3]};
    *(u32x2*)(sQ + row * 132 + ch * 8) = u32x2{I.q[k][0], I.q[k][1]}; *(u32x2*)(sQ + row * 132 + ch * 8 + 4) = u32x2{I.q[k][2], I.q[k][3]};
    *(u32x2*)(sV + row * 132 + ch * 8) = u32x2{I.v[k][0], I.v[k][1]}; *(u32x2*)(sV + row * 132 + ch * 8 + 4) = u32x2{I.v[k][2], I.v[k][3]};
  }
  for (int e = tid; e < 64 * 68 / 2; e += 256) { ((unsigned*)sT)[e] = 0u; ((unsigned*)sTt)[e] = 0u; }
  if (tid < 64) {
    const float be = sigmoidf_(I.be);
    const float g = -expf(P.a_log[dir][h]) * softplusf_(I.al + P.dt_bias[dir][h]);
    float gc = g;
#pragma unroll
    for (int o = 1; o < 64; o <<= 1) { const float v = __shfl_up(gc, o); if (lane >= o) gc += v; }
    sg[tid] = gc; sbeta[tid] = be; seg[tid] = expf(gc); GC[(size_t)item * 64 + tid] = gc;
  }
  if (item + stride < 8192) dn_prep_issue(P, I, item + stride, tid);
  lds_barrier();
  {
    const int mi = w >> 1, ni = w & 1;
    f32x16 kk, qk;
#pragma unroll
    for (int i = 0; i < 16; ++i) { kk[i] = 0.f; qk[i] = 0.f; }
#pragma unroll
    for (int ks = 0; ks < 8; ++ks) {
      const bf16x8 bf = ldfrag(sK, 32 * ni + r, 132, 16 * ks + 4 * hh);
      const bf16x8 ak = ldfrag(sK, 32 * mi + r, 132, 16 * ks + 4 * hh);
      const bf16x8 aq = ldfrag(sQ, 32 * mi + r, 132, 16 * ks + 4 * hh);
      kk = MFMA32(ak, bf, kk); qk = MFMA32(aq, bf, qk);
    }
    lds_barrier();
    bf16_t* ATT = (bf16_t*)(P.ws + OFF_ATT) + (size_t)item * 4096;
    const int j = 32 * ni + r; const float gj = sg[j];
#pragma unroll
    for (int reg = 0; reg < 16; ++reg) {
      const int i = 32 * mi + crow(reg, hh);
      const float d = __expf(i >= j ? sg[i] - gj : 0.f);
      sLm[i * 68 + j] = f2bf((i > j) ? sbeta[i] * kk[reg] * d : 0.f);
      for (int rep = 0; rep <= DUPST; ++rep) { ATT[i * 64 + j] = f2bf((i >= j) ? qk[reg] * d : 0.f); asm volatile("" ::: "memory"); }
    }
  }
  lds_barrier();
  if (tid < 64) {
    const int blk = tid >> 4, c = tid & 15;
    float x[16];
#pragma unroll
    for (int i = 0; i < 16; ++i) {
      float a = (i == c) ? 1.f : 0.f;
      const bf16_t* lrow = sLm + (16 * blk + i) * 68 + 16 * blk;
#pragma unroll
      for (int j = 0; j < i; ++j) a -= bf2f(lrow[j]) * x[j];
      x[i] = a;
    }
#pragma unroll
    for (int i = 0; i < 16; ++i) { const bf16_t v = f2bf(x[i]); sT[(16 * blk + i) * 68 + 16 * blk + c] = v; sTt[(16 * blk + c) * 68 + 16 * blk + i] = v; }
  }
  lds_barrier();
  if (w < 2) {
    const int a = w;
    f32x16 X, Y;
#pragma unroll
    for (int i = 0; i < 16; ++i) { X[i] = 0.f; Y[i] = 0.f; }
    {
      bf16x8 A = ldfrag(sLm, 32 * a + r, 68, 32 * a + 4 * hh);
      if (r < 16) A = bf16x8{0, 0, 0, 0, 0, 0, 0, 0};
      X = MFMA32(A, ldfrag(sTt, 32 * a + r, 68, 32 * a + 4 * hh), X);
    }
#pragma unroll
    for (int s = 0; s < 2; ++s) Y = MFMA32(ldfrag(sT, 32 * a + r, 68, 32 * a + 16 * s + 4 * hh), pack8(X, s), Y);
    if (r < 16) {
#pragma unroll
      for (int reg = 8; reg < 16; ++reg) {
        const int i = crow(reg, hh); const bf16_t v = f2bf(-Y[reg]);
        sT[(32 * a + i) * 68 + 32 * a + r] = v; sTt[(32 * a + r) * 68 + 32 * a + i] = v;
      }
    }
  }
  lds_barrier();
  if (w == 0) {
    f32x16 X, Y;
#pragma unroll
    for (int i = 0; i < 16; ++i) { X[i] = 0.f; Y[i] = 0.f; }
#pragma unroll
    for (int s = 0; s < 2; ++s) X = MFMA32(ldfrag(sLm, 32 + r, 68, 16 * s + 4 * hh), ldfrag(sTt, r, 68, 16 * s + 4 * hh), X);
#pragma unroll
    for (int s = 0; s < 2; ++s) Y = MFMA32(ldfrag(sT, 32 + r, 68, 32 + 16 * s + 4 * hh), pack8(X, s), Y);
#pragma unroll
    for (int reg = 0; reg < 16; ++reg) sT[(32 + crow(reg, hh)) * 68 + r] = f2bf(-Y[reg]);
  }
  lds_barrier();
  {
    const int c = tid;
    if (c < 128) {
#pragma unroll 2
      for (int i0 = 0; i0 < 64; i0 += 16) {
        float x[16];
#pragma unroll
        for (int i = 0; i < 16; ++i) x[i] = bf2f(sV[(i0 + i) * 132 + c]) * sbeta[i0 + i];
#pragma unroll
        for (int i = 0; i < 16; i += 4) *(u32x2*)(sRv + c * 68 + i0 + i) = u32x2{pk2(x[i], x[i + 1]), pk2(x[i + 2], x[i + 3])};
      }
    } else {
      const int d = c - 128;
      bf16_t* Kt = (bf16_t*)(P.ws + OFF_KTT) + (size_t)item * 8192 + d * 64;
      const float gl = sg[63];
#pragma unroll 2
      for (int i = 0; i < 64; i += 8) {
        float y[8], kt[8];
#pragma unroll
        for (int e = 0; e < 8; ++e) {
          const float kv = bf2f(sK[(i + e) * 132 + d]), ge = seg[i + e];
          y[e] = kv * sbeta[i + e] * ge; kt[e] = kv * __expf(gl - sg[i + e]);
        }
        *(u32x2*)(sRk + d * 68 + i) = u32x2{pk2(y[0], y[1]), pk2(y[2], y[3])}; *(u32x2*)(sRk + d * 68 + i + 4) = u32x2{pk2(y[4], y[5]), pk2(y[6], y[7])};
        *(u32x4*)(Kt + i) = u32x4{pk2(kt[0], kt[1]), pk2(kt[2], kt[3]), pk2(kt[4], kt[5]), pk2(kt[6], kt[7])};
      }
    }
  }
  lds_barrier();
  {
    bf16_t* Ut = (bf16_t*)(P.ws + OFF_UT) + (size_t)item * 8192;
    bf16_t* Wc = (bf16_t*)(P.ws + OFF_WC) + (size_t)item * 8192;
#pragma unroll
    for (int mi = 0; mi < 2; ++mi) {
      f32x16 du, dw;
#pragma unroll
      for (int i = 0; i < 16; ++i) { du[i] = 0.f; dw[i] = 0.f; }
#pragma unroll
      for (int s = 0; s < 4; ++s) {
        if (mi == 0 && s >= 2) continue;
        const bf16x8 tf = ldfrag(sT, 32 * mi + r, 68, 16 * s + 4 * hh);
        du = MFMA32(tf, ldfrag(sRv, 32 * w + r, 68, 16 * s + 4 * hh), du);
        dw = MFMA32(ldfrag(sRk, 32 * w + r, 68, 16 * s + 4 * hh), tf, dw);
      }
#pragma unroll
      for (int g4 = 0; g4 < 4; ++g4) {
        for (int rep = 0; rep <= DUPST; ++rep) {
        *(u32x2*)(Ut + (32 * w + r) * 64 + 32 * mi + 8 * g4 + 4 * hh) = u32x2{pk2(du[4 * g4], du[4 * g4 + 1]), pk2(du[4 * g4 + 2], du[4 * g4 + 3])};
        *(u32x2*)(Wc + (32 * mi + r) * 128 + 32 * w + 8 * g4 + 4 * hh) = u32x2{pk2(dw[4 * g4], dw[4 * g4 + 1]), pk2(dw[4 * g4 + 2], dw[4 * g4 + 3])};
        asm volatile("" ::: "memory"); }
      }
    }
  }
  }
}
DI void phase4(const Params& P, char* smem) {
  const int tid = threadIdx.x;
  {
    const float* SC = P.out; bf16_t* U5 = (bf16_t*)(P.ws + OFF_U5); const f32x2* PW = (const f32x2*)(P.ws + OFF_PW);
    const int nrep0_ = (REP_PHASE == 40) ? P.p_hi - 7 : 1;
    for (int rep0_ = 0; rep0_ < nrep0_; ++rep0_)
    for (int it = blockIdx.x; it < 128; it += gridDim.x) {
      const int g = it >> 2, b = (it & 3) * 4 + (tid >> 7), dir = (tid >> 6) & 1, n = tid & 63;
      const f32x2 a = PW[((g * 2 + dir) * 65 + 64) * 64 + n];
      float xr = 0.f, xi = 0.f;
#pragma unroll 8
      for (int s = 0; s < 64; ++s) {
        const int c = dir ? 63 - s : s; const size_t nn = (size_t)g * 1024 + b * 64 + c;
        U5[nn * 1280 + 1024 + dir * 128 + n] = f2bf(xr); U5[nn * 1280 + 1024 + dir * 128 + 64 + n] = f2bf(xi);
        const float sr = SC[nn * 256 + dir * 128 + n], si = SC[nn * 256 + dir * 128 + 64 + n];
        const float nr = a[0] * xr - a[1] * xi + sr, ni = a[0] * xi + a[1] * xr + si;
        xr = nr; xi = ni;
      }
    }
  }
  const int hb = tid >> 8;
  dn_prep_loop(P, smem + hb * 78336, blockIdx.x * 2 + hb, (REP_PHASE == 41) ? gridDim.x * 2 / (P.p_hi - 7) : gridDim.x * 2, tid & 255);
}

constexpr int RB_W = 136, RB_A = 72;
constexpr int RB_G = 2 * (64 * RB_W + 64 * RB_W + 64 * RB_A + 128 * RB_A);
constexpr int RB_BYTES = RB_G + 256;
struct DnLd { u64_t v[32]; float g; };
DI void dn_issue(const Params& P, DnLd& L, int seq, int cc, int lw, int lane) {
  const int b = seq >> 3, hd = seq & 7, dir = hd >> 2, h = hd & 3;
  const size_t item = (size_t)seq * 64 + cc;
  if (lw == 0) {
    const bf16_t* Wg = (const bf16_t*)(P.ws + OFF_WC) + item * 8192;
#pragma unroll
    for (int k = 0; k < 32; ++k) { const int idx = lane + 64 * k; L.v[k] = ld8_pinned(Wg + (idx >> 5) * 128 + (idx & 31) * 4); }
  } else if (lw == 1) {
    const bf16_t* Qn = (const bf16_t*)(P.ws + OFF_QN) + (size_t)(b * 4 + h) * SEQ * 128;
#pragma unroll
    for (int k = 0; k < 32; ++k) {
      const int idx = lane + 64 * k, row = idx >> 5, p = cc * 64 + row, l = dir ? (SEQ - 1 - p) : p;
      L.v[k] = ld8_pinned(Qn + (size_t)l * 128 + (idx & 31) * 4);
    }
  } else if (lw == 2) {
    const bf16_t* Kg = (const bf16_t*)(P.ws + OFF_KTT) + item * 8192;
#pragma unroll
    for (int k = 0; k < 32; ++k) { const int idx = lane + 64 * k; L.v[k] = ld8_pinned(Kg + (idx >> 4) * 64 + (idx & 15) * 4); }
  } else {
    const bf16_t* Ag = (const bf16_t*)(P.ws + OFF_ATT) + item * 4096;
#pragma unroll
    for (int k = 0; k < 16; ++k) { const int idx = lane + 64 * k; L.v[k] = ld8_pinned(Ag + (idx >> 4) * 64 + (idx & 15) * 4); }
    L.g = ld4_pinned((const float*)(P.ws + OFF_GC) + item * 64 + lane);
  }
}
DI void dn_commit(const DnLd& L, char* buf, int lw, int lane) {
  bf16_t* sW = (bf16_t*)buf; bf16_t* sQ = sW + 64 * RB_W; bf16_t* sA = sQ + 64 * RB_W; bf16_t* sKt = sA + 64 * RB_A;
  if (lw == 0) {
#pragma unroll
    for (int k = 0; k < 32; ++k) { const int idx = lane + 64 * k, p = idx & 31, ps = (p & ~3) | ((p & 1) << 1) | ((p >> 1) & 1); *(u64_t*)(sW + (idx >> 5) * RB_W + ps * 4) = L.v[k]; }
  } else if (lw == 1) {
#pragma unroll
    for (int k = 0; k < 32; ++k) { const int idx = lane + 64 * k, p = idx & 31, ps = (p & ~3) | ((p & 1) << 1) | ((p >> 1) & 1); *(u64_t*)(sQ + (idx >> 5) * RB_W + ps * 4) = L.v[k]; }
  } else if (lw == 2) {
#pragma unroll
    for (int k = 0; k < 32; ++k) { const int idx = lane + 64 * k, p = idx & 15, ps = (p & ~3) | ((p & 1) << 1) | ((p >> 1) & 1); *(u64_t*)(sKt + (idx >> 4) * RB_A + ps * 4) = L.v[k]; }
  } else {
#pragma unroll
    for (int k = 0; k < 16; ++k) { const int idx = lane + 64 * k, p = idx & 15, ps = (p & ~3) | ((p & 1) << 1) | ((p >> 1) & 1); *(u64_t*)(sA + (idx >> 4) * RB_A + ps * 4) = L.v[k]; }
    ((float*)(buf + RB_G))[lane] = L.g;
  }
}
DI void dn_recur(const Params& P, char* smem, int seq) {
  const int tid = threadIdx.x, lane = tid & 63, w = __builtin_amdgcn_readfirstlane(tid >> 6), r = lane & 31, hh = lane >> 5;
  const int b = seq >> 3, hd = seq & 7, dir = hd >> 2, h = hd & 3;
  __syncthreads();
  if (w >= 4) {
    const int lw = w - 4;
    DnLd LA, LB;
    dn_issue(P, LA, seq, 0, lw, lane);
    dn_commit(LA, smem, lw, lane);
    dn_issue(P, LA, seq, 1, lw, lane);
    dn_issue(P, LB, seq, 2, lw, lane);
    lds_barrier();
    for (int cc = 0; cc < 64; cc += 2) {
      for (int rep = 0; rep <= DUPL; ++rep) { dn_commit(LA, smem + RB_BYTES, lw, lane); asm volatile("" ::: "memory"); }
      for (int rep = 0; rep <= DUPL; ++rep) { dn_issue(P, LA, seq, min(cc + 3, 63), lw, lane); asm volatile("" ::: "memory"); }
      lds_barrier();
      for (int rep = 0; rep <= DUPL; ++rep) { dn_commit(LB, smem, lw, lane); asm volatile("" ::: "memory"); }
      for (int rep = 0; rep <= DUPL; ++rep) { dn_issue(P, LB, seq, min(cc + 4, 63), lw, lane); asm volatile("" ::: "memory"); }
      lds_barrier();
    }
  } else {
    const int dv0 = 32 * w;
    const float* GC = (const float*)(P.ws + OFF_GC);
    bf16_t* O = (bf16_t*)P.out + (size_t)dir * NTOK * 512;
    f32x16 S[4];
#pragma unroll
    for (int t = 0; t < 4; ++t)
#pragma unroll
      for (int i = 0; i < 16; ++i) S[t][i] = 0.f;
    lds_barrier();
    for (int cc = 0; cc < 64; ++cc) {
      const size_t item = (size_t)seq * 64 + cc;
      const bf16_t* sW = (const bf16_t*)(smem + (cc & 1) * RB_BYTES); const bf16_t* sQ = sW + 64 * RB_W; const bf16_t* sA = sQ + 64 * RB_W; const bf16_t* sKt = sA + 64 * RB_A;
      const bf16_t* Ug = (const bf16_t*)(P.ws + OFF_UT) + item * 8192;
      f32x16 vn[2];
#pragma unroll
      for (int m = 0; m < 2; ++m)
#pragma unroll
        for (int g4 = 0; g4 < 4; ++g4) {
          const u32x2 u = *(const u32x2*)(Ug + (dv0 + r) * 64 + 32 * m + 8 * g4 + 4 * hh);
          vn[m][4 * g4 + 0] = bflo(u[0]); vn[m][4 * g4 + 1] = bfhi(u[0]); vn[m][4 * g4 + 2] = bflo(u[1]); vn[m][4 * g4 + 3] = bfhi(u[1]);
        }
      const float* sG = (const float*)(smem + (cc & 1) * RB_BYTES + RB_G);
      const float egl = __expf(sG[63]);
      f32x16 aW[2], aQ[2];
#pragma unroll
      for (int m = 0; m < 2; ++m)
#pragma unroll
        for (int i = 0; i < 16; ++i) { aW[m][i] = 0.f; aQ[m][i] = 0.f; }
      bf16x8 fa[2][4];
      fa[0][0] = ldfrag16(sW, r, RB_W, 0, hh); fa[0][1] = ldfrag16(sW, 32 + r, RB_W, 0, hh);
      fa[0][2] = ldfrag16(sQ, r, RB_W, 0, hh); fa[0][3] = ldfrag16(sQ, 32 + r, RB_W, 0, hh);
#pragma unroll
      for (int ks = 0; ks < 8; ++ks) {
        const int cur = ks & 1, nxt = cur ^ 1;
        if (ks + 1 < 8) {
          fa[nxt][0] = ldfrag16(sW, r, RB_W, (ks + 1), hh); fa[nxt][1] = ldfrag16(sW, 32 + r, RB_W, (ks + 1), hh);
          fa[nxt][2] = ldfrag16(sQ, r, RB_W, (ks + 1), hh); fa[nxt][3] = ldfrag16(sQ, 32 + r, RB_W, (ks + 1), hh);
        }
        const bf16x8 sf = pack8(S[ks >> 1], ks & 1);
        aW[0] = MFMA32(fa[cur][0], sf, aW[0]); aW[1] = MFMA32(fa[cur][1], sf, aW[1]);
        aQ[0] = MFMA32(fa[cur][2], sf, aQ[0]); aQ[1] = MFMA32(fa[cur][3], sf, aQ[1]);
      }
      bf16x8 fA[4];
#pragma unroll
      for (int ks = 0; ks < 4; ++ks) fA[ks] = ldfrag16(sA, r, RB_A, ks, hh);
#pragma unroll
      for (int m = 0; m < 2; ++m)
#pragma unroll
        for (int i = 0; i < 16; ++i) aQ[m][i] *= __expf(sG[32 * m + crow(i, hh)]);
#pragma unroll
      for (int m = 0; m < 2; ++m)
#pragma unroll
        for (int i = 0; i < 16; ++i) vn[m][i] -= aW[m][i];
      bf16x8 vf[4];
      vf[0] = pack8(vn[0], 0); vf[1] = pack8(vn[0], 1); vf[2] = pack8(vn[1], 0); vf[3] = pack8(vn[1], 1);
      bf16x8 fk[2][4];
#pragma unroll
      for (int ks = 0; ks < 4; ++ks) aQ[0] = MFMA32(fA[ks], vf[ks], aQ[0]);
#pragma unroll
      for (int ks = 0; ks < 4; ++ks) fA[ks] = ldfrag16(sA, 32 + r, RB_A, ks, hh);
#pragma unroll
      for (int ks = 0; ks < 4; ++ks) fk[0][ks] = ldfrag16(sKt, r, RB_A, ks, hh);
#pragma unroll
      for (int ks = 0; ks < 4; ++ks) aQ[1] = MFMA32(fA[ks], vf[ks], aQ[1]);
#pragma unroll
      for (int t = 0; t < 4; ++t) {
        const int cur = t & 1, nxt = cur ^ 1;
        if (t + 1 < 4) {
#pragma unroll
          for (int ks = 0; ks < 4; ++ks) fk[nxt][ks] = ldfrag16(sKt, 32 * (t + 1) + r, RB_A, ks, hh);
        }
#pragma unroll
        for (int i = 0; i < 16; ++i) S[t][i] *= egl;
#pragma unroll
        for (int ks = 0; ks < 4; ++ks) S[t] = MFMA32(fk[cur][ks], vf[ks], S[t]);
      }
      {
        bf16_t* Ob = O + (size_t)b * SEQ * 512 + h * 128 + dv0 + r;
#pragma unroll
        for (int m = 0; m < 2; ++m)
#pragma unroll
          for (int i = 0; i < 16; ++i) {
            const int p = cc * 64 + 32 * m + crow(i, hh), l = dir ? (SEQ - 1 - p) : p;
            Ob[(size_t)l * 512] = f2bf(aQ[m][i]);
          }
      }
      lds_barrier();
    }
  }
}

DI void phase6(const Params& P, LAS unsigned char* lds, int ctr_off) {
  const int tid = threadIdx.x, lane = tid & 63, wid = tid >> 6, wr = wid >> 2, wc = wid & 3, fr = lane & 15, fq = lane >> 4;
  const bf16_t* MY = (const bf16_t*)(P.ws + OFF_MY); const bf16_t* U5 = (const bf16_t*)(P.ws + OFF_U5);
  bf16_t* Y5 = (bf16_t*)(P.ws + OFF_Y5);
  unsigned* ctr = (unsigned*)(P.ws + OFF_CTR) + ctr_off;
  LAS unsigned* sid = (LAS unsigned*)(lds + 131072);
  const int q0 = blockIdx.x & 7, pref = (blockIdx.x < 128 && gridDim.x > 128) ? 1 : 0;
  int step = 0;
  for (;;) {
    const int q = (q0 + (step >> 1)) & 7, part = pref ^ (step & 1), lim = part ? 16 : 48;
    __syncthreads();
    if (tid == 0) *sid = atomicAdd(ctr + part * 8 + q, 1u);
    __syncthreads();
    const int got = (int)*sid;
    if (got >= lim) { if (++step >= 16) break; continue; }
    const int idl = part ? 48 + got : got;
    const int g = q + 8 * (idl >> 4), tn = (idl >> 2) & 3, tm = idl & 3;
    f32x4 acc[2][2][4][2];
    gemm256<false>(MY + (size_t)(g * 1024 + tm * 256) * 1280, 1280, U5 + (size_t)(g * 1024 + tn * 256) * 1280, 1280, 1280, lds, acc);
#pragma unroll
    for (int ai = 0; ai < 2; ++ai)
#pragma unroll
      for (int bj = 0; bj < 2; ++bj)
#pragma unroll
        for (int m = 0; m < 4; ++m)
#pragma unroll
          for (int n = 0; n < 2; ++n) {
            const int row0 = tm * 256 + ai * 128 + wr * 64 + m * 16 + fq * 4, col = tn * 256 + bj * 128 + wc * 32 + n * 16 + fr;
            const int t = row0 >> 4, p = row0 & 15; const size_t tok = (size_t)col * 64 + t;
            const f32x4 v = acc[ai][bj][m][n];
            const u32x2 o = {pk2(gelu_tanh(v[0]), gelu_tanh(v[1])), pk2(gelu_tanh(v[2]), gelu_tanh(v[3]))};
            *(u32x2*)(Y5 + tok * 512 + g * 16 + p) = o;
          }
  }
}

DI void phase7(const Params& P, LAS unsigned char* lds) {
  const int tid = threadIdx.x, lane = tid & 63, wid = tid >> 6, wr = wid >> 2, wc = wid & 3, fr = lane & 15, fq = lane >> 4;
  const bf16_t* Y5 = (const bf16_t*)(P.ws + OFF_Y5); const bf16_t* GW = (const bf16_t*)(P.ws + OFF_GLUWT);
  const bf16_t* ZA = (const bf16_t*)(P.ws + OFF_ZA); const bf16_t* ZB = (const bf16_t*)(P.ws + OFF_ZB);
  bf16_t* YAB = (bf16_t*)(P.ws + OFF_YAB);
  {
    const int bid = blockIdx.x, nbk = gridDim.x, nj = bid < 1024 ? (1024 - bid + nbk - 1) / nbk : 0;
    auto tile_of = [&](int j, int& tm, int& tn) { const int id = bid + j * nbk, grp = id >> 5, ig = id & 31; tm = grp * 8 + (ig & 7); tn = ig >> 3; };
    gemm256_stream<true, true>(nj, 8, 512, 512,
      [&](int j, const bf16_t*& A, const bf16_t*& Bt) { int tm, tn; tile_of(j, tm, tn); A = Y5 + (size_t)tm * 256 * 512; Bt = GW + (size_t)tn * 256 * 512; },
      [&](int j, f32x4 (&acc)[2][2][4][2]) {
        int tm, tn; tile_of(j, tm, tn);
        const int jc = tn * 128 + wc * 32 + fq * 8;
        f32x4 bv[2], bg[2];
#pragma unroll
        for (int n = 0; n < 2; ++n) { bv[n] = *(const f32x4*)(P.glu_b + jc + 4 * n); bg[n] = *(const f32x4*)(P.glu_b + 512 + jc + 4 * n); }
#pragma unroll
        for (int ai = 0; ai < 2; ++ai)
#pragma unroll
          for (int m = 0; m < 4; ++m) {
            const size_t t = (size_t)tm * 256 + ai * 128 + wr * 64 + m * 16 + fr;
            const u32x4 z = *(const u32x4*)(ZA + t * 512 + jc);
            float y[8];
#pragma unroll
            for (int n = 0; n < 2; ++n)
#pragma unroll
              for (int e = 0; e < 4; ++e) {
                const unsigned zz = z[2 * n + (e >> 1)]; const float zf = (e & 1) ? bfhi(zz) : bflo(zz);
                y[4 * n + e] = (acc[ai][0][m][n][e] + bv[n][e]) * sigmoidf_(acc[ai][1][m][n][e] + bg[n][e]) * siluf_(zf);
              }
            *(u32x4*)(YAB + t * 1024 + jc) = u32x4{pk2(y[0], y[1]), pk2(y[2], y[3]), pk2(y[4], y[5]), pk2(y[6], y[7])};
          }
      }, lds);
  }
  const bf16_t* Of = (const bf16_t*)P.out; const bf16_t* Ob = Of + (size_t)NTOK * 512;
  float nw[8];
#pragma unroll
  for (int e = 0; e < 8; ++e) nw[e] = P.dn_norm_w[(lane & 15) * 8 + e];
  for (int t0 = (blockIdx.x * NWV + wid) * 4; t0 < NTOK; t0 += gridDim.x * NWV * 4) {
    u32x4 a[4], bq[4], z[4];
#pragma unroll
    for (int u = 0; u < 4; ++u) {
      const size_t off = (size_t)(t0 + u) * 512 + lane * 8;
      a[u] = *(const u32x4*)(Of + off); bq[u] = *(const u32x4*)(Ob + off); z[u] = *(const u32x4*)(ZB + off);
    }
#pragma unroll
    for (int u = 0; u < 4; ++u) {
      float o[8]; float ss = 0.f;
#pragma unroll
      for (int e = 0; e < 4; ++e) { o[2 * e] = bflo(a[u][e]) + bflo(bq[u][e]); o[2 * e + 1] = bfhi(a[u][e]) + bfhi(bq[u][e]); }
#pragma unroll
      for (int e = 0; e < 8; ++e) ss += o[e] * o[e];
#pragma unroll
      for (int sft = 1; sft < 16; sft <<= 1) ss += __shfl_xor(ss, sft);
      const float rs = rsqrtf(ss * (1.f / 128.f) + 1e-6f);
      float y[8];
#pragma unroll
      for (int e = 0; e < 4; ++e) { y[2 * e] = o[2 * e] * rs * nw[2 * e] * siluf_(bflo(z[u][e])); y[2 * e + 1] = o[2 * e + 1] * rs * nw[2 * e + 1] * siluf_(bfhi(z[u][e])); }
      *(u32x4*)(YAB + (size_t)(t0 + u) * 1024 + 512 + lane * 8) = u32x4{pk2(y[0], y[1]), pk2(y[2], y[3]), pk2(y[4], y[5]), pk2(y[6], y[7])};
    }
  }
}

DI void phase8_norm(const Params& P, const float* sss, int tm) {
  const int tid = threadIdx.x, lane = tid & 63, wid = tid >> 6;
  __syncthreads();
  for (int rr = 0; rr < 32; rr += 4) {
    f32x4 v[4][4];
#pragma unroll
    for (int u = 0; u < 4; ++u) {
      const f32x4* xr = (const f32x4*)(P.out + ((size_t)tm * 256 + wid * 32 + rr + u) * DM) + lane;
#pragma unroll
      for (int j = 0; j < 4; ++j) v[u][j] = xr[64 * j];
    }
#pragma unroll
    for (int u = 0; u < 4; ++u) {
      const int row = wid * 32 + rr + u;
      const f32x4 p4 = *(const f32x4*)(sss + row * 4);
      const float rstd = rsqrtf((p4[0] + p4[1] + p4[2] + p4[3]) * (1.f / DM) + 1e-6f);
      f32x4* xr = (f32x4*)(P.out + ((size_t)tm * 256 + row) * DM) + lane;
#pragma unroll
      for (int j = 0; j < 4; ++j) {
        const f32x4 fw = *(const f32x4*)(P.final_norm_w + lane * 4 + 256 * j);
        f32x4 o;
#pragma unroll
        for (int e = 0; e < 4; ++e) o[e] = v[u][j][e] * rstd * fw[e];
        xr[64 * j] = o;
      }
    }
  }
  __syncthreads();
}
DI void phase8(const Params& P, LAS unsigned char* lds) {
  const int tid = threadIdx.x, lane = tid & 63, wid = tid >> 6, wr = wid >> 2, wc = wid & 3, fr = lane & 15, fq = lane >> 4;
  const bf16_t* YAB = (const bf16_t*)(P.ws + OFF_YAB); const bf16_t* W = (const bf16_t*)(P.ws + OFF_WOUTT);
  const float* mod = (const float*)(P.ws + OFF_MOD);
  float* sss = (float*)((char*)lds + 131072 + 64);
  for (int id = blockIdx.x * 4; id < 1024; id = ((id & 3) == 3) ? id - 3 + gridDim.x * 4 : id + 1) {
    const int tm = id >> 2, tn = id & 3;
    if (tn == 0) { for (int e = tid; e < 1024; e += NTHR) sss[e] = 0.f; }
    {
      f32x4 acc[2][2][4][2];
      gemm256<true, true>(YAB + (size_t)tm * 256 * 1024, 1024, W + (size_t)tn * 256 * 1024, 1024, 1024, lds, acc);
      f32x4 gvv[2][2];
#pragma unroll
      for (int bj = 0; bj < 2; ++bj)
#pragma unroll
        for (int n = 0; n < 2; ++n) gvv[bj][n] = *(const f32x4*)(mod + ((tm * 256) >> 12) * 3072 + 2048 + tn * 256 + bj * 128 + wc * 32 + fq * 8 + 4 * n);
#pragma unroll
      for (int ai = 0; ai < 2; ++ai)
#pragma unroll
        for (int m = 0; m < 4; ++m) {
          const size_t t = (size_t)tm * 256 + ai * 128 + wr * 64 + m * 16 + fr;
          float ssv = 0.f;
#pragma unroll
          for (int bj = 0; bj < 2; ++bj)
#pragma unroll
            for (int n = 0; n < 2; ++n) {
              const int col = tn * 256 + bj * 128 + wc * 32 + fq * 8 + 4 * n;
              const f32x4 xv = *(const f32x4*)(P.x + t * DM + col), gv = gvv[bj][n];
              f32x4 o;
#pragma unroll
              for (int e = 0; e < 4; ++e) { o[e] = xv[e] + gv[e] * acc[ai][bj][m][n][e]; ssv += o[e] * o[e]; }
              *(f32x4*)(P.out + t * DM + col) = o;
            }
          ssv += __shfl_xor(ssv, 16); ssv += __shfl_xor(ssv, 32);
          if (fq == 0) sss[(ai * 128 + wr * 64 + m * 16 + fr) * 4 + wc] += ssv;
        }
    }
    if (tn == 3) phase8_norm(P, sss, tm);
  }
}
DI void phase9(const Params& P) {
  const int tid = threadIdx.x, lane = tid & 63, wid = tid >> 6;
  for (int row0 = (blockIdx.x * NWV + wid) * 4; row0 < NTOK; row0 += gridDim.x * NWV * 4) {
    f32x4 v[4][4];
#pragma unroll
    for (int u = 0; u < 4; ++u) {
      const f32x4* xr = (const f32x4*)(P.out + (size_t)(row0 + u) * DM) + lane;
#pragma unroll
      for (int j = 0; j < 4; ++j) v[u][j] = xr[64 * j];
    }
#pragma unroll
    for (int u = 0; u < 4; ++u) {
      f32x4* xr = (f32x4*)(P.out + (size_t)(row0 + u) * DM) + lane;
      float s = 0.f;
#pragma unroll
      for (int j = 0; j < 4; ++j) s += v[u][j][0] * v[u][j][0] + v[u][j][1] * v[u][j][1] + v[u][j][2] * v[u][j][2] + v[u][j][3] * v[u][j][3];
      const float rstd = rsqrtf(wave_sum(s) * (1.f / DM) + 1e-6f);
#pragma unroll
      for (int j = 0; j < 4; ++j) {
        const f32x4 fw = *(const f32x4*)(P.final_norm_w + lane * 4 + 256 * j);
        f32x4 o;
#pragma unroll
        for (int e = 0; e < 4; ++e) o[e] = v[u][j][e] * rstd * fw[e];
        xr[64 * j] = o;
      }
    }
  }
}

#ifndef SPLIT56
#define SPLIT56 0
#endif
DI void phase5(const Params& P, char* smem, LAS unsigned char* lds) {
  for (int seq = blockIdx.x; seq < 128; seq += gridDim.x) dn_recur(P, smem, seq);
  if (!SPLIT56) phase6(P, lds, 0);
}
constexpr int LDS_BYTES = 160 * 1024;
__global__ void __launch_bounds__(NTHR) hybrid_fwd(Params P) {
  extern __shared__ __attribute__((aligned(16))) unsigned char lds_raw[];
  LAS unsigned char* lds = (LAS unsigned char*)lds_raw;
  char* smem = (char*)lds_raw;
  cg::grid_group grid = cg::this_grid();
#define SEAM(p) if (P.p_lo < (p) && P.p_hi >= (p)) grid.sync()
#ifndef PH_MASK
#define PH_MASK 0x3ff
#endif
#define RUN(p, call) if (((PH_MASK >> (p)) & 1) && P.p_lo <= (p) && P.p_hi >= (p)) { const int nrep_ = (REP_PHASE == (p)) ? P.p_hi - 7 : 1; for (int rep_ = 0; rep_ < nrep_; ++rep_) { if (rep_) grid.sync(); call; } }
  RUN(0, phase0(P, smem));
  SEAM(1);
  RUN(1, phase1(P, smem));
  SEAM(2);
  RUN(2, phase2(P, lds));
  SEAM(3);
  RUN(3, phase3(P, lds));
  SEAM(4);
  RUN(4, phase4(P, smem));
  SEAM(5);
  RUN(5, phase5(P, smem, lds));
  if (SPLIT56) { SEAM(6); RUN(6, phase6(P, lds, 0)); }
  SEAM(7);
  RUN(7, phase7(P, lds));
  SEAM(8);
  RUN(8, phase8(P, lds));
}

extern "C" void kernel_launch(void* const* d_in, const int* in_sizes, int n_in, void* d_out, int out_size, void* d_ws, size_t ws_size, hipStream_t stream) {
  static int grid_blocks = 0;
  if (!grid_blocks) {
    int dev = 0, cus = 0, per_cu = 0;
    (void)hipGetDevice(&dev);
    (void)hipDeviceGetAttribute(&cus, hipDeviceAttributeMultiprocessorCount, dev);
    (void)hipFuncSetAttribute((const void*)hybrid_fwd, hipFuncAttributeMaxDynamicSharedMemorySize, LDS_BYTES);
    (void)hipOccupancyMaxActiveBlocksPerMultiprocessor(&per_cu, (const void*)hybrid_fwd, NTHR, LDS_BYTES);
    if (per_cu < 1) per_cu = 1;
    if (per_cu > 1) per_cu = 1;
    grid_blocks = cus * per_cu;
    if (ws_size < WS_END) fprintf(stderr, "workspace too small: %zu < %zu\n", ws_size, (size_t)WS_END);
  }
  Params p{};
  const float* const* in = (const float* const*)d_in;
  p.x = in[0]; p.c = in[1]; p.ada_w = in[2]; p.ada_b = in[3]; p.norm_w = in[4]; p.w_in = in[5]; p.conv_w = in[6];
  p.a_log[0] = in[7]; p.dt_bias[0] = in[8]; p.a_log[1] = in[9]; p.dt_bias[1] = in[10]; p.dn_norm_w = in[11];
  for (int d = 0; d < 2; ++d) {
    const int o = 12 + 7 * d;
    p.lam_re[d] = in[o]; p.lam_im[d] = in[o + 1]; p.log_step[d] = in[o + 2]; p.b_re[d] = in[o + 3]; p.b_im[d] = in[o + 4]; p.c_re[d] = in[o + 5]; p.c_im[d] = in[o + 6];
  }
  p.s5_d = in[26]; p.glu_w = in[27]; p.glu_b = in[28]; p.w_out = in[29]; p.final_norm_w = in[30];
  p.out = (float*)d_out; p.ws = (char*)d_ws;
#if N_LAUNCH_MODE == 1
  for (int ph = 0; ph <= 9; ++ph) {
    p.p_lo = ph; p.p_hi = ph;
    hipLaunchKernelGGL(hybrid_fwd, dim3(grid_blocks), dim3(NTHR), LDS_BYTES, stream, p);
  }
#else
  p.p_lo = 0; p.p_hi = 9;
  void* args[] = {&p};
  hipError_t e = hipLaunchCooperativeKernel((const void*)hybrid_fwd, dim3(grid_blocks), dim3(NTHR), args, LDS_BYTES, stream);
  if (e != hipSuccess) fprintf(stderr, "cooperative launch failed: %s (grid %d)\n", hipGetErrorString(e), grid_blocks);
#endif
}
```

```cpp
#include <hip/hip_runtime.h>
#include <hip/hip_cooperative_groups.h>
#include <cstdio>
#include <cstdint>
namespace cg = cooperative_groups;

#ifndef N_LAUNCH_MODE
#define N_LAUNCH_MODE 0
#endif
#ifndef REP_PHASE
#define REP_PHASE -1
#endif

#define DUPST 0
#ifndef DUPL
#define DUPL 0
#endif
#define DI __device__ __forceinline__
#define LAS __attribute__((address_space(3)))
constexpr int NTHR = 512, NWV = 8;
typedef unsigned short bf16_t;
typedef short bf16x8 __attribute__((ext_vector_type(8)));
typedef float f32x4 __attribute__((ext_vector_type(4)));
typedef float f32x2 __attribute__((ext_vector_type(2)));
typedef float f32x16 __attribute__((ext_vector_type(16)));
typedef unsigned u32x4 __attribute__((ext_vector_type(4)));
typedef unsigned u32x2 __attribute__((ext_vector_type(2)));
typedef __bf16 bf2_t __attribute__((ext_vector_type(2)));

constexpr int DM = 1024, NB = 16, SEQ = 4096, NTOK = NB * SEQ;
constexpr int INC = 3088, INP = 3328;
constexpr size_t MiB = 1u << 20;
constexpr size_t OFF_HB = 0;
constexpr size_t OFF_QKVRAW = 128 * MiB;
constexpr size_t OFF_WC = 0;
constexpr size_t OFF_UT = 128 * MiB;
constexpr size_t OFF_ATT = 256 * MiB;
constexpr size_t OFF_Y5 = 656 * MiB;
constexpr size_t OFF_U5 = 320 * MiB;
constexpr size_t OFF_ZA = 400 * MiB;
constexpr size_t OFF_ZB = 464 * MiB;
constexpr size_t OFF_QN = 528 * MiB;
constexpr size_t OFF_KN = 592 * MiB;
constexpr size_t OFF_VN = 656 * MiB;
constexpr size_t OFF_YAB = 528 * MiB;
constexpr size_t OFF_MY = 720 * MiB;
constexpr size_t OFF_MS = 800 * MiB;
constexpr size_t OFF_KTT = 816 * MiB;
constexpr size_t OFF_WINT = 944 * MiB;
constexpr size_t OFF_GLUWT = 952 * MiB;
constexpr size_t OFF_WOUTT = 953 * MiB;
constexpr size_t OFF_BA = 955 * MiB;
constexpr size_t OFF_GC = 959 * MiB;
constexpr size_t OFF_KTAB = 961 * MiB;
constexpr size_t OFF_PW = 965 * MiB;
constexpr size_t OFF_FB = 968 * MiB;
constexpr size_t OFF_MOD = 969 * MiB;
constexpr size_t OFF_CTR = 969 * MiB + 512 * 1024;
constexpr size_t WS_END = 970 * MiB;

struct Params {
  const float *x, *c, *ada_w, *ada_b, *norm_w, *w_in, *conv_w;
  const float *a_log[2], *dt_bias[2], *dn_norm_w;
  const float *lam_re[2], *lam_im[2], *log_step[2], *b_re[2], *b_im[2], *c_re[2], *c_im[2];
  const float *s5_d, *glu_w, *glu_b, *w_out, *final_norm_w;
  float* out;
  char* ws;
  int p_lo, p_hi;
};

DI unsigned pk2(float a, float b) { f32x2 v = {a, b}; bf2_t r = __builtin_convertvector(v, bf2_t); return __builtin_bit_cast(unsigned, r); }
DI bf16_t f2bf(float a) { return (bf16_t)(pk2(a, 0.f) & 0xffffu); }
DI float bf2f(bf16_t v) { return __uint_as_float(((unsigned)v) << 16); }
DI float bflo(unsigned u) { return __uint_as_float(u << 16); }
DI float bfhi(unsigned u) { return __uint_as_float(u & 0xffff0000u); }
DI float sigmoidf_(float x) { return 1.f / (1.f + __expf(-x)); }
DI float siluf_(float x) { return x / (1.f + __expf(-x)); }
DI float gelu_tanh(float x) { float u = 0.7978845608028654f * (x + 0.044715f * x * x * x); float e = __expf(2.f * u); float t = 1.f - 2.f / (e + 1.f); return 0.5f * x * (1.f + t); }
DI float softplusf_(float x) { return x > 15.f ? x : log1pf(expf(x)); }
DI float wave_sum(float v) {
#pragma unroll
  for (int o = 1; o < 64; o <<= 1) v += __shfl_xor(v, o);
  return v;
}
DI void lds_barrier() { asm volatile("s_waitcnt lgkmcnt(0)" ::: "memory"); __builtin_amdgcn_s_barrier(); asm volatile("" ::: "memory"); }
typedef unsigned long long u64_t;
DI u64_t ld8_pinned(const void* p) { return __hip_atomic_load((const u64_t*)p, __ATOMIC_RELAXED, __HIP_MEMORY_SCOPE_WORKGROUP); }
DI float ld4_pinned(const void* p) { return __builtin_bit_cast(float, __hip_atomic_load((const unsigned*)p, __ATOMIC_RELAXED, __HIP_MEMORY_SCOPE_WORKGROUP)); }
DI int crow(int reg, int h) { return (reg & 3) + 8 * (reg >> 2) + 4 * h; }
DI bf16x8 pack8(const f32x16& x, int s) {
  u32x4 p;
  p[0] = pk2(x[8 * s + 0], x[8 * s + 1]); p[1] = pk2(x[8 * s + 2], x[8 * s + 3]);
  p[2] = pk2(x[8 * s + 4], x[8 * s + 5]); p[3] = pk2(x[8 * s + 6], x[8 * s + 7]);
  return __builtin_bit_cast(bf16x8, p);
}
DI bf16x8 ldfrag(const bf16_t* base, int row, int stride, int col) {
  const bf16_t* p = base + row * stride + col;
  u32x2 lo = *(const u32x2*)p, hi = *(const u32x2*)(p + 8);
  u32x4 v = {lo[0], lo[1], hi[0], hi[1]};
  return __builtin_bit_cast(bf16x8, v);
}
#define MFMA32(a, b, c) __builtin_amdgcn_mfma_f32_32x32x16_bf16((a), (b), (c), 0, 0, 0)
#define MFMA16(a, b, c) __builtin_amdgcn_mfma_f32_16x16x32_bf16((a), (b), (c), 0, 0, 0)

constexpr int G_HTB = 128 * 64 * 2;
DI int lds_byte(int r, int c) { const int st = (r >> 4) * 2 + (c >> 5), rr = r & 15, cc = c & 31, ob = rr * 64 + cc * 2; return st * 1024 + (ob ^ (((ob >> 9) & 1) << 5)); }
DI void stage_rc(int b, int& R, int& C) { const int st = b / 1024, sb = b % 1024, swz = sb ^ (((sb >> 9) & 1) << 5); R = (st >> 1) * 16 + swz / 64; C = (st & 1) * 32 + (swz % 64) / 2; }
template <bool TRANS, bool PERM = false>
DI void gemm256(const bf16_t* __restrict__ A, int lda, const bf16_t* __restrict__ Bt, int ldb, int K, LAS unsigned char* lds, f32x4 (&acc)[2][2][4][2]) {
  const int tid = threadIdx.x, wid = __builtin_amdgcn_readfirstlane(tid >> 6), lane = tid & 63, wr = wid >> 2, wc = wid & 3, fr = lane & 15, fq = lane >> 4;
  unsigned voffA[2], voffB[2];
#pragma unroll
  for (int i = 0; i < 2; ++i) {
    int R, C; stage_rc(tid * 16 + i * 8192, R, C);
    const int Rb = PERM ? ((R & ~31) + 8 * ((R & 15) >> 2) + 4 * ((R >> 4) & 1) + (R & 3)) : R;
    voffA[i] = (unsigned)(R * lda + C) * 2u; voffB[i] = (unsigned)(Rb * ldb + C) * 2u;
  }
  const unsigned ldsw = (unsigned)wid * 1024u;
  const int aoff = lds_byte(wr * 64 + fr, fq * 8), boff = lds_byte(wc * 32 + fr, fq * 8);
  const char* cA0 = (const char*)A; const char* cA1 = cA0 + (size_t)128 * lda * 2;
  const char* cB0 = (const char*)Bt; const char* cB1 = cB0 + (size_t)128 * ldb * 2;
#define G_SA(b, h) (((b) * 2 + (h)) * G_HTB)
#define G_SB(b, h) ((4 + (b) * 2 + (h)) * G_HTB)
#define G_STAGE(bufoff, gbase, voff, kt) do { _Pragma("unroll") for (int _i = 0; _i < 2; ++_i) \
    __builtin_amdgcn_global_load_lds((const unsigned*)((gbase) + (size_t)(kt) * 128 + (voff)[_i]), (LAS unsigned*)(lds + (bufoff) + ldsw + _i * 8192), 16, 0, 0); } while (0)
#define G_LDA(dst, b, h) do { _Pragma("unroll") for (int m = 0; m < 4; ++m) _Pragma("unroll") for (int k = 0; k < 2; ++k) dst[m][k] = *(const LAS bf16x8*)(lds + G_SA(b, h) + aoff + m * 2048 + k * 1024); } while (0)
#define G_LDB(dst, b, h) do { _Pragma("unroll") for (int n = 0; n < 2; ++n) _Pragma("unroll") for (int k = 0; k < 2; ++k) dst[n][k] = *(const LAS bf16x8*)(lds + G_SB(b, h) + boff + n * 2048 + k * 1024); } while (0)
#define G_MMA(ai, bj, At_, Bt_) do { __builtin_amdgcn_s_setprio(1); _Pragma("unroll") for (int m = 0; m < 4; ++m) _Pragma("unroll") for (int n = 0; n < 2; ++n) _Pragma("unroll") for (int k = 0; k < 2; ++k) \
    acc[ai][bj][m][n] = TRANS ? MFMA16(Bt_[n][k], At_[m][k], acc[ai][bj][m][n]) : MFMA16(At_[m][k], Bt_[n][k], acc[ai][bj][m][n]); __builtin_amdgcn_s_setprio(0); } while (0)
#define G_WAIT_V(n) asm volatile("s_waitcnt vmcnt(" #n ")" ::: "memory")
#define G_WAIT_L(n) asm volatile("s_waitcnt lgkmcnt(" #n ")" ::: "memory")
#define G_BAR __builtin_amdgcn_s_barrier()
#define G_SCHED __builtin_amdgcn_sched_barrier(0)
#pragma unroll
  for (int a = 0; a < 2; ++a)
#pragma unroll
    for (int b = 0; b < 2; ++b)
#pragma unroll
      for (int m = 0; m < 4; ++m)
#pragma unroll
        for (int n = 0; n < 2; ++n) acc[a][b][m][n] = f32x4{0.f, 0.f, 0.f, 0.f};
  bf16x8 At[4][2], B0[2][2], B1[2][2];
  const int nt = K / 64;
  G_WAIT_V(0); G_WAIT_L(0); G_BAR;
  G_STAGE(G_SB(0, 0), cB0, voffB, 0); G_STAGE(G_SA(0, 0), cA0, voffA, 0);
  G_STAGE(G_SB(0, 1), cB1, voffB, 0); G_STAGE(G_SA(0, 1), cA1, voffA, 0);
  if (wr == 1) G_BAR;
  G_WAIT_V(4); G_BAR;
  G_STAGE(G_SB(1, 0), cB0, voffB, 1); G_STAGE(G_SA(1, 0), cA0, voffA, 1); G_STAGE(G_SB(1, 1), cB1, voffB, 1);
  G_WAIT_V(6); G_BAR;
  for (int t = 0; t < nt - 2; t += 2) {
    G_LDB(B0, 0, 0); G_SCHED; G_LDA(At, 0, 0); G_STAGE(G_SA(1, 1), cA1, voffA, t + 1);
    G_WAIT_L(8); G_BAR; G_WAIT_L(0); G_MMA(0, 0, At, B0); G_BAR; G_SCHED;
    G_LDB(B1, 0, 1); G_STAGE(G_SB(0, 0), cB0, voffB, t + 2);
    G_BAR; G_WAIT_L(0); G_MMA(0, 1, At, B1); G_BAR;
    G_LDA(At, 0, 1); G_STAGE(G_SA(0, 0), cA0, voffA, t + 2);
    G_BAR; G_WAIT_L(0); G_MMA(1, 0, At, B0); G_BAR; G_SCHED;
    G_STAGE(G_SB(0, 1), cB1, voffB, t + 2);
    G_WAIT_V(6); G_BAR; G_MMA(1, 1, At, B1); G_BAR;
    G_LDB(B0, 1, 0); G_SCHED; G_LDA(At, 1, 0); G_STAGE(G_SA(0, 1), cA1, voffA, t + 2);
    G_WAIT_L(8); G_BAR; G_WAIT_L(0); G_MMA(0, 0, At, B0); G_BAR; G_SCHED;
    G_LDB(B1, 1, 1); G_STAGE(G_SB(1, 0), cB0, voffB, t + 3);
    G_BAR; G_WAIT_L(0); G_MMA(0, 1, At, B1); G_BAR;
    G_LDA(At, 1, 1); G_STAGE(G_SA(1, 0), cA0, voffA, t + 3);
    G_BAR; G_WAIT_L(0); G_MMA(1, 0, At, B0); G_BAR; G_SCHED;
    G_STAGE(G_SB(1, 1), cB1, voffB, t + 3);
    G_WAIT_V(6); G_BAR; G_MMA(1, 1, At, B1); G_BAR;
  }
  { G_LDB(B0, 0, 0); G_LDA(At, 0, 0); G_STAGE(G_SA(1, 1), cA1, voffA, nt - 1);
    G_BAR; G_WAIT_L(0); G_MMA(0, 0, At, B0); G_BAR;
    G_LDB(B1, 0, 1); G_BAR; G_WAIT_L(0); G_MMA(0, 1, At, B1); G_BAR;
    G_LDA(At, 0, 1); G_WAIT_V(4); G_BAR; G_WAIT_L(0); G_MMA(1, 0, At, B0); G_MMA(1, 1, At, B1); G_BAR; }
  { G_LDB(B0, 1, 0); G_LDA(At, 1, 0); G_WAIT_V(2); G_BAR; G_WAIT_L(0); G_MMA(0, 0, At, B0); G_BAR;
    G_LDB(B1, 1, 1); G_WAIT_V(0); G_BAR; G_WAIT_L(0); G_MMA(0, 1, At, B1); G_BAR;
    G_LDA(At, 1, 1); G_BAR; G_WAIT_L(0); G_MMA(1, 0, At, B0); G_MMA(1, 1, At, B1); G_BAR; }
  if (wr == 0) G_BAR;
}

template <bool TRANS, bool PERM, class TileFn, class EpiFn>
DI void gemm256_stream(int nj, int nt, int lda, int ldb, TileFn tilefn, EpiFn epifn, LAS unsigned char* lds) {
  if (nj <= 0) return;
  const int tid = threadIdx.x, wid = __builtin_amdgcn_readfirstlane(tid >> 6), lane = tid & 63, wr = wid >> 2, wc = wid & 3, fr = lane & 15, fq = lane >> 4;
  unsigned voffA[2], voffB[2];
#pragma unroll
  for (int i = 0; i < 2; ++i) {
    int R, C; stage_rc(tid * 16 + i * 8192, R, C);
    const int Rb = PERM ? ((R & ~31) + 8 * ((R & 15) >> 2) + 4 * ((R >> 4) & 1) + (R & 3)) : R;
    voffA[i] = (unsigned)(R * lda + C) * 2u; voffB[i] = (unsigned)(Rb * ldb + C) * 2u;
  }
  const unsigned ldsw = (unsigned)wid * 1024u;
  const int aoff = lds_byte(wr * 64 + fr, fq * 8), boff = lds_byte(wc * 32 + fr, fq * 8);
  const size_t hA = (size_t)128 * lda * 2, hB = (size_t)128 * ldb * 2;
  const char *cA, *cB, *nA, *nB;
  { const bf16_t *a, *b; tilefn(0, a, b); cA = (const char*)a; cB = (const char*)b; nA = cA; nB = cB; if (nj > 1) { tilefn(1, a, b); nA = (const char*)a; nB = (const char*)b; } }
  int j = 0, tbeg = 0, tend = nt;
#define GS_A(g, h) (((g) < tend ? cA + (size_t)((g) - tbeg) * 128 : nA + (size_t)((g) - tend) * 128) + (h) * hA)
#define GS_B(g, h) (((g) < tend ? cB + (size_t)((g) - tbeg) * 128 : nB + (size_t)((g) - tend) * 128) + (h) * hB)
#define GS_STAGE(bufoff, gptr, voff) do { const char* _p = (gptr); _Pragma("unroll") for (int _i = 0; _i < 2; ++_i) \
    __builtin_amdgcn_global_load_lds((const unsigned*)(_p + (voff)[_i]), (LAS unsigned*)(lds + (bufoff) + ldsw + _i * 8192), 16, 0, 0); } while (0)
  f32x4 acc[2][2][4][2];
#pragma unroll
  for (int a = 0; a < 2; ++a)
#pragma unroll
    for (int b = 0; b < 2; ++b)
#pragma unroll
      for (int m = 0; m < 4; ++m)
#pragma unroll
        for (int n = 0; n < 2; ++n) acc[a][b][m][n] = f32x4{0.f, 0.f, 0.f, 0.f};
  bf16x8 At[4][2], B0[2][2], B1[2][2];
  const int total = nj * nt;
  G_WAIT_V(0); G_WAIT_L(0); G_BAR;
  GS_STAGE(G_SB(0, 0), GS_B(0, 0), voffB); GS_STAGE(G_SA(0, 0), GS_A(0, 0), voffA);
  GS_STAGE(G_SB(0, 1), GS_B(0, 1), voffB); GS_STAGE(G_SA(0, 1), GS_A(0, 1), voffA);
  if (wr == 1) G_BAR;
  G_WAIT_V(4); G_BAR;
  GS_STAGE(G_SB(1, 0), GS_B(1, 0), voffB); GS_STAGE(G_SA(1, 0), GS_A(1, 0), voffA); GS_STAGE(G_SB(1, 1), GS_B(1, 1), voffB);
  G_WAIT_V(6); G_BAR;
  for (int t = 0; t < total - 2; t += 2) {
    G_LDB(B0, 0, 0); G_SCHED; G_LDA(At, 0, 0); GS_STAGE(G_SA(1, 1), GS_A(t + 1, 1), voffA);
    G_WAIT_L(8); G_BAR; G_WAIT_L(0); G_MMA(0, 0, At, B0); G_BAR; G_SCHED;
    G_LDB(B1, 0, 1); GS_STAGE(G_SB(0, 0), GS_B(t + 2, 0), voffB);
    G_BAR; G_WAIT_L(0); G_MMA(0, 1, At, B1); G_BAR;
    G_LDA(At, 0, 1); GS_STAGE(G_SA(0, 0), GS_A(t + 2, 0), voffA);
    G_BAR; G_WAIT_L(0); G_MMA(1, 0, At, B0); G_BAR; G_SCHED;
    GS_STAGE(G_SB(0, 1), GS_B(t + 2, 1), voffB);
    G_WAIT_V(6); G_BAR; G_MMA(1, 1, At, B1); G_BAR;
    G_LDB(B0, 1, 0); G_SCHED; G_LDA(At, 1, 0); GS_STAGE(G_SA(0, 1), GS_A(t + 2, 1), voffA);
    G_WAIT_L(8); G_BAR; G_WAIT_L(0); G_MMA(0, 0, At, B0); G_BAR; G_SCHED;
    G_LDB(B1, 1, 1); GS_STAGE(G_SB(1, 0), GS_B(t + 3, 0), voffB);
    G_BAR; G_WAIT_L(0); G_MMA(0, 1, At, B1); G_BAR;
    G_LDA(At, 1, 1); GS_STAGE(G_SA(1, 0), GS_A(t + 3, 0), voffA);
    G_BAR; G_WAIT_L(0); G_MMA(1, 0, At, B0); G_BAR; G_SCHED;
    GS_STAGE(G_SB(1, 1), GS_B(t + 3, 1), voffB);
    G_WAIT_V(6); G_BAR; G_MMA(1, 1, At, B1); G_BAR;
    if (t + 2 == tend) {
      epifn(j, acc);
#pragma unroll
      for (int a = 0; a < 2; ++a)
#pragma unroll
        for (int b = 0; b < 2; ++b)
#pragma unroll
          for (int m = 0; m < 4; ++m)
#pragma unroll
            for (int n = 0; n < 2; ++n) acc[a][b][m][n] = f32x4{0.f, 0.f, 0.f, 0.f};
      ++j; tbeg = tend; tend += nt; cA = nA; cB = nB;
      if (j + 1 < nj) { const bf16_t *a, *b; tilefn(j + 1, a, b); nA = (const char*)a; nB = (const char*)b; }
    }
  }
  { G_LDB(B0, 0, 0); G_LDA(At, 0, 0); GS_STAGE(G_SA(1, 1), GS_A(total - 1, 1), voffA);
    G_BAR; G_WAIT_L(0); G_MMA(0, 0, At, B0); G_BAR;
    G_LDB(B1, 0, 1); G_BAR; G_WAIT_L(0); G_MMA(0, 1, At, B1); G_BAR;
    G_LDA(At, 0, 1); G_WAIT_V(4); G_BAR; G_WAIT_L(0); G_MMA(1, 0, At, B0); G_MMA(1, 1, At, B1); G_BAR; }
  { G_LDB(B0, 1, 0); G_LDA(At, 1, 0); G_WAIT_V(2); G_BAR; G_WAIT_L(0); G_MMA(0, 0, At, B0); G_BAR;
    G_LDB(B1, 1, 1); G_WAIT_V(0); G_BAR; G_WAIT_L(0); G_MMA(0, 1, At, B1); G_BAR;
    G_LDA(At, 1, 1); G_BAR; G_WAIT_L(0); G_MMA(1, 0, At, B0); G_MMA(1, 1, At, B1); G_BAR; }
  if (wr == 0) G_BAR;
  epifn(j, acc);
}

DI void p0_mod_item(const Params& P, char* smem, int it) {
  float* ssil = (float*)smem;
  float* sred = ssil + 16 * 1024;
  const int tid = threadIdx.x, cl = tid & 31, ks = tid >> 5, col = it * 32 + cl;
  __syncthreads();
  for (int e = tid; e < 16 * 1024; e += NTHR) ssil[e] = siluf_(P.c[e]);
  __syncthreads();
  float acc[16];
#pragma unroll
  for (int b = 0; b < 16; ++b) acc[b] = 0.f;
#pragma unroll 1
  for (int k0 = ks * 64; k0 < ks * 64 + 64; k0 += 16) {
    float w[16];
#pragma unroll
    for (int u = 0; u < 16; ++u) w[u] = P.ada_w[(size_t)(k0 + u) * 3072 + col];
#pragma unroll
    for (int u = 0; u < 16; ++u)
#pragma unroll
      for (int b = 0; b < 16; ++b) acc[b] += ssil[b * 1024 + k0 + u] * w[u];
  }
#pragma unroll
  for (int b = 0; b < 16; ++b) sred[(ks * 16 + b) * 32 + cl] = acc[b];
  __syncthreads();
  {
    const int b = tid >> 5;
    float s = P.ada_b[col];
#pragma unroll
    for (int k2 = 0; k2 < 16; ++k2) s += sred[(k2 * 16 + b) * 32 + cl];
    ((float*)(P.ws + OFF_MOD))[b * 3072 + col] = s;
  }
}
DI void p0_transpose_item(const float* __restrict__ src, int N, int K, int k0, int srcn0, int nvalid, bf16_t* __restrict__ dst, int dstn0, float* s, int tid) {
  const int n = tid & 31, kr = tid >> 5;
#pragma unroll
  for (int i = 0; i < 8; ++i) { const int k = kr + 8 * i; s[k * 33 + n] = (n < nvalid) ? src[(size_t)(k0 + k) * N + srcn0 + n] : 0.f; }
  __syncthreads();
  const int on = tid >> 3, kc = tid & 7;
  u32x4 o;
  o[0] = pk2(s[(kc * 8 + 0) * 33 + on], s[(kc * 8 + 1) * 33 + on]); o[1] = pk2(s[(kc * 8 + 2) * 33 + on], s[(kc * 8 + 3) * 33 + on]);
  o[2] = pk2(s[(kc * 8 + 4) * 33 + on], s[(kc * 8 + 5) * 33 + on]); o[3] = pk2(s[(kc * 8 + 6) * 33 + on], s[(kc * 8 + 7) * 33 + on]);
  *(u32x4*)(dst + (size_t)(dstn0 + on) * K + k0 + kc * 8) = o;
  __syncthreads();
}
DI void s5_lambda(const Params& P, int g, int dir, int n, float& dt, float& lr, float& li) {
  dt = expf(P.log_step[dir][g]); lr = P.lam_re[dir][g * 64 + n]; li = P.lam_im[dir][g * 64 + n];
}
DI void cpow(float dt, float lr, float li, float e, float& re, float& im) {
  const float mag = __expf(lr * dt * e), x = li * dt * e;
  const float n = rintf(x * 0.15915494309189535f);
  const float y = fmaf(n, -6.2831854820251465f, x) + n * 1.7484556000744883e-7f;
  re = mag * __cosf(y); im = mag * __sinf(y);
}
DI void s5_f(float dt, float lr, float li, float& fre, float& fim) {
  float ar, ai; cpow(dt, lr, li, 1.f, ar, ai);
  const float nr = ar - 1.f, ni = ai, den = lr * lr + li * li;
  fre = (nr * lr + ni * li) / den; fim = (ni * lr - nr * li) / den;
}
DI void p0_ktab_item(const Params& P, float* sm, int it, int tid) {
  const int tau = it & 63, dir = (it >> 6) & 1, g = it >> 7;
  float* sw = sm;
  float* sG = sw + 128;
  float* sC = sG + 2048;
  if (tid < 64) {
    float dt, lr, li; s5_lambda(P, g, dir, tid, dt, lr, li);
    float fr_, fi_, ar, ai; s5_f(dt, lr, li, fr_, fi_); cpow(dt, lr, li, (float)tau, ar, ai);
    sw[tid * 2] = fr_ * ar - fi_ * ai; sw[tid * 2 + 1] = fr_ * ai + fi_ * ar;
  }
  for (int e = tid; e < 1024; e += 256) { sC[e * 2] = P.c_re[dir][g * 1024 + e]; sC[e * 2 + 1] = P.c_im[dir][g * 1024 + e]; }
  __syncthreads();
  for (int e = tid; e < 1024; e += 256) {
    const int n = e >> 4;
    const float br = P.b_re[dir][g * 1024 + e], bi = P.b_im[dir][g * 1024 + e], wr_ = sw[n * 2], wi_ = sw[n * 2 + 1];
    sG[e * 2] = wr_ * br - wi_ * bi; sG[e * 2 + 1] = wr_ * bi + wi_ * br;
  }
  __syncthreads();
  const int p = tid >> 4, q = tid & 15;
  float acc = 0.f;
  for (int n = 0; n < 64; ++n) acc += sC[(p * 64 + n) * 2] * sG[(n * 16 + q) * 2] - sC[(p * 64 + n) * 2 + 1] * sG[(n * 16 + q) * 2 + 1];
  ((float*)(P.ws + OFF_KTAB))[(size_t)it * 256 + tid] = acc;
  __syncthreads();
}
DI void phase0(const Params& P, char* smem) {
  const int bid = blockIdx.x, nb = gridDim.x, tid = threadIdx.x, hb = tid >> 8, t2 = tid & 255;
  {
    f32x2* PW = (f32x2*)(P.ws + OFF_PW); f32x2* FB = (f32x2*)(P.ws + OFF_FB);
    const int total = 32 * 2 * 65 * 64;
    for (int e = bid * NTHR + tid; e < total; e += nb * NTHR) {
      const int n = e & 63, ex = (e >> 6) % 65, gd = (e >> 6) / 65, dir = gd & 1, g = gd >> 1;
      float dt, lr, li; s5_lambda(P, g, dir, n, dt, lr, li);
      float re, im; cpow(dt, lr, li, (float)ex, re, im);
      PW[e] = f32x2{re, im};
      if (ex == 0) { float fr_, fi_; s5_f(dt, lr, li, fr_, fi_); FB[gd * 64 + n] = f32x2{fr_, fi_}; }
    }
  }
  if (bid == 0 && tid < 16) ((unsigned*)(P.ws + OFF_CTR))[tid] = 0u;
  for (int it = bid; it < 96; it += nb) p0_mod_item(P, smem, it);
  __syncthreads();
  constexpr int I1 = 1664, I2 = 256, I3 = 512;
  float* str = (float*)smem + hb * (64 * 33);
  for (int it = bid * 2 + hb; it < I1 + I2 + I3; it += nb * 2) {
    int r = it;
    if (r < I1) {
      const int kb = r / 104, nt = r % 104, n0 = nt * 32; int nvalid = INC - n0; nvalid = nvalid < 0 ? 0 : (nvalid > 32 ? 32 : nvalid);
      p0_transpose_item(P.w_in, INC, DM, kb * 64, n0, nvalid, (bf16_t*)(P.ws + OFF_WINT), n0, str, t2); continue;
    } r -= I1;
    if (r < I2) {
      const int kb = r / 32, nt = r % 32, n0 = nt * 32, t = n0 >> 8, i = n0 & 255;
      const int src0 = (i < 128) ? t * 128 + i : 512 + t * 128 + (i - 128);
      p0_transpose_item(P.glu_w, 1024, 512, kb * 64, src0, 32, (bf16_t*)(P.ws + OFF_GLUWT), n0, str, t2); continue;
    } r -= I2;
    { const int kb = r / 32, nt = r % 32; p0_transpose_item(P.w_out, 1024, 1024, kb * 64, nt * 32, 32, (bf16_t*)(P.ws + OFF_WOUTT), nt * 32, str, t2); }
  }
  __syncthreads();
  float* skt = (float*)smem + hb * 4352;
  for (int it = bid * 2 + hb; it < 4096; it += nb * 2) p0_ktab_item(P, skt, it, t2);
}

DI void phase1(const Params& P, char* smem) {
  const int bid = blockIdx.x, nb = gridDim.x, tid = threadIdx.x, lane = tid & 63, wid = tid >> 6;
  const float* mod = (const float*)(P.ws + OFF_MOD);
  bf16_t* hB = (bf16_t*)(P.ws + OFF_HB);
  for (int row0 = (bid * NWV + wid) * 4; row0 < NTOK; row0 += nb * NWV * 4) {
    f32x4 v[4][4];
#pragma unroll
    for (int u = 0; u < 4; ++u) {
      const f32x4* xr = (const f32x4*)(P.x + (size_t)(row0 + u) * DM) + lane;
#pragma unroll
      for (int j = 0; j < 4; ++j) v[u][j] = xr[64 * j];
    }
#pragma unroll
    for (int u = 0; u < 4; ++u) {
      const int row = row0 + u, b = row >> 12;
      float s = 0.f;
#pragma unroll
      for (int j = 0; j < 4; ++j) s += v[u][j][0] * v[u][j][0] + v[u][j][1] * v[u][j][1] + v[u][j][2] * v[u][j][2] + v[u][j][3] * v[u][j][3];
      const float rstd = rsqrtf(wave_sum(s) * (1.f / DM) + 1e-6f);
#pragma unroll
      for (int j = 0; j < 4; ++j) {
        const int col = lane * 4 + 256 * j;
        const f32x4 nw = *(const f32x4*)(P.norm_w + col), sh = *(const f32x4*)(mod + b * 3072 + col), sc = *(const f32x4*)(mod + b * 3072 + 1024 + col);
        float h[4];
#pragma unroll
        for (int e = 0; e < 4; ++e) h[e] = v[u][j][e] * rstd * nw[e] * (1.f + sc[e]) + sh[e];
        u32x2 o = {pk2(h[0], h[1]), pk2(h[2], h[3])};
        *(u32x2*)(hB + (size_t)row * DM + col) = o;
      }
    }
  }
  const float* KT = (const float*)(P.ws + OFF_KTAB);
  const f32x2* PW = (const f32x2*)(P.ws + OFF_PW); const f32x2* FB = (const f32x2*)(P.ws + OFF_FB);
  bf16_t* MY = (bf16_t*)(P.ws + OFF_MY); bf16_t* MS = (bf16_t*)(P.ws + OFF_MS);
  const int totalY = 32 * 1024 * 160;
  for (int e = bid * NTHR + tid; e < totalY; e += nb * NTHR) {
    const int kc = e % 160, row = (e / 160) & 1023, g = e / (160 * 1024), t = row >> 4, p = row & 15;
    float o[8];
    if (kc < 128) {
      const int s = kc >> 1, q0 = (kc & 1) * 8;
      if (t == s) {
        const float* k0 = KT + ((size_t)((g * 2 + 0) * 64 + 0) * 256 + p * 16 + q0); const float* k1 = KT + ((size_t)((g * 2 + 1) * 64 + 0) * 256 + p * 16 + q0);
#pragma unroll
        for (int j = 0; j < 8; ++j) o[j] = k0[j] + k1[j] + ((q0 + j == p) ? P.s5_d[g * 16 + p] : 0.f);
      } else {
        const int dir = t > s ? 0 : 1, tau = t > s ? t - s : s - t;
        const float* k0 = KT + ((size_t)((g * 2 + dir) * 64 + tau) * 256 + p * 16 + q0);
#pragma unroll
        for (int j = 0; j < 8; ++j) o[j] = k0[j];
      }
    } else {
      const int c2 = (kc - 128) * 8, dir = c2 >> 7, part = (c2 >> 6) & 1, n0 = c2 & 63;
      const int ex = dir == 0 ? t + 1 : 64 - t;
#pragma unroll
      for (int j = 0; j < 8; ++j) {
        const int n = n0 + j; const f32x2 a = PW[((g * 2 + dir) * 65 + ex) * 64 + n];
        const float cr = P.c_re[dir][(g * 16 + p) * 64 + n], ci = P.c_im[dir][(g * 16 + p) * 64 + n];
        o[j] = part == 0 ? (cr * a[0] - ci * a[1]) : -(cr * a[1] + ci * a[0]);
      }
    }
    u32x4 ov = {pk2(o[0], o[1]), pk2(o[2], o[3]), pk2(o[4], o[5]), pk2(o[6], o[7])};
    *(u32x4*)(MY + ((size_t)(g * 1024 + row) * 1280 + kc * 8)) = ov;
  }
  const int totalS = 32 * 256 * 128;
  for (int e = bid * NTHR + tid; e < totalS; e += nb * NTHR) {
    const int kc = e & 127, row = (e >> 7) & 255, g = e >> 15, dir = row >> 7, part = (row >> 6) & 1, n = row & 63;
    const int s = kc >> 1, q0 = (kc & 1) * 8, ex = dir == 0 ? 63 - s : s;
    const f32x2 a = PW[((g * 2 + dir) * 65 + ex) * 64 + n], f = FB[(g * 2 + dir) * 64 + n];
    const float wr_ = a[0] * f[0] - a[1] * f[1], wi_ = a[0] * f[1] + a[1] * f[0];
    float o[8];
#pragma unroll
    for (int j = 0; j < 8; ++j) {
      const float br = P.b_re[dir][(g * 64 + n) * 16 + q0 + j], bi = P.b_im[dir][(g * 64 + n) * 16 + q0 + j];
      o[j] = part == 0 ? (wr_ * br - wi_ * bi) : (wr_ * bi + wi_ * br);
    }
    u32x4 ov = {pk2(o[0], o[1]), pk2(o[2], o[3]), pk2(o[4], o[5]), pk2(o[6], o[7])};
    *(u32x4*)(MS + ((size_t)(g * 256 + row) * 1024 + kc * 8)) = ov;
  }
}

DI void phase2(const Params& P, LAS unsigned char* lds) {
  const int tid = threadIdx.x, lane = tid & 63, wid = tid >> 6, wr = wid >> 2, wc = wid & 3, fr = lane & 15, fq = lane >> 4;
  const bf16_t* hB = (const bf16_t*)(P.ws + OFF_HB); const bf16_t* W = (const bf16_t*)(P.ws + OFF_WINT);
  bf16_t* U5 = (bf16_t*)(P.ws + OFF_U5); bf16_t* ZA = (bf16_t*)(P.ws + OFF_ZA); bf16_t* ZB = (bf16_t*)(P.ws + OFF_ZB);
  bf16_t* QKV = (bf16_t*)(P.ws + OFF_QKVRAW); float* BA = (float*)(P.ws + OFF_BA);
  constexpr int NT = 13, NTILES = 256 * NT;
  const int bid = blockIdx.x, nbk = gridDim.x, nj = bid < NTILES ? (NTILES - bid + nbk - 1) / nbk : 0;
  auto tile_of = [&](int j, int& tm, int& tn) { const int id = bid + j * nbk, grp = id / (8 * NT), ig = id % (8 * NT); tm = grp * 8 + (ig & 7); tn = ig >> 3; };
  gemm256_stream<true, true>(nj, DM / 64, DM, DM,
    [&](int j, const bf16_t*& A, const bf16_t*& Bt) { int tm, tn; tile_of(j, tm, tn); A = hB + (size_t)tm * 256 * DM; Bt = W + (size_t)tn * 256 * DM; },
    [&](int j, f32x4 (&acc)[2][2][4][2]) {
      int tm, tn; tile_of(j, tm, tn);
#pragma unroll
      for (int ai = 0; ai < 2; ++ai)
#pragma unroll
        for (int m = 0; m < 4; ++m) {
          const int t = tm * 256 + ai * 128 + wr * 64 + m * 16 + fr;
#pragma unroll
          for (int bj = 0; bj < 2; ++bj) {
            const int col = tn * 256 + bj * 128 + wc * 32 + fq * 8;
            const f32x4 v0 = acc[ai][bj][m][0], v1 = acc[ai][bj][m][1];
            if (tn == 12) { if (col < INC) { *(f32x4*)(BA + (size_t)t * 16 + (col - 3072)) = v0; *(f32x4*)(BA + (size_t)t * 16 + (col - 3072) + 4) = v1; } continue; }
            const u32x4 o = {pk2(v0[0], v0[1]), pk2(v0[2], v0[3]), pk2(v1[0], v1[1]), pk2(v1[2], v1[3])};
            if (tn < 2) { const int g = col >> 4, q = col & 15; *(u32x4*)(U5 + ((size_t)(g * 1024 + (t >> 6)) * 1280 + (t & 63) * 16 + q)) = o; }
            else if (tn < 4) *(u32x4*)(ZA + (size_t)t * 512 + (col - 512)) = o;
            else if (tn < 10) *(u32x4*)(QKV + (size_t)t * 1536 + (col - 1024)) = o;
            else *(u32x4*)(ZB + (size_t)t * 512 + (col - 2560)) = o;
          }
        }
    }, lds);
}

DI void phase3(const Params& P, LAS unsigned char* lds) {
  const int tid = threadIdx.x, lane = tid & 63, wid = tid >> 6, wr = wid >> 2, wc = wid & 3, fr = lane & 15, fq = lane >> 4;
  const bf16_t* MS = (const bf16_t*)(P.ws + OFF_MS); const bf16_t* U5 = (const bf16_t*)(P.ws + OFF_U5);
  float* SC = P.out;
  const int nrep3a_ = (REP_PHASE == 30) ? P.p_hi - 7 : 1;
  for (int rep3a_ = 0; rep3a_ < nrep3a_; ++rep3a_)
  for (int id = blockIdx.x; id < 128; id += gridDim.x) {
    const int g = id >> 2, tn = id & 3;
    f32x4 acc[2][2][4][2];
    gemm256<false>(MS + (size_t)(g * 256) * 1024, 1024, U5 + (size_t)(g * 1024 + tn * 256) * 1280, 1280, 1024, lds, acc);
#pragma unroll
    for (int ai = 0; ai < 2; ++ai)
#pragma unroll
      for (int bj = 0; bj < 2; ++bj)
#pragma unroll
        for (int m = 0; m < 4; ++m)
#pragma unroll
          for (int n = 0; n < 2; ++n) {
            const int row0 = ai * 128 + wr * 64 + m * 16 + fq * 4, col = tn * 256 + bj * 128 + wc * 32 + n * 16 + fr;
            *(f32x4*)(SC + ((size_t)(g * 1024 + col) * 256 + row0)) = acc[ai][bj][m][n];
          }
  }
  const bf16_t* QKV = (const bf16_t*)(P.ws + OFF_QKVRAW);
  const int nbk = gridDim.x, vb = (blockIdx.x + nbk - (128 % nbk)) % nbk;
  const int nrep3b_ = (REP_PHASE == 31) ? P.p_hi - 7 : 1;
  for (int rep3b_ = 0; rep3b_ < nrep3b_; ++rep3b_)
  for (int it = vb * NWV + wid; it < 16 * 128 * 3; it += nbk * NWV) {
    const int part = it % 3, c = (it / 3) & 127, b = it / (3 * 128), h = lane >> 4;
    const int colq = part * 512 + lane * 8;
    float wt[5][8];
#pragma unroll
    for (int k = 0; k < 5; ++k) {
      const f32x4 wa = *(const f32x4*)(P.conv_w + k * 1536 + colq), wb = *(const f32x4*)(P.conv_w + k * 1536 + colq + 4);
#pragma unroll
      for (int e = 0; e < 4; ++e) { wt[k][e] = wa[e]; wt[k][4 + e] = wb[e]; }
    }
    bf16_t* dst = (bf16_t*)(P.ws + (part == 0 ? OFF_QN : part == 1 ? OFF_KN : OFF_VN)) + (size_t)(b * 4 + h) * SEQ * 128 + (lane & 15) * 8;
    const int l0 = c * 32;
#pragma unroll 1
    for (int i0 = 0; i0 < 32; i0 += 8) {
      u32x4 u[12];
#pragma unroll
      for (int k = 0; k < 12; ++k) {
        const int l = l0 + i0 - 2 + k;
        u[k] = (l >= 0 && l < SEQ) ? *(const u32x4*)(QKV + (size_t)(b * SEQ + l) * 1536 + colq) : u32x4{0u, 0u, 0u, 0u};
      }
#pragma unroll
      for (int i = 0; i < 8; ++i) {
        float y[8];
#pragma unroll
        for (int e = 0; e < 8; ++e) y[e] = 0.f;
#pragma unroll
        for (int k = 0; k < 5; ++k)
#pragma unroll
          for (int e = 0; e < 4; ++e) { y[2 * e] += wt[k][2 * e] * bflo(u[i + k][e]); y[2 * e + 1] += wt[k][2 * e + 1] * bfhi(u[i + k][e]); }
        float ss = 0.f;
#pragma unroll
        for (int e = 0; e < 8; ++e) { y[e] = siluf_(y[e]); ss += y[e] * y[e]; }
        if (part < 2) {
#pragma unroll
          for (int o = 1; o < 16; o <<= 1) ss += __shfl_xor(ss, o);
          float sc = rsqrtf(ss + 1e-6f); if (part == 0) sc *= 0.08838834764831845f;
#pragma unroll
          for (int e = 0; e < 8; ++e) y[e] *= sc;
        }
        *(u32x4*)(dst + (size_t)(l0 + i0 + i) * 128) = u32x4{pk2(y[0], y[1]), pk2(y[2], y[3]), pk2(y[4], y[5]), pk2(y[6], y[7])};
      }
    }
  }
}

struct PrepIn { u32x4 k[4], q[4], v[4]; float be, al; };
DI void dn_prep_issue(const Params& P, PrepIn& I, int item, int tid) {
  const int cc = item & 63, hd = (item >> 6) & 7, b = item >> 9, dir = hd >> 2, h = hd & 3;
  const size_t base = (size_t)(b * 4 + h) * SEQ * 128;
  const bf16_t* Qn = (const bf16_t*)(P.ws + OFF_QN) + base; const bf16_t* Kn = (const bf16_t*)(P.ws + OFF_KN) + base; const bf16_t* Vn = (const bf16_t*)(P.ws + OFF_VN) + base;
#pragma unroll
  for (int k = 0; k < 4; ++k) {
    const int idx = tid + 256 * k, row = idx >> 4, ch = idx & 15, p = cc * 64 + row, l = dir ? (SEQ - 1 - p) : p;
    I.k[k] = *(const u32x4*)(Kn + (size_t)l * 128 + ch * 8); I.q[k] = *(const u32x4*)(Qn + (size_t)l * 128 + ch * 8); I.v[k] = *(const u32x4*)(Vn + (size_t)l * 128 + ch * 8);
  }
  if (tid < 64) {
    const float* BA = (const float*)(P.ws + OFF_BA);
    const int p = cc * 64 + tid, l = dir ? (SEQ - 1 - p) : p; const size_t t = (size_t)b * SEQ + l;
    I.be = BA[t * 16 + dir * 4 + h]; I.al = BA[t * 16 + 8 + dir * 4 + h];
  }
}
DI void dn_prep_loop(const Params& P, char* sm, int first, int stride, int tid) {
  const int lane = tid & 63, w = tid >> 6, r = lane & 31, hh = lane >> 5;
  bf16_t* sK = (bf16_t*)sm;
  bf16_t* sQ = sK + 64 * 132;
  bf16_t* sRv = sQ;
  bf16_t* sLm = sQ + 128 * 68;
  bf16_t* sTt = sLm + 64 * 68;
  bf16_t* sRk = sLm;
  bf16_t* sT = sTt + 64 * 68;
  float* sg = (float*)(sT + 64 * 68);
  float* sbeta = sg + 64;
  float* seg = sbeta + 64;
  bf16_t* sV = (bf16_t*)(seg + 64);
  float* GC = (float*)(P.ws + OFF_GC);
  PrepIn I;
  if (first < 8192) dn_prep_issue(P, I, first, tid);
  for (int item = first; item < 8192; item += stride) {
  const int cc = item & 63, hd = (item >> 6) & 7, dir = hd >> 2, h = hd & 3;
  lds_barrier();
#pragma unroll
  for (int k = 0; k < 4; ++k) {
    const int idx = tid + 256 * k, row = idx >> 4, ch = idx & 15;
    *(u32x2*)(sK + row * 132 + ch * 8) = u32x2{I.k[k][0], I.k[k][1]}; *(u32x2*)(sK + row * 132 + ch * 8 + 4) = u32x2{I.k[k][2], I.k[k][3]};
    *(u32x2*)(sQ + row * 132 + ch * 8) = u32x2{I.q[k][0], I.q[k][1]}; *(u32x2*)(sQ + row * 132 + ch * 8 + 4) = u32x2{I.q[k][2], I.q[k][3]};
    *(u32x2*)(sV + row * 132 + ch * 8) = u32x2{I.v[k][0], I.v[k][1]}; *(u32x2*)(sV + row * 132 + ch * 8 + 4) = u32x2{I.v[k][2], I.v[k][3]};
  }
  for (int e = tid; e < 64 * 68 / 2; e += 256) { ((unsigned*)sT)[e] = 0u; ((unsigned*)sTt)[e] = 0u; }
  if (tid < 64) {
    const float be = sigmoidf_(I.be);
    const float g = -expf(P.a_log[dir][h]) * softplusf_(I.al + P.dt_bias[dir][h]);
    float gc = g;
#pragma unroll
    for (int o = 1; o < 64; o <<= 1) { const float v = __shfl_up(gc, o); if (lane >= o) gc += v; }
    sg[tid] = gc; sbeta[tid] = be; seg[tid] = expf(gc); GC[(size_t)item * 64 + tid] = gc;
  }
  if (item + stride < 8192) dn_prep_issue(P, I, item + stride, tid);
  lds_barrier();
  {
    const int mi = w >> 1, ni = w & 1;
    f32x16 kk, qk;
#pragma unroll
    for (int i = 0; i < 16; ++i) { kk[i] = 0.f; qk[i] = 0.f; }
#pragma unroll
    for (int ks = 0; ks < 8; ++ks) {
      const bf16x8 bf = ldfrag(sK, 32 * ni + r, 132, 16 * ks + 4 * hh);
      const bf16x8 ak = ldfrag(sK, 32 * mi + r, 132, 16 * ks + 4 * hh);
      const bf16x8 aq = ldfrag(sQ, 32 * mi + r, 132, 16 * ks + 4 * hh);
      kk = MFMA32(ak, bf, kk); qk = MFMA32(aq, bf, qk);
    }
    lds_barrier();
    bf16_t* ATT = (bf16_t*)(P.ws + OFF_ATT) + (size_t)item * 4096;
    const int j = 32 * ni + r; const float gj = sg[j];
#pragma unroll
    for (int reg = 0; reg < 16; ++reg) {
      const int i = 32 * mi + crow(reg, hh);
      const float d = __expf(i >= j ? sg[i] - gj : 0.f);
      sLm[i * 68 + j] = f2bf((i > j) ? sbeta[i] * kk[reg] * d : 0.f);
      for (int rep = 0; rep <= DUPST; ++rep) { ATT[i * 64 + j] = f2bf((i >= j) ? qk[reg] * d : 0.f); asm volatile("" ::: "memory"); }
    }
  }
  lds_barrier();
  if (tid < 64) {
    const int blk = tid >> 4, c = tid & 15;
    float x[16];
#pragma unroll
    for (int i = 0; i < 16; ++i) {
      float a = (i == c) ? 1.f : 0.f;
      const bf16_t* lrow = sLm + (16 * blk + i) * 68 + 16 * blk;
#pragma unroll
      for (int j = 0; j < i; ++j) a -= bf2f(lrow[j]) * x[j];
      x[i] = a;
    }
#pragma unroll
    for (int i = 0; i < 16; ++i) { const bf16_t v = f2bf(x[i]); sT[(16 * blk + i) * 68 + 16 * blk + c] = v; sTt[(16 * blk + c) * 68 + 16 * blk + i] = v; }
  }
  lds_barrier();
  if (w < 2) {
    const int a = w;
    f32x16 X, Y;
#pragma unroll
    for (int i = 0; i < 16; ++i) { X[i] = 0.f; Y[i] = 0.f; }
    {
      bf16x8 A = ldfrag(sLm, 32 * a + r, 68, 32 * a + 4 * hh);
      if (r < 16) A = bf16x8{0, 0, 0, 0, 0, 0, 0, 0};
      X = MFMA32(A, ldfrag(sTt, 32 * a + r, 68, 32 * a + 4 * hh), X);
    }
#pragma unroll
    for (int s = 0; s < 2; ++s) Y = MFMA32(ldfrag(sT, 32 * a + r, 68, 32 * a + 16 * s + 4 * hh), pack8(X, s), Y);
    if (r < 16) {
#pragma unroll
      for (int reg = 8; reg < 16; ++reg) {
        const int i = crow(reg, hh); const bf16_t v = f2bf(-Y[reg]);
        sT[(32 * a + i) * 68 + 32 * a + r] = v; sTt[(32 * a + r) * 68 + 32 * a + i] = v;
      }
    }
  }
  lds_barrier();
  if (w == 0) {
    f32x16 X, Y;
#pragma unroll
    for (int i = 0; i < 16; ++i) { X[i] = 0.f; Y[i] = 0.f; }
#pragma unroll
    for (int s = 0; s < 2; ++s) X = MFMA32(ldfrag(sLm, 32 + r, 68, 16 * s + 4 * hh), ldfrag(sTt, r, 68, 16 * s + 4 * hh), X);
#pragma unroll
    for (int s = 0; s < 2; ++s) Y = MFMA32(ldfrag(sT, 32 + r, 68, 32 + 16 * s + 4 * hh), pack8(X, s), Y);
#pragma unroll
    for (int reg = 0; reg < 16; ++reg) sT[(32 + crow(reg, hh)) * 68 + r] = f2bf(-Y[reg]);
  }
  lds_barrier();
  {
    const int c = tid;
    if (c < 128) {
#pragma unroll 2
      for (int i0 = 0; i0 < 64; i0 += 16) {
        float x[16];
#pragma unroll
        for (int i = 0; i < 16; ++i) x[i] = bf2f(sV[(i0 + i) * 132 + c]) * sbeta[i0 + i];
#pragma unroll
        for (int i = 0; i < 16; i += 4) *(u32x2*)(sRv + c * 68 + i0 + i) = u32x2{pk2(x[i], x[i + 1]), pk2(x[i + 2], x[i + 3])};
      }
    } else {
      const int d = c - 128;
      bf16_t* Kt = (bf16_t*)(P.ws + OFF_KTT) + (size_t)item * 8192 + d * 64;
      const float gl = sg[63];
#pragma unroll 2
      for (int i = 0; i < 64; i += 8) {
        float y[8], kt[8];
#pragma unroll
        for (int e = 0; e < 8; ++e) {
          const float kv = bf2f(sK[(i + e) * 132 + d]), ge = seg[i + e];
          y[e] = kv * sbeta[i + e] * ge; kt[e] = kv * __expf(gl - sg[i + e]);
        }
        *(u32x2*)(sRk + d * 68 + i) = u32x2{pk2(y[0], y[1]), pk2(y[2], y[3])}; *(u32x2*)(sRk + d * 68 + i + 4) = u32x2{pk2(y[4], y[5]), pk2(y[6], y[7])};
        *(u32x4*)(Kt + i) = u32x4{pk2(kt[0], kt[1]), pk2(kt[2], kt[3]), pk2(kt[4], kt[5]), pk2(kt[6], kt[7])};
      }
    }
  }
  lds_barrier();
  {
    bf16_t* Ut = (bf16_t*)(P.ws + OFF_UT) + (size_t)item * 8192;
    bf16_t* Wc = (bf16_t*)(P.ws + OFF_WC) + (size_t)item * 8192;
#pragma unroll
    for (int mi = 0; mi < 2; ++mi) {
      f32x16 du, dw;
#pragma unroll
      for (int i = 0; i < 16; ++i) { du[i] = 0.f; dw[i] = 0.f; }
#pragma unroll
      for (int s = 0; s < 4; ++s) {
        if (mi == 0 && s >= 2) continue;
        const bf16x8 tf = ldfrag(sT, 32 * mi + r, 68, 16 * s + 4 * hh);
        du = MFMA32(tf, ldfrag(sRv, 32 * w + r, 68, 16 * s + 4 * hh), du);
        dw = MFMA32(ldfrag(sRk, 32 * w + r, 68, 16 * s + 4 * hh), tf, dw);
      }
#pragma unroll
      for (int g4 = 0; g4 < 4; ++g4) {
        for (int rep = 0; rep <= DUPST; ++rep) {
        *(u32x2*)(Ut + (32 * w + r) * 64 + 32 * mi + 8 * g4 + 4 * hh) = u32x2{pk2(du[4 * g4], du[4 * g4 + 1]), pk2(du[4 * g4 + 2], du[4 * g4 + 3])};
        *(u32x2*)(Wc + (32 * mi + r) * 128 + 32 * w + 8 * g4 + 4 * hh) = u32x2{pk2(dw[4 * g4], dw[4 * g4 + 1]), pk2(dw[4 * g4 + 2], dw[4 * g4 + 3])};
        asm volatile("" ::: "memory"); }
      }
    }
  }
  }
}
DI void phase4(const Params& P, char* smem) {
  const int tid = threadIdx.x;
  {
    const float* SC = P.out; bf16_t* U5 = (bf16_t*)(P.ws + OFF_U5); const f32x2* PW = (const f32x2*)(P.ws + OFF_PW);
    const int nrep0_ = (REP_PHASE == 40) ? P.p_hi - 7 : 1;
    for (int rep0_ = 0; rep0_ < nrep0_; ++rep0_)
    for (int it = blockIdx.x; it < 128; it += gridDim.x) {
      const int g = it >> 2, b = (it & 3) * 4 + (tid >> 7), dir = (tid >> 6) & 1, n = tid & 63;
      const f32x2 a = PW[((g * 2 + dir) * 65 + 64) * 64 + n];
      float xr = 0.f, xi = 0.f;
#pragma unroll 8
      for (int s = 0; s < 64; ++s) {
        const int c = dir ? 63 - s : s; const size_t nn = (size_t)g * 1024 + b * 64 + c;
        U5[nn * 1280 + 1024 + dir * 128 + n] = f2bf(xr); U5[nn * 1280 + 1024 + dir * 128 + 64 + n] = f2bf(xi);
        const float sr = SC[nn * 256 + dir * 128 + n], si = SC[nn * 256 + dir * 128 + 64 + n];
        const float nr = a[0] * xr - a[1] * xi + sr, ni = a[0] * xi + a[1] * xr + si;
        xr = nr; xi = ni;
      }
    }
  }
  const int hb = tid >> 8;
  dn_prep_loop(P, smem + hb * 78336, blockIdx.x * 2 + hb, (REP_PHASE == 41) ? gridDim.x * 2 / (P.p_hi - 7) : gridDim.x * 2, tid & 255);
}

constexpr int RB_BYTES = 60160;
struct DnLd { u64_t v[32]; float g; };
DI void dn_issue(const Params& P, DnLd& L, int seq, int cc, int lw, int lane) {
  const int b = seq >> 3, hd = seq & 7, dir = hd >> 2, h = hd & 3;
  const size_t item = (size_t)seq * 64 + cc;
  if (lw == 0) {
    const bf16_t* Wg = (const bf16_t*)(P.ws + OFF_WC) + item * 8192;
#pragma unroll
    for (int k = 0; k < 32; ++k) { const int idx = lane + 64 * k; L.v[k] = ld8_pinned(Wg + (idx >> 5) * 128 + (idx & 31) * 4); }
  } else if (lw == 1) {
    const bf16_t* Qn = (const bf16_t*)(P.ws + OFF_QN) + (size_t)(b * 4 + h) * SEQ * 128;
#pragma unroll
    for (int k = 0; k < 32; ++k) {
      const int idx = lane + 64 * k, row = idx >> 5, p = cc * 64 + row, l = dir ? (SEQ - 1 - p) : p;
      L.v[k] = ld8_pinned(Qn + (size_t)l * 128 + (idx & 31) * 4);
    }
  } else if (lw == 2) {
    const bf16_t* Kg = (const bf16_t*)(P.ws + OFF_KTT) + item * 8192;
#pragma unroll
    for (int k = 0; k < 32; ++k) { const int idx = lane + 64 * k; L.v[k] = ld8_pinned(Kg + (idx >> 4) * 64 + (idx & 15) * 4); }
  } else {
    const bf16_t* Ag = (const bf16_t*)(P.ws + OFF_ATT) + item * 4096;
#pragma unroll
    for (int k = 0; k < 16; ++k) { const int idx = lane + 64 * k; L.v[k] = ld8_pinned(Ag + (idx >> 4) * 64 + (idx & 15) * 4); }
    L.g = ld4_pinned((const float*)(P.ws + OFF_GC) + item * 64 + lane);
  }
}
DI void dn_commit(const DnLd& L, char* buf, int lw, int lane) {
  bf16_t* sW = (bf16_t*)buf; bf16_t* sQ = sW + 64 * 132; bf16_t* sA = sQ + 64 * 132; bf16_t* sKt = sA + 64 * 68;
  if (lw == 0) {
#pragma unroll
    for (int k = 0; k < 32; ++k) { const int idx = lane + 64 * k; *(u64_t*)(sW + (idx >> 5) * 132 + (idx & 31) * 4) = L.v[k]; }
  } else if (lw == 1) {
#pragma unroll
    for (int k = 0; k < 32; ++k) { const int idx = lane + 64 * k; *(u64_t*)(sQ + (idx >> 5) * 132 + (idx & 31) * 4) = L.v[k]; }
  } else if (lw == 2) {
#pragma unroll
    for (int k = 0; k < 32; ++k) { const int idx = lane + 64 * k; *(u64_t*)(sKt + (idx >> 4) * 68 + (idx & 15) * 4) = L.v[k]; }
  } else {
#pragma unroll
    for (int k = 0; k < 16; ++k) { const int idx = lane + 64 * k; *(u64_t*)(sA + (idx >> 4) * 68 + (idx & 15) * 4) = L.v[k]; }
    ((float*)(buf + 59904))[lane] = L.g;
  }
}
DI void dn_recur(const Params& P, char* smem, int seq) {
  const int tid = threadIdx.x, lane = tid & 63, w = __builtin_amdgcn_readfirstlane(tid >> 6), r = lane & 31, hh = lane >> 5;
  const int b = seq >> 3, hd = seq & 7, dir = hd >> 2, h = hd & 3;
  __syncthreads();
  if (w >= 4) {
    const int lw = w - 4;
    DnLd LA, LB;
    dn_issue(P, LA, seq, 0, lw, lane);
    dn_commit(LA, smem, lw, lane);
    dn_issue(P, LA, seq, 1, lw, lane);
    dn_issue(P, LB, seq, 2, lw, lane);
    lds_barrier();
    for (int cc = 0; cc < 64; cc += 2) {
      for (int rep = 0; rep <= DUPL; ++rep) { dn_commit(LA, smem + RB_BYTES, lw, lane); asm volatile("" ::: "memory"); }
      for (int rep = 0; rep <= DUPL; ++rep) { dn_issue(P, LA, seq, min(cc + 3, 63), lw, lane); asm volatile("" ::: "memory"); }
      lds_barrier();
      for (int rep = 0; rep <= DUPL; ++rep) { dn_commit(LB, smem, lw, lane); asm volatile("" ::: "memory"); }
      for (int rep = 0; rep <= DUPL; ++rep) { dn_issue(P, LB, seq, min(cc + 4, 63), lw, lane); asm volatile("" ::: "memory"); }
      lds_barrier();
    }
  } else {
    const int dv0 = 32 * w;
    const float* GC = (const float*)(P.ws + OFF_GC);
    bf16_t* O = (bf16_t*)P.out + (size_t)dir * NTOK * 512;
    f32x16 S[4];
#pragma unroll
    for (int t = 0; t < 4; ++t)
#pragma unroll
      for (int i = 0; i < 16; ++i) S[t][i] = 0.f;
    lds_barrier();
    for (int cc = 0; cc < 64; ++cc) {
      const size_t item = (size_t)seq * 64 + cc;
      const bf16_t* sW = (const bf16_t*)(smem + (cc & 1) * RB_BYTES); const bf16_t* sQ = sW + 64 * 132; const bf16_t* sA = sQ + 64 * 132; const bf16_t* sKt = sA + 64 * 68;
      const bf16_t* Ug = (const bf16_t*)(P.ws + OFF_UT) + item * 8192;
      f32x16 vn[2];
#pragma unroll
      for (int m = 0; m < 2; ++m)
#pragma unroll
        for (int g4 = 0; g4 < 4; ++g4) {
          const u32x2 u = *(const u32x2*)(Ug + (dv0 + r) * 64 + 32 * m + 8 * g4 + 4 * hh);
          vn[m][4 * g4 + 0] = bflo(u[0]); vn[m][4 * g4 + 1] = bfhi(u[0]); vn[m][4 * g4 + 2] = bflo(u[1]); vn[m][4 * g4 + 3] = bfhi(u[1]);
        }
      const float* sG = (const float*)(smem + (cc & 1) * RB_BYTES + 59904);
      const float egl = __expf(sG[63]);
      f32x16 aW[2], aQ[2];
#pragma unroll
      for (int m = 0; m < 2; ++m)
#pragma unroll
        for (int i = 0; i < 16; ++i) { aW[m][i] = 0.f; aQ[m][i] = 0.f; }
      bf16x8 fa[2][4];
      fa[0][0] = ldfrag(sW, r, 132, 4 * hh); fa[0][1] = ldfrag(sW, 32 + r, 132, 4 * hh);
      fa[0][2] = ldfrag(sQ, r, 132, 4 * hh); fa[0][3] = ldfrag(sQ, 32 + r, 132, 4 * hh);
#pragma unroll
      for (int ks = 0; ks < 8; ++ks) {
        const int cur = ks & 1, nxt = cur ^ 1;
        if (ks + 1 < 8) {
          fa[nxt][0] = ldfrag(sW, r, 132, 16 * (ks + 1) + 4 * hh); fa[nxt][1] = ldfrag(sW, 32 + r, 132, 16 * (ks + 1) + 4 * hh);
          fa[nxt][2] = ldfrag(sQ, r, 132, 16 * (ks + 1) + 4 * hh); fa[nxt][3] = ldfrag(sQ, 32 + r, 132, 16 * (ks + 1) + 4 * hh);
        }
        const bf16x8 sf = pack8(S[ks >> 1], ks & 1);
        aW[0] = MFMA32(fa[cur][0], sf, aW[0]); aW[1] = MFMA32(fa[cur][1], sf, aW[1]);
        aQ[0] = MFMA32(fa[cur][2], sf, aQ[0]); aQ[1] = MFMA32(fa[cur][3], sf, aQ[1]);
      }
      bf16x8 fA[4];
#pragma unroll
      for (int ks = 0; ks < 4; ++ks) fA[ks] = ldfrag(sA, r, 68, 16 * ks + 4 * hh);
#pragma unroll
      for (int m = 0; m < 2; ++m)
#pragma unroll
        for (int i = 0; i < 16; ++i) aQ[m][i] *= __expf(sG[32 * m + crow(i, hh)]);
#pragma unroll
      for (int m = 0; m < 2; ++m)
#pragma unroll
        for (int i = 0; i < 16; ++i) vn[m][i] -= aW[m][i];
      bf16x8 vf[4];
      vf[0] = pack8(vn[0], 0); vf[1] = pack8(vn[0], 1); vf[2] = pack8(vn[1], 0); vf[3] = pack8(vn[1], 1);
      bf16x8 fk[2][4];
#pragma unroll
      for (int ks = 0; ks < 4; ++ks) aQ[0] = MFMA32(fA[ks], vf[ks], aQ[0]);
#pragma unroll
      for (int ks = 0; ks < 4; ++ks) fA[ks] = ldfrag(sA, 32 + r, 68, 16 * ks + 4 * hh);
#pragma unroll
      for (int ks = 0; ks < 4; ++ks) fk[0][ks] = ldfrag(sKt, r, 68, 16 * ks + 4 * hh);
#pragma unroll
      for (int ks = 0; ks < 4; ++ks) aQ[1] = MFMA32(fA[ks], vf[ks], aQ[1]);
#pragma unroll
      for (int t = 0; t < 4; ++t) {
        const int cur = t & 1, nxt = cur ^ 1;
        if (t + 1 < 4) {
#pragma unroll
          for (int ks = 0; ks < 4; ++ks) fk[nxt][ks] = ldfrag(sKt, 32 * (t + 1) + r, 68, 16 * ks + 4 * hh);
        }
#pragma unroll
        for (int i = 0; i < 16; ++i) S[t][i] *= egl;
#pragma unroll
        for (int ks = 0; ks < 4; ++ks) S[t] = MFMA32(fk[cur][ks], vf[ks], S[t]);
      }
      {
        bf16_t* Ob = O + (size_t)b * SEQ * 512 + h * 128 + dv0 + r;
#pragma unroll
        for (int m = 0; m < 2; ++m)
#pragma unroll
          for (int i = 0; i < 16; ++i) {
            const int p = cc * 64 + 32 * m + crow(i, hh), l = dir ? (SEQ - 1 - p) : p;
            Ob[(size_t)l * 512] = f2bf(aQ[m][i]);
          }
      }
      lds_barrier();
    }
  }
}

DI void phase6(const Params& P, LAS unsigned char* lds, int ctr_off) {
  const int tid = threadIdx.x, lane = tid & 63, wid = tid >> 6, wr = wid >> 2, wc = wid & 3, fr = lane & 15, fq = lane >> 4;
  const bf16_t* MY = (const bf16_t*)(P.ws + OFF_MY); const bf16_t* U5 = (const bf16_t*)(P.ws + OFF_U5);
  bf16_t* Y5 = (bf16_t*)(P.ws + OFF_Y5);
  unsigned* ctr = (unsigned*)(P.ws + OFF_CTR) + ctr_off;
  LAS unsigned* sid = (LAS unsigned*)(lds + 131072);
  const int q0 = blockIdx.x & 7, pref = (blockIdx.x < 128 && gridDim.x > 128) ? 1 : 0;
  int step = 0;
  for (;;) {
    const int q = (q0 + (step >> 1)) & 7, part = pref ^ (step & 1), lim = part ? 16 : 48;
    __syncthreads();
    if (tid == 0) *sid = atomicAdd(ctr + part * 8 + q, 1u);
    __syncthreads();
    const int got = (int)*sid;
    if (got >= lim) { if (++step >= 16) break; continue; }
    const int idl = part ? 48 + got : got;
    const int g = q + 8 * (idl >> 4), tn = (idl >> 2) & 3, tm = idl & 3;
    f32x4 acc[2][2][4][2];
    gemm256<false>(MY + (size_t)(g * 1024 + tm * 256) * 1280, 1280, U5 + (size_t)(g * 1024 + tn * 256) * 1280, 1280, 1280, lds, acc);
#pragma unroll
    for (int ai = 0; ai < 2; ++ai)
#pragma unroll
      for (int bj = 0; bj < 2; ++bj)
#pragma unroll
        for (int m = 0; m < 4; ++m)
#pragma unroll
          for (int n = 0; n < 2; ++n) {
            const int row0 = tm * 256 + ai * 128 + wr * 64 + m * 16 + fq * 4, col = tn * 256 + bj * 128 + wc * 32 + n * 16 + fr;
            const int t = row0 >> 4, p = row0 & 15; const size_t tok = (size_t)col * 64 + t;
            const f32x4 v = acc[ai][bj][m][n];
            const u32x2 o = {pk2(gelu_tanh(v[0]), gelu_tanh(v[1])), pk2(gelu_tanh(v[2]), gelu_tanh(v[3]))};
            *(u32x2*)(Y5 + tok * 512 + g * 16 + p) = o;
          }
  }
}

DI void phase7(const Params& P, LAS unsigned char* lds) {
  const int tid = threadIdx.x, lane = tid & 63, wid = tid >> 6, wr = wid >> 2, wc = wid & 3, fr = lane & 15, fq = lane >> 4;
  const bf16_t* Y5 = (const bf16_t*)(P.ws + OFF_Y5); const bf16_t* GW = (const bf16_t*)(P.ws + OFF_GLUWT);
  const bf16_t* ZA = (const bf16_t*)(P.ws + OFF_ZA); const bf16_t* ZB = (const bf16_t*)(P.ws + OFF_ZB);
  bf16_t* YAB = (bf16_t*)(P.ws + OFF_YAB);
  {
    const int bid = blockIdx.x, nbk = gridDim.x, nj = bid < 1024 ? (1024 - bid + nbk - 1) / nbk : 0;
    auto tile_of = [&](int j, int& tm, int& tn) { const int id = bid + j * nbk, grp = id >> 5, ig = id & 31; tm = grp * 8 + (ig & 7); tn = ig >> 3; };
    gemm256_stream<true, true>(nj, 8, 512, 512,
      [&](int j, const bf16_t*& A, const bf16_t*& Bt) { int tm, tn; tile_of(j, tm, tn); A = Y5 + (size_t)tm * 256 * 512; Bt = GW + (size_t)tn * 256 * 512; },
      [&](int j, f32x4 (&acc)[2][2][4][2]) {
        int tm, tn; tile_of(j, tm, tn);
        const int jc = tn * 128 + wc * 32 + fq * 8;
        f32x4 bv[2], bg[2];
#pragma unroll
        for (int n = 0; n < 2; ++n) { bv[n] = *(const f32x4*)(P.glu_b + jc + 4 * n); bg[n] = *(const f32x4*)(P.glu_b + 512 + jc + 4 * n); }
#pragma unroll
        for (int ai = 0; ai < 2; ++ai)
#pragma unroll
          for (int m = 0; m < 4; ++m) {
            const size_t t = (size_t)tm * 256 + ai * 128 + wr * 64 + m * 16 + fr;
            const u32x4 z = *(const u32x4*)(ZA + t * 512 + jc);
            float y[8];
#pragma unroll
            for (int n = 0; n < 2; ++n)
#pragma unroll
              for (int e = 0; e < 4; ++e) {
                const unsigned zz = z[2 * n + (e >> 1)]; const float zf = (e & 1) ? bfhi(zz) : bflo(zz);
                y[4 * n + e] = (acc[ai][0][m][n][e] + bv[n][e]) * sigmoidf_(acc[ai][1][m][n][e] + bg[n][e]) * siluf_(zf);
              }
            *(u32x4*)(YAB + t * 1024 + jc) = u32x4{pk2(y[0], y[1]), pk2(y[2], y[3]), pk2(y[4], y[5]), pk2(y[6], y[7])};
          }
      }, lds);
  }
  const bf16_t* Of = (const bf16_t*)P.out; const bf16_t* Ob = Of + (size_t)NTOK * 512;
  float nw[8];
#pragma unroll
  for (int e = 0; e < 8; ++e) nw[e] = P.dn_norm_w[(lane & 15) * 8 + e];
  for (int t0 = (blockIdx.x * NWV + wid) * 4; t0 < NTOK; t0 += gridDim.x * NWV * 4) {
    u32x4 a[4], bq[4], z[4];
#pragma unroll
    for (int u = 0; u < 4; ++u) {
      const size_t off = (size_t)(t0 + u) * 512 + lane * 8;
      a[u] = *(const u32x4*)(Of + off); bq[u] = *(const u32x4*)(Ob + off); z[u] = *(const u32x4*)(ZB + off);
    }
#pragma unroll
    for (int u = 0; u < 4; ++u) {
      float o[8]; float ss = 0.f;
#pragma unroll
      for (int e = 0; e < 4; ++e) { o[2 * e] = bflo(a[u][e]) + bflo(bq[u][e]); o[2 * e + 1] = bfhi(a[u][e]) + bfhi(bq[u][e]); }
#pragma unroll
      for (int e = 0; e < 8; ++e) ss += o[e] * o[e];
#pragma unroll
      for (int sft = 1; sft < 16; sft <<= 1) ss += __shfl_xor(ss, sft);
      const float rs = rsqrtf(ss * (1.f / 128.f) + 1e-6f);
      float y[8];
#pragma unroll
      for (int e = 0; e < 4; ++e) { y[2 * e] = o[2 * e] * rs * nw[2 * e] * siluf_(bflo(z[u][e])); y[2 * e + 1] = o[2 * e + 1] * rs * nw[2 * e + 1] * siluf_(bfhi(z[u][e])); }
      *(u32x4*)(YAB + (size_t)(t0 + u) * 1024 + 512 + lane * 8) = u32x4{pk2(y[0], y[1]), pk2(y[2], y[3]), pk2(y[4], y[5]), pk2(y[6], y[7])};
    }
  }
}

DI void phase8_norm(const Params& P, const float* sss, int tm) {
  const int tid = threadIdx.x, lane = tid & 63, wid = tid >> 6;
  __syncthreads();
  for (int rr = 0; rr < 32; rr += 4) {
    f32x4 v[4][4];
#pragma unroll
    for (int u = 0; u < 4; ++u) {
      const f32x4* xr = (const f32x4*)(P.out + ((size_t)tm * 256 + wid * 32 + rr + u) * DM) + lane;
#pragma unroll
      for (int j = 0; j < 4; ++j) v[u][j] = xr[64 * j];
    }
#pragma unroll
    for (int u = 0; u < 4; ++u) {
      const int row = wid * 32 + rr + u;
      const f32x4 p4 = *(const f32x4*)(sss + row * 4);
      const float rstd = rsqrtf((p4[0] + p4[1] + p4[2] + p4[3]) * (1.f / DM) + 1e-6f);
      f32x4* xr = (f32x4*)(P.out + ((size_t)tm * 256 + row) * DM) + lane;
#pragma unroll
      for (int j = 0; j < 4; ++j) {
        const f32x4 fw = *(const f32x4*)(P.final_norm_w + lane * 4 + 256 * j);
        f32x4 o;
#pragma unroll
        for (int e = 0; e < 4; ++e) o[e] = v[u][j][e] * rstd * fw[e];
        xr[64 * j] = o;
      }
    }
  }
  __syncthreads();
}
DI void phase8(const Params& P, LAS unsigned char* lds) {
  const int tid = threadIdx.x, lane = tid & 63, wid = tid >> 6, wr = wid >> 2, wc = wid & 3, fr = lane & 15, fq = lane >> 4;
  const bf16_t* YAB = (const bf16_t*)(P.ws + OFF_YAB); const bf16_t* W = (const bf16_t*)(P.ws + OFF_WOUTT);
  const float* mod = (const float*)(P.ws + OFF_MOD);
  float* sss = (float*)((char*)lds + 131072 + 64);
  for (int id = blockIdx.x * 4; id < 1024; id = ((id & 3) == 3) ? id - 3 + gridDim.x * 4 : id + 1) {
    const int tm = id >> 2, tn = id & 3;
    if (tn == 0) { for (int e = tid; e < 1024; e += NTHR) sss[e] = 0.f; }
    {
      f32x4 acc[2][2][4][2];
      gemm256<true, true>(YAB + (size_t)tm * 256 * 1024, 1024, W + (size_t)tn * 256 * 1024, 1024, 1024, lds, acc);
      f32x4 gvv[2][2];
#pragma unroll
      for (int bj = 0; bj < 2; ++bj)
#pragma unroll
        for (int n = 0; n < 2; ++n) gvv[bj][n] = *(const f32x4*)(mod + ((tm * 256) >> 12) * 3072 + 2048 + tn * 256 + bj * 128 + wc * 32 + fq * 8 + 4 * n);
#pragma unroll
      for (int ai = 0; ai < 2; ++ai)
#pragma unroll
        for (int m = 0; m < 4; ++m) {
          const size_t t = (size_t)tm * 256 + ai * 128 + wr * 64 + m * 16 + fr;
          float ssv = 0.f;
#pragma unroll
          for (int bj = 0; bj < 2; ++bj)
#pragma unroll
            for (int n = 0; n < 2; ++n) {
              const int col = tn * 256 + bj * 128 + wc * 32 + fq * 8 + 4 * n;
              const f32x4 xv = *(const f32x4*)(P.x + t * DM + col), gv = gvv[bj][n];
              f32x4 o;
#pragma unroll
              for (int e = 0; e < 4; ++e) { o[e] = xv[e] + gv[e] * acc[ai][bj][m][n][e]; ssv += o[e] * o[e]; }
              *(f32x4*)(P.out + t * DM + col) = o;
            }
          ssv += __shfl_xor(ssv, 16); ssv += __shfl_xor(ssv, 32);
          if (fq == 0) sss[(ai * 128 + wr * 64 + m * 16 + fr) * 4 + wc] += ssv;
        }
    }
    if (tn == 3) phase8_norm(P, sss, tm);
  }
}
DI void phase9(const Params& P) {
  const int tid = threadIdx.x, lane = tid & 63, wid = tid >> 6;
  for (int row0 = (blockIdx.x * NWV + wid) * 4; row0 < NTOK; row0 += gridDim.x * NWV * 4) {
    f32x4 v[4][4];
#pragma unroll
    for (int u = 0; u < 4; ++u) {
      const f32x4* xr = (const f32x4*)(P.out + (size_t)(row0 + u) * DM) + lane;
#pragma unroll
      for (int j = 0; j < 4; ++j) v[u][j] = xr[64 * j];
    }
#pragma unroll
    for (int u = 0; u < 4; ++u) {
      f32x4* xr = (f32x4*)(P.out + (size_t)(row0 + u) * DM) + lane;
      float s = 0.f;
#pragma unroll
      for (int j = 0; j < 4; ++j) s += v[u][j][0] * v[u][j][0] + v[u][j][1] * v[u][j][1] + v[u][j][2] * v[u][j][2] + v[u][j][3] * v[u][j][3];
      const float rstd = rsqrtf(wave_sum(s) * (1.f / DM) + 1e-6f);
#pragma unroll
      for (int j = 0; j < 4; ++j) {
        const f32x4 fw = *(const f32x4*)(P.final_norm_w + lane * 4 + 256 * j);
        f32x4 o;
#pragma unroll
        for (int e = 0; e < 4; ++e) o[e] = v[u][j][e] * rstd * fw[e];
        xr[64 * j] = o;
      }
    }
  }
}

#ifndef SPLIT56
#define SPLIT56 0
#endif
DI void phase5(const Params& P, char* smem, LAS unsigned char* lds) {
  for (int seq = blockIdx.x; seq < 128; seq += gridDim.x) dn_recur(P, smem, seq);
  if (!SPLIT56) phase6(P, lds, 0);
}
constexpr int LDS_BYTES = 160 * 1024;
__global__ void __launch_bounds__(NTHR) hybrid_fwd(Params P) {
  extern __shared__ __attribute__((aligned(16))) unsigned char lds_raw[];
  LAS unsigned char* lds = (LAS unsigned char*)lds_raw;
  char* smem = (char*)lds_raw;
  cg::grid_group grid = cg::this_grid();
#define SEAM(p) if (P.p_lo < (p) && P.p_hi >= (p)) grid.sync()
#ifndef PH_MASK
#define PH_MASK 0x3ff
#endif
#define RUN(p, call) if (((PH_MASK >> (p)) & 1) && P.p_lo <= (p) && P.p_hi >= (p)) { const int nrep_ = (REP_PHASE == (p)) ? P.p_hi - 7 : 1; for (int rep_ = 0; rep_ < nrep_; ++rep_) { if (rep_) grid.sync(); call; } }
  RUN(0, phase0(P, smem));
  SEAM(1);
  RUN(1, phase1(P, smem));
  SEAM(2);
  RUN(2, phase2(P, lds));
  SEAM(3);
  RUN(3, phase3(P, lds));
  SEAM(4);
  RUN(4, phase4(P, smem));
  SEAM(5);
  RUN(5, phase5(P, smem, lds));
  if (SPLIT56) { SEAM(6); RUN(6, phase6(P, lds, 0)); }
  SEAM(7);
  RUN(7, phase7(P, lds));
  SEAM(8);
  RUN(8, phase8(P, lds));
}

extern "C" void kernel_launch(void* const* d_in, const int* in_sizes, int n_in, void* d_out, int out_size, void* d_ws, size_t ws_size, hipStream_t stream) {
  static int grid_blocks = 0;
  if (!grid_blocks) {
    int dev = 0, cus = 0, per_cu = 0;
    (void)hipGetDevice(&dev);
    (void)hipDeviceGetAttribute(&cus, hipDeviceAttributeMultiprocessorCount, dev);
    (void)hipFuncSetAttribute((const void*)hybrid_fwd, hipFuncAttributeMaxDynamicSharedMemorySize, LDS_BYTES);
    (void)hipOccupancyMaxActiveBlocksPerMultiprocessor(&per_cu, (const void*)hybrid_fwd, NTHR, LDS_BYTES);
    if (per_cu < 1) per_cu = 1;
    if (per_cu > 1) per_cu = 1;
    grid_blocks = cus * per_cu;
    if (ws_size < WS_END) fprintf(stderr, "workspace too small: %zu < %zu\n", ws_size, (size_t)WS_END);
  }
  Params p{};
  const float* const* in = (const float* const*)d_in;
  p.x = in[0]; p.c = in[1]; p.ada_w = in[2]; p.ada_b = in[3]; p.norm_w = in[4]; p.w_in = in[5]; p.conv_w = in[6];
  p.a_log[0] = in[7]; p.dt_bias[0] = in[8]; p.a_log[1] = in[9]; p.dt_bias[1] = in[10]; p.dn_norm_w = in[11];
  for (int d = 0; d < 2; ++d) {
    const int o = 12 + 7 * d;
    p.lam_re[d] = in[o]; p.lam_im[d] = in[o + 1]; p.log_step[d] = in[o + 2]; p.b_re[d] = in[o + 3]; p.b_im[d] = in[o + 4]; p.c_re[d] = in[o + 5]; p.c_im[d] = in[o + 6];
  }
  p.s5_d = in[26]; p.glu_w = in[27]; p.glu_b = in[28]; p.w_out = in[29]; p.final_norm_w = in[30];
  p.out = (float*)d_out; p.ws = (char*)d_ws;
#if N_LAUNCH_MODE == 1
  for (int ph = 0; ph <= 9; ++ph) {
    p.p_lo = ph; p.p_hi = ph;
    hipLaunchKernelGGL(hybrid_fwd, dim3(grid_blocks), dim3(NTHR), LDS_BYTES, stream, p);
  }
#else
  p.p_lo = 0; p.p_hi = 9;
  void* args[] = {&p};
  hipError_t e = hipLaunchCooperativeKernel((const void*)hybrid_fwd, dim3(grid_blocks), dim3(NTHR), args, LDS_BYTES, stream);
  if (e != hipSuccess) fprintf(stderr, "cooperative launch failed: %s (grid %d)\n", hipGetErrorString(e), grid_blocks);
#endif
}
```

```cpp
#include <hip/hip_runtime.h>
#include <hip/hip_cooperative_groups.h>
#include <cstdio>
#include <cstdint>
namespace cg = cooperative_groups;

#ifndef N_LAUNCH_MODE
#define N_LAUNCH_MODE 0
#endif
#ifndef REP_PHASE
#define REP_PHASE -1
#endif

#define DUPST 0
#ifndef DUPL
#define DUPL 0
#endif
#define DI __device__ __forceinline__
#define LAS __attribute__((address_space(3)))
constexpr int NTHR = 512, NWV = 8;
typedef unsigned short bf16_t;
typedef short bf16x8 __attribute__((ext_vector_type(8)));
typedef float f32x4 __attribute__((ext_vector_type(4)));
typedef float f32x2 __attribute__((ext_vector_type(2)));
typedef float f32x16 __attribute__((ext_vector_type(16)));
typedef unsigned u32x4 __attribute__((ext_vector_type(4)));
typedef unsigned u32x2 __attribute__((ext_vector_type(2)));
typedef __bf16 bf2_t __attribute__((ext_vector_type(2)));

constexpr int DM = 1024, NB = 16, SEQ = 4096, NTOK = NB * SEQ;
constexpr int INC = 3088, INP = 3328;
constexpr size_t MiB = 1u << 20;
constexpr size_t OFF_HB = 0;
constexpr size_t OFF_QKVRAW = 128 * MiB;
constexpr size_t OFF_WC = 0;
constexpr size_t OFF_UT = 128 * MiB;
constexpr size_t OFF_ATT = 256 * MiB;
constexpr size_t OFF_Y5 = 656 * MiB;
constexpr size_t OFF_U5 = 320 * MiB;
constexpr size_t OFF_ZA = 400 * MiB;
constexpr size_t OFF_ZB = 464 * MiB;
constexpr size_t OFF_QN = 528 * MiB;
constexpr size_t OFF_KN = 592 * MiB;
constexpr size_t OFF_VN = 656 * MiB;
constexpr size_t OFF_YAB = 528 * MiB;
constexpr size_t OFF_MY = 720 * MiB;
constexpr size_t OFF_MS = 800 * MiB;
constexpr size_t OFF_KTT = 816 * MiB;
constexpr size_t OFF_WINT = 944 * MiB;
constexpr size_t OFF_GLUWT = 952 * MiB;
constexpr size_t OFF_WOUTT = 953 * MiB;
constexpr size_t OFF_BA = 955 * MiB;
constexpr size_t OFF_GC = 959 * MiB;
constexpr size_t OFF_KTAB = 961 * MiB;
constexpr size_t OFF_PW = 965 * MiB;
constexpr size_t OFF_FB = 968 * MiB;
constexpr size_t OFF_MOD = 969 * MiB;
constexpr size_t OFF_CTR = 969 * MiB + 512 * 1024;
constexpr size_t WS_END = 970 * MiB;

struct Params {
  const float *x, *c, *ada_w, *ada_b, *norm_w, *w_in, *conv_w;
  const float *a_log[2], *dt_bias[2], *dn_norm_w;
  const float *lam_re[2], *lam_im[2], *log_step[2], *b_re[2], *b_im[2], *c_re[2], *c_im[2];
  const float *s5_d, *glu_w, *glu_b, *w_out, *final_norm_w;
  float* out;
  char* ws;
  int p_lo, p_hi;
};

DI unsigned pk2(float a, float b) { f32x2 v = {a, b}; bf2_t r = __builtin_convertvector(v, bf2_t); return __builtin_bit_cast(unsigned, r); }
DI bf16_t f2bf(float a) { return (bf16_t)(pk2(a, 0.f) & 0xffffu); }
DI float bf2f(bf16_t v) { return __uint_as_float(((unsigned)v) << 16); }
DI float bflo(unsigned u) { return __uint_as_float(u << 16); }
DI float bfhi(unsigned u) { return __uint_as_float(u & 0xffff0000u); }
DI float sigmoidf_(float x) { return 1.f / (1.f + __expf(-x)); }
DI float siluf_(float x) { return x / (1.f + __expf(-x)); }
DI float gelu_tanh(float x) { float u = 0.7978845608028654f * (x + 0.044715f * x * x * x); float e = __expf(2.f * u); float t = 1.f - 2.f / (e + 1.f); return 0.5f * x * (1.f + t); }
DI float softplusf_(float x) { return x > 15.f ? x : log1pf(expf(x)); }
DI float wave_sum(float v) {
#pragma unroll
  for (int o = 1; o < 64; o <<= 1) v += __shfl_xor(v, o);
  return v;
}
DI void lds_barrier() { asm volatile("s_waitcnt lgkmcnt(0)" ::: "memory"); __builtin_amdgcn_s_barrier(); asm volatile("" ::: "memory"); }
typedef unsigned long long u64_t;
DI u64_t ld8_pinned(const void* p) { return __hip_atomic_load((const u64_t*)p, __ATOMIC_RELAXED, __HIP_MEMORY_SCOPE_WORKGROUP); }
DI float ld4_pinned(const void* p) { return __builtin_bit_cast(float, __hip_atomic_load((const unsigned*)p, __ATOMIC_RELAXED, __HIP_MEMORY_SCOPE_WORKGROUP)); }
DI int crow(int reg, int h) { return (reg & 3) + 8 * (reg >> 2) + 4 * h; }
DI bf16x8 pack8(const f32x16& x, int s) {
  u32x4 p;
  p[0] = pk2(x[8 * s + 0], x[8 * s + 1]); p[1] = pk2(x[8 * s + 2], x[8 * s + 3]);
  p[2] = pk2(x[8 * s + 4], x[8 * s + 5]); p[3] = pk2(x[8 * s + 6], x[8 * s + 7]);
  return __builtin_bit_cast(bf16x8, p);
}
DI bf16x8 ldfrag(const bf16_t* base, int row, int stride, int col) {
  const bf16_t* p = base + row * stride + col;
  u32x2 lo = *(const u32x2*)p, hi = *(const u32x2*)(p + 8);
  u32x4 v = {lo[0], lo[1], hi[0], hi[1]};
  return __builtin_bit_cast(bf16x8, v);
}
#define MFMA32(a, b, c) __builtin_amdgcn_mfma_f32_32x32x16_bf16((a), (b), (c), 0, 0, 0)
#define MFMA16(a, b, c) __builtin_amdgcn_mfma_f32_16x16x32_bf16((a), (b), (c), 0, 0, 0)

constexpr int G_HTB = 128 * 64 * 2;
DI int lds_byte(int r, int c) { const int st = (r >> 4) * 2 + (c >> 5), rr = r & 15, cc = c & 31, ob = rr * 64 + cc * 2; return st * 1024 + (ob ^ (((ob >> 9) & 1) << 5)); }
DI void stage_rc(int b, int& R, int& C) { const int st = b / 1024, sb = b % 1024, swz = sb ^ (((sb >> 9) & 1) << 5); R = (st >> 1) * 16 + swz / 64; C = (st & 1) * 32 + (swz % 64) / 2; }
template <bool TRANS, bool PERM = false>
DI void gemm256(const bf16_t* __restrict__ A, int lda, const bf16_t* __restrict__ Bt, int ldb, int K, LAS unsigned char* lds, f32x4 (&acc)[2][2][4][2]) {
  const int tid = threadIdx.x, wid = __builtin_amdgcn_readfirstlane(tid >> 6), lane = tid & 63, wr = wid >> 2, wc = wid & 3, fr = lane & 15, fq = lane >> 4;
  unsigned voffA[2], voffB[2];
#pragma unroll
  for (int i = 0; i < 2; ++i) {
    int R, C; stage_rc(tid * 16 + i * 8192, R, C);
    const int Rb = PERM ? ((R & ~31) + 8 * ((R & 15) >> 2) + 4 * ((R >> 4) & 1) + (R & 3)) : R;
    voffA[i] = (unsigned)(R * lda + C) * 2u; voffB[i] = (unsigned)(Rb * ldb + C) * 2u;
  }
  const unsigned ldsw = (unsigned)wid * 1024u;
  const int aoff = lds_byte(wr * 64 + fr, fq * 8), boff = lds_byte(wc * 32 + fr, fq * 8);
  const char* cA0 = (const char*)A; const char* cA1 = cA0 + (size_t)128 * lda * 2;
  const char* cB0 = (const char*)Bt; const char* cB1 = cB0 + (size_t)128 * ldb * 2;
#define G_SA(b, h) (((b) * 2 + (h)) * G_HTB)
#define G_SB(b, h) ((4 + (b) * 2 + (h)) * G_HTB)
#define G_STAGE(bufoff, gbase, voff, kt) do { _Pragma("unroll") for (int _i = 0; _i < 2; ++_i) \
    __builtin_amdgcn_global_load_lds((const unsigned*)((gbase) + (size_t)(kt) * 128 + (voff)[_i]), (LAS unsigned*)(lds + (bufoff) + ldsw + _i * 8192), 16, 0, 0); } while (0)
#define G_LDA(dst, b, h) do { _Pragma("unroll") for (int m = 0; m < 4; ++m) _Pragma("unroll") for (int k = 0; k < 2; ++k) dst[m][k] = *(const LAS bf16x8*)(lds + G_SA(b, h) + aoff + m * 2048 + k * 1024); } while (0)
#define G_LDB(dst, b, h) do { _Pragma("unroll") for (int n = 0; n < 2; ++n) _Pragma("unroll") for (int k = 0; k < 2; ++k) dst[n][k] = *(const LAS bf16x8*)(lds + G_SB(b, h) + boff + n * 2048 + k * 1024); } while (0)
#define G_MMA(ai, bj, At_, Bt_) do { __builtin_amdgcn_s_setprio(1); _Pragma("unroll") for (int m = 0; m < 4; ++m) _Pragma("unroll") for (int n = 0; n < 2; ++n) _Pragma("unroll") for (int k = 0; k < 2; ++k) \
    acc[ai][bj][m][n] = TRANS ? MFMA16(Bt_[n][k], At_[m][k], acc[ai][bj][m][n]) : MFMA16(At_[m][k], Bt_[n][k], acc[ai][bj][m][n]); __builtin_amdgcn_s_setprio(0); } while (0)
#define G_WAIT_V(n) asm volatile("s_waitcnt vmcnt(" #n ")" ::: "memory")
#define G_WAIT_L(n) asm volatile("s_waitcnt lgkmcnt(" #n ")" ::: "memory")
#define G_BAR __builtin_amdgcn_s_barrier()
#define G_SCHED __builtin_amdgcn_sched_barrier(0)
#pragma unroll
  for (int a = 0; a < 2; ++a)
#pragma unroll
    for (int b = 0; b < 2; ++b)
#pragma unroll
      for (int m = 0; m < 4; ++m)
#pragma unroll
        for (int n = 0; n < 2; ++n) acc[a][b][m][n] = f32x4{0.f, 0.f, 0.f, 0.f};
  bf16x8 At[4][2], B0[2][2], B1[2][2];
  const int nt = K / 64;
  G_WAIT_V(0); G_WAIT_L(0); G_BAR;
  G_STAGE(G_SB(0, 0), cB0, voffB, 0); G_STAGE(G_SA(0, 0), cA0, voffA, 0);
  G_STAGE(G_SB(0, 1), cB1, voffB, 0); G_STAGE(G_SA(0, 1), cA1, voffA, 0);
  if (wr == 1) G_BAR;
  G_WAIT_V(4); G_BAR;
  G_STAGE(G_SB(1, 0), cB0, voffB, 1); G_STAGE(G_SA(1, 0), cA0, voffA, 1); G_STAGE(G_SB(1, 1), cB1, voffB, 1);
  G_WAIT_V(6); G_BAR;
  for (int t = 0; t < nt - 2; t += 2) {
    G_LDB(B0, 0, 0); G_SCHED; G_LDA(At, 0, 0); G_STAGE(G_SA(1, 1), cA1, voffA, t + 1);
    G_WAIT_L(8); G_BAR; G_WAIT_L(0); G_MMA(0, 0, At, B0); G_BAR; G_SCHED;
    G_LDB(B1, 0, 1); G_STAGE(G_SB(0, 0), cB0, voffB, t + 2);
    G_BAR; G_WAIT_L(0); G_MMA(0, 1, At, B1); G_BAR;
    G_LDA(At, 0, 1); G_STAGE(G_SA(0, 0), cA0, voffA, t + 2);
    G_BAR; G_WAIT_L(0); G_MMA(1, 0, At, B0); G_BAR; G_SCHED;
    G_STAGE(G_SB(0, 1), cB1, voffB, t + 2);
    G_WAIT_V(6); G_BAR; G_MMA(1, 1, At, B1); G_BAR;
    G_LDB(B0, 1, 0); G_SCHED; G_LDA(At, 1, 0); G_STAGE(G_SA(0, 1), cA1, voffA, t + 2);
    G_WAIT_L(8); G_BAR; G_WAIT_L(0); G_MMA(0, 0, At, B0); G_BAR; G_SCHED;
    G_LDB(B1, 1, 1); G_STAGE(G_SB(1, 0), cB0, voffB, t + 3);
    G_BAR; G_WAIT_L(0); G_MMA(0, 1, At, B1); G_BAR;
    G_LDA(At, 1, 1); G_STAGE(G_SA(1, 0), cA0, voffA, t + 3);
    G_BAR; G_WAIT_L(0); G_MMA(1, 0, At, B0); G_BAR; G_SCHED;
    G_STAGE(G_SB(1, 1), cB1, voffB, t + 3);
    G_WAIT_V(6); G_BAR; G_MMA(1, 1, At, B1); G_BAR;
  }
  { G_LDB(B0, 0, 0); G_LDA(At, 0, 0); G_STAGE(G_SA(1, 1), cA1, voffA, nt - 1);
    G_BAR; G_WAIT_L(0); G_MMA(0, 0, At, B0); G_BAR;
    G_LDB(B1, 0, 1); G_BAR; G_WAIT_L(0); G_MMA(0, 1, At, B1); G_BAR;
    G_LDA(At, 0, 1); G_WAIT_V(4); G_BAR; G_WAIT_L(0); G_MMA(1, 0, At, B0); G_MMA(1, 1, At, B1); G_BAR; }
  { G_LDB(B0, 1, 0); G_LDA(At, 1, 0); G_WAIT_V(2); G_BAR; G_WAIT_L(0); G_MMA(0, 0, At, B0); G_BAR;
    G_LDB(B1, 1, 1); G_WAIT_V(0); G_BAR; G_WAIT_L(0); G_MMA(0, 1, At, B1); G_BAR;
    G_LDA(At, 1, 1); G_BAR; G_WAIT_L(0); G_MMA(1, 0, At, B0); G_MMA(1, 1, At, B1); G_BAR; }
  if (wr == 0) G_BAR;
}

template <bool TRANS, bool PERM, class TileFn, class EpiFn>
DI void gemm256_stream(int nj, int nt, int lda, int ldb, TileFn tilefn, EpiFn epifn, LAS unsigned char* lds) {
  if (nj <= 0) return;
  const int tid = threadIdx.x, wid = __builtin_amdgcn_readfirstlane(tid >> 6), lane = tid & 63, wr = wid >> 2, wc = wid & 3, fr = lane & 15, fq = lane >> 4;
  unsigned voffA[2], voffB[2];
#pragma unroll
  for (int i = 0; i < 2; ++i) {
    int R, C; stage_rc(tid * 16 + i * 8192, R, C);
    const int Rb = PERM ? ((R & ~31) + 8 * ((R & 15) >> 2) + 4 * ((R >> 4) & 1) + (R & 3)) : R;
    voffA[i] = (unsigned)(R * lda + C) * 2u; voffB[i] = (unsigned)(Rb * ldb + C) * 2u;
  }
  const unsigned ldsw = (unsigned)wid * 1024u;
  const int aoff = lds_byte(wr * 64 + fr, fq * 8), boff = lds_byte(wc * 32 + fr, fq * 8);
  const size_t hA = (size_t)128 * lda * 2, hB = (size_t)128 * ldb * 2;
  const char *cA, *cB, *nA, *nB;
  { const bf16_t *a, *b; tilefn(0, a, b); cA = (const char*)a; cB = (const char*)b; nA = cA; nB = cB; if (nj > 1) { tilefn(1, a, b); nA = (const char*)a; nB = (const char*)b; } }
  int j = 0, tbeg = 0, tend = nt;
#define GS_A(g, h) (((g) < tend ? cA + (size_t)((g) - tbeg) * 128 : nA + (size_t)((g) - tend) * 128) + (h) * hA)
#define GS_B(g, h) (((g) < tend ? cB + (size_t)((g) - tbeg) * 128 : nB + (size_t)((g) - tend) * 128) + (h) * hB)
#define GS_STAGE(bufoff, gptr, voff) do { const char* _p = (gptr); _Pragma("unroll") for (int _i = 0; _i < 2; ++_i) \
    __builtin_amdgcn_global_load_lds((const unsigned*)(_p + (voff)[_i]), (LAS unsigned*)(lds + (bufoff) + ldsw + _i * 8192), 16, 0, 0); } while (0)
  f32x4 acc[2][2][4][2];
#pragma unroll
  for (int a = 0; a < 2; ++a)
#pragma unroll
    for (int b = 0; b < 2; ++b)
#pragma unroll
      for (int m = 0; m < 4; ++m)
#pragma unroll
        for (int n = 0; n < 2; ++n) acc[a][b][m][n] = f32x4{0.f, 0.f, 0.f, 0.f};
  bf16x8 At[4][2], B0[2][2], B1[2][2];
  const int total = nj * nt;
  G_WAIT_V(0); G_WAIT_L(0); G_BAR;
  GS_STAGE(G_SB(0, 0), GS_B(0, 0), voffB); GS_STAGE(G_SA(0, 0), GS_A(0, 0), voffA);
  GS_STAGE(G_SB(0, 1), GS_B(0, 1), voffB); GS_STAGE(G_SA(0, 1), GS_A(0, 1), voffA);
  if (wr == 1) G_BAR;
  G_WAIT_V(4); G_BAR;
  GS_STAGE(G_SB(1, 0), GS_B(1, 0), voffB); GS_STAGE(G_SA(1, 0), GS_A(1, 0), voffA); GS_STAGE(G_SB(1, 1), GS_B(1, 1), voffB);
  G_WAIT_V(6); G_BAR;
  for (int t = 0; t < total - 2; t += 2) {
    G_LDB(B0, 0, 0); G_SCHED; G_LDA(At, 0, 0); GS_STAGE(G_SA(1, 1), GS_A(t + 1, 1), voffA);
    G_WAIT_L(8); G_BAR; G_WAIT_L(0); G_MMA(0, 0, At, B0); G_BAR; G_SCHED;
    G_LDB(B1, 0, 1); GS_STAGE(G_SB(0, 0), GS_B(t + 2, 0), voffB);
    G_BAR; G_WAIT_L(0); G_MMA(0, 1, At, B1); G_BAR;
    G_LDA(At, 0, 1); GS_STAGE(G_SA(0, 0), GS_A(t + 2, 0), voffA);
    G_BAR; G_WAIT_L(0); G_MMA(1, 0, At, B0); G_BAR; G_SCHED;
    GS_STAGE(G_SB(0, 1), GS_B(t + 2, 1), voffB);
    G_WAIT_V(6); G_BAR; G_MMA(1, 1, At, B1); G_BAR;
    G_LDB(B0, 1, 0); G_SCHED; G_LDA(At, 1, 0); GS_STAGE(G_SA(0, 1), GS_A(t + 2, 1), voffA);
    G_WAIT_L(8); G_BAR; G_WAIT_L(0); G_MMA(0, 0, At, B0); G_BAR; G_SCHED;
    G_LDB(B1, 1, 1); GS_STAGE(G_SB(1, 0), GS_B(t + 3, 0), voffB);
    G_BAR; G_WAIT_L(0); G_MMA(0, 1, At, B1); G_BAR;
    G_LDA(At, 1, 1); GS_STAGE(G_SA(1, 0), GS_A(t + 3, 0), voffA);
    G_BAR; G_WAIT_L(0); G_MMA(1, 0, At, B0); G_BAR; G_SCHED;
    GS_STAGE(G_SB(1, 1), GS_B(t + 3, 1), voffB);
    G_WAIT_V(6); G_BAR; G_MMA(1, 1, At, B1); G_BAR;
    if (t + 2 == tend) {
      epifn(j, acc);
#pragma unroll
      for (int a = 0; a < 2; ++a)
#pragma unroll
        for (int b = 0; b < 2; ++b)
#pragma unroll
          for (int m = 0; m < 4; ++m)
#pragma unroll
            for (int n = 0; n < 2; ++n) acc[a][b][m][n] = f32x4{0.f, 0.f, 0.f, 0.f};
      ++j; tbeg = tend; tend += nt; cA = nA; cB = nB;
      if (j + 1 < nj) { const bf16_t *a, *b; tilefn(j + 1, a, b); nA = (const char*)a; nB = (const char*)b; }
    }
  }
  { G_LDB(B0, 0, 0); G_LDA(At, 0, 0); GS_STAGE(G_SA(1, 1), GS_A(total - 1, 1), voffA);
    G_BAR; G_WAIT_L(0); G_MMA(0, 0, At, B0); G_BAR;
    G_LDB(B1, 0, 1); G_BAR; G_WAIT_L(0); G_MMA(0, 1, At, B1); G_BAR;
    G_LDA(At, 0, 1); G_WAIT_V(4); G_BAR; G_WAIT_L(0); G_MMA(1, 0, At, B0); G_MMA(1, 1, At, B1); G_BAR; }
  { G_LDB(B0, 1, 0); G_LDA(At, 1, 0); G_WAIT_V(2); G_BAR; G_WAIT_L(0); G_MMA(0, 0, At, B0); G_BAR;
    G_LDB(B1, 1, 1); G_WAIT_V(0); G_BAR; G_WAIT_L(0); G_MMA(0, 1, At, B1); G_BAR;
    G_LDA(At, 1, 1); G_BAR; G_WAIT_L(0); G_MMA(1, 0, At, B0); G_MMA(1, 1, At, B1); G_BAR; }
  if (wr == 0) G_BAR;
  epifn(j, acc);
}

DI void p0_mod_item(const Params& P, char* smem, int it) {
  float* ssil = (float*)smem;
  float* sred = ssil + 16 * 1024;
  const int tid = threadIdx.x, cl = tid & 31, ks = tid >> 5, col = it * 32 + cl;
  __syncthreads();
  for (int e = tid; e < 16 * 1024; e += NTHR) ssil[e] = siluf_(P.c[e]);
  __syncthreads();
  float acc[16];
#pragma unroll
  for (int b = 0; b < 16; ++b) acc[b] = 0.f;
#pragma unroll 1
  for (int k0 = ks * 64; k0 < ks * 64 + 64; k0 += 16) {
    float w[16];
#pragma unroll
    for (int u = 0; u < 16; ++u) w[u] = P.ada_w[(size_t)(k0 + u) * 3072 + col];
#pragma unroll
    for (int u = 0; u < 16; ++u)
#pragma unroll
      for (int b = 0; b < 16; ++b) acc[b] += ssil[b * 1024 + k0 + u] * w[u];
  }
#pragma unroll
  for (int b = 0; b < 16; ++b) sred[(ks * 16 + b) * 32 + cl] = acc[b];
  __syncthreads();
  {
    const int b = tid >> 5;
    float s = P.ada_b[col];
#pragma unroll
    for (int k2 = 0; k2 < 16; ++k2) s += sred[(k2 * 16 + b) * 32 + cl];
    ((float*)(P.ws + OFF_MOD))[b * 3072 + col] = s;
  }
}
DI void p0_transpose_item(const float* __restrict__ src, int N, int K, int k0, int srcn0, int nvalid, bf16_t* __restrict__ dst, int dstn0, float* s, int tid) {
  const int n = tid & 31, kr = tid >> 5;
#pragma unroll
  for (int i = 0; i < 8; ++i) { const int k = kr + 8 * i; s[k * 33 + n] = (n < nvalid) ? src[(size_t)(k0 + k) * N + srcn0 + n] : 0.f; }
  __syncthreads();
  const int on = tid >> 3, kc = tid & 7;
  u32x4 o;
  o[0] = pk2(s[(kc * 8 + 0) * 33 + on], s[(kc * 8 + 1) * 33 + on]); o[1] = pk2(s[(kc * 8 + 2) * 33 + on], s[(kc * 8 + 3) * 33 + on]);
  o[2] = pk2(s[(kc * 8 + 4) * 33 + on], s[(kc * 8 + 5) * 33 + on]); o[3] = pk2(s[(kc * 8 + 6) * 33 + on], s[(kc * 8 + 7) * 33 + on]);
  *(u32x4*)(dst + (size_t)(dstn0 + on) * K + k0 + kc * 8) = o;
  __syncthreads();
}
DI void s5_lambda(const Params& P, int g, int dir, int n, float& dt, float& lr, float& li) {
  dt = expf(P.log_step[dir][g]); lr = P.lam_re[dir][g * 64 + n]; li = P.lam_im[dir][g * 64 + n];
}
DI void cpow(float dt, float lr, float li, float e, float& re, float& im) {
  const float mag = __expf(lr * dt * e), x = li * dt * e;
  const float n = rintf(x * 0.15915494309189535f);
  const float y = fmaf(n, -6.2831854820251465f, x) + n * 1.7484556000744883e-7f;
  re = mag * __cosf(y); im = mag * __sinf(y);
}
DI void s5_f(float dt, float lr, float li, float& fre, float& fim) {
  float ar, ai; cpow(dt, lr, li, 1.f, ar, ai);
  const float nr = ar - 1.f, ni = ai, den = lr * lr + li * li;
  fre = (nr * lr + ni * li) / den; fim = (ni * lr - nr * li) / den;
}
DI void p0_ktab_item(const Params& P, float* sm, int it, int tid) {
  const int tau = it & 63, dir = (it >> 6) & 1, g = it >> 7;
  float* sw = sm;
  float* sG = sw + 128;
  float* sC = sG + 2048;
  if (tid < 64) {
    float dt, lr, li; s5_lambda(P, g, dir, tid, dt, lr, li);
    float fr_, fi_, ar, ai; s5_f(dt, lr, li, fr_, fi_); cpow(dt, lr, li, (float)tau, ar, ai);
    sw[tid * 2] = fr_ * ar - fi_ * ai; sw[tid * 2 + 1] = fr_ * ai + fi_ * ar;
  }
  for (int e = tid; e < 1024; e += 256) { sC[e * 2] = P.c_re[dir][g * 1024 + e]; sC[e * 2 + 1] = P.c_im[dir][g * 1024 + e]; }
  __syncthreads();
  for (int e = tid; e < 1024; e += 256) {
    const int n = e >> 4;
    const float br = P.b_re[dir][g * 1024 + e], bi = P.b_im[dir][g * 1024 + e], wr_ = sw[n * 2], wi_ = sw[n * 2 + 1];
    sG[e * 2] = wr_ * br - wi_ * bi; sG[e * 2 + 1] = wr_ * bi + wi_ * br;
  }
  __syncthreads();
  const int p = tid >> 4, q = tid & 15;
  float acc = 0.f;
  for (int n = 0; n < 64; ++n) acc += sC[(p * 64 + n) * 2] * sG[(n * 16 + q) * 2] - sC[(p * 64 + n) * 2 + 1] * sG[(n * 16 + q) * 2 + 1];
  ((float*)(P.ws + OFF_KTAB))[(size_t)it * 256 + tid] = acc;
  __syncthreads();
}
DI void phase0(const Params& P, char* smem) {
  const int bid = blockIdx.x, nb = gridDim.x, tid = threadIdx.x, hb = tid >> 8, t2 = tid & 255;
  {
    f32x2* PW = (f32x2*)(P.ws + OFF_PW); f32x2* FB = (f32x2*)(P.ws + OFF_FB);
    const int total = 32 * 2 * 65 * 64;
    for (int e = bid * NTHR + tid; e < total; e += nb * NTHR) {
      const int n = e & 63, ex = (e >> 6) % 65, gd = (e >> 6) / 65, dir = gd & 1, g = gd >> 1;
      float dt, lr, li; s5_lambda(P, g, dir, n, dt, lr, li);
      float re, im; cpow(dt, lr, li, (float)ex, re, im);
      PW[e] = f32x2{re, im};
      if (ex == 0) { float fr_, fi_; s5_f(dt, lr, li, fr_, fi_); FB[gd * 64 + n] = f32x2{fr_, fi_}; }
    }
  }
  if (bid == 0 && tid < 16) ((unsigned*)(P.ws + OFF_CTR))[tid] = 0u;
  for (int it = bid; it < 96; it += nb) p0_mod_item(P, smem, it);
  __syncthreads();
  constexpr int I1 = 1664, I2 = 256, I3 = 512;
  float* str = (float*)smem + hb * (64 * 33);
  for (int it = bid * 2 + hb; it < I1 + I2 + I3; it += nb * 2) {
    int r = it;
    if (r < I1) {
      const int kb = r / 104, nt = r % 104, n0 = nt * 32; int nvalid = INC - n0; nvalid = nvalid < 0 ? 0 : (nvalid > 32 ? 32 : nvalid);
      p0_transpose_item(P.w_in, INC, DM, kb * 64, n0, nvalid, (bf16_t*)(P.ws + OFF_WINT), n0, str, t2); continue;
    } r -= I1;
    if (r < I2) {
      const int kb = r / 32, nt = r % 32, n0 = nt * 32, t = n0 >> 8, i = n0 & 255;
      const int src0 = (i < 128) ? t * 128 + i : 512 + t * 128 + (i - 128);
      p0_transpose_item(P.glu_w, 1024, 512, kb * 64, src0, 32, (bf16_t*)(P.ws + OFF_GLUWT), n0, str, t2); continue;
    } r -= I2;
    { const int kb = r / 32, nt = r % 32; p0_transpose_item(P.w_out, 1024, 1024, kb * 64, nt * 32, 32, (bf16_t*)(P.ws + OFF_WOUTT), nt * 32, str, t2); }
  }
  __syncthreads();
  float* skt = (float*)smem + hb * 4352;
  for (int it = bid * 2 + hb; it < 4096; it += nb * 2) p0_ktab_item(P, skt, it, t2);
}

DI void phase1(const Params& P, char* smem) {
  const int bid = blockIdx.x, nb = gridDim.x, tid = threadIdx.x, lane = tid & 63, wid = tid >> 6;
  const float* mod = (const float*)(P.ws + OFF_MOD);
  bf16_t* hB = (bf16_t*)(P.ws + OFF_HB);
  for (int row0 = (bid * NWV + wid) * 4; row0 < NTOK; row0 += nb * NWV * 4) {
    f32x4 v[4][4];
#pragma unroll
    for (int u = 0; u < 4; ++u) {
      const f32x4* xr = (const f32x4*)(P.x + (size_t)(row0 + u) * DM) + lane;
#pragma unroll
      for (int j = 0; j < 4; ++j) v[u][j] = xr[64 * j];
    }
#pragma unroll
    for (int u = 0; u < 4; ++u) {
      const int row = row0 + u, b = row >> 12;
      float s = 0.f;
#pragma unroll
      for (int j = 0; j < 4; ++j) s += v[u][j][0] * v[u][j][0] + v[u][j][1] * v[u][j][1] + v[u][j][2] * v[u][j][2] + v[u][j][3] * v[u][j][3];
      const float rstd = rsqrtf(wave_sum(s) * (1.f / DM) + 1e-6f);
#pragma unroll
      for (int j = 0; j < 4; ++j) {
        const int col = lane * 4 + 256 * j;
        const f32x4 nw = *(const f32x4*)(P.norm_w + col), sh = *(const f32x4*)(mod + b * 3072 + col), sc = *(const f32x4*)(mod + b * 3072 + 1024 + col);
        float h[4];
#pragma unroll
        for (int e = 0; e < 4; ++e) h[e] = v[u][j][e] * rstd * nw[e] * (1.f + sc[e]) + sh[e];
        u32x2 o = {pk2(h[0], h[1]), pk2(h[2], h[3])};
        *(u32x2*)(hB + (size_t)row * DM + col) = o;
      }
    }
  }
  const float* KT = (const float*)(P.ws + OFF_KTAB);
  const f32x2* PW = (const f32x2*)(P.ws + OFF_PW); const f32x2* FB = (const f32x2*)(P.ws + OFF_FB);
  bf16_t* MY = (bf16_t*)(P.ws + OFF_MY); bf16_t* MS = (bf16_t*)(P.ws + OFF_MS);
  const int totalY = 32 * 1024 * 160;
  for (int e = bid * NTHR + tid; e < totalY; e += nb * NTHR) {
    const int kc = e % 160, row = (e / 160) & 1023, g = e / (160 * 1024), t = row >> 4, p = row & 15;
    float o[8];
    if (kc < 128) {
      const int s = kc >> 1, q0 = (kc & 1) * 8;
      if (t == s) {
        const float* k0 = KT + ((size_t)((g * 2 + 0) * 64 + 0) * 256 + p * 16 + q0); const float* k1 = KT + ((size_t)((g * 2 + 1) * 64 + 0) * 256 + p * 16 + q0);
#pragma unroll
        for (int j = 0; j < 8; ++j) o[j] = k0[j] + k1[j] + ((q0 + j == p) ? P.s5_d[g * 16 + p] : 0.f);
      } else {
        const int dir = t > s ? 0 : 1, tau = t > s ? t - s : s - t;
        const float* k0 = KT + ((size_t)((g * 2 + dir) * 64 + tau) * 256 + p * 16 + q0);
#pragma unroll
        for (int j = 0; j < 8; ++j) o[j] = k0[j];
      }
    } else {
      const int c2 = (kc - 128) * 8, dir = c2 >> 7, part = (c2 >> 6) & 1, n0 = c2 & 63;
      const int ex = dir == 0 ? t + 1 : 64 - t;
#pragma unroll
      for (int j = 0; j < 8; ++j) {
        const int n = n0 + j; const f32x2 a = PW[((g * 2 + dir) * 65 + ex) * 64 + n];
        const float cr = P.c_re[dir][(g * 16 + p) * 64 + n], ci = P.c_im[dir][(g * 16 + p) * 64 + n];
        o[j] = part == 0 ? (cr * a[0] - ci * a[1]) : -(cr * a[1] + ci * a[0]);
      }
    }
    u32x4 ov = {pk2(o[0], o[1]), pk2(o[2], o[3]), pk2(o[4], o[5]), pk2(o[6], o[7])};
    *(u32x4*)(MY + ((size_t)(g * 1024 + row) * 1280 + kc * 8)) = ov;
  }
  const int totalS = 32 * 256 * 128;
  for (int e = bid * NTHR + tid; e < totalS; e += nb * NTHR) {
    const int kc = e & 127, row = (e >> 7) & 255, g = e >> 15, dir = row >> 7, part = (row >> 6) & 1, n = row & 63;
    const int s = kc >> 1, q0 = (kc & 1) * 8, ex = dir == 0 ? 63 - s : s;
    const f32x2 a = PW[((g * 2 + dir) * 65 + ex) * 64 + n], f = FB[(g * 2 + dir) * 64 + n];
    const float wr_ = a[0] * f[0] - a[1] * f[1], wi_ = a[0] * f[1] + a[1] * f[0];
    float o[8];
#pragma unroll
    for (int j = 0; j < 8; ++j) {
      const float br = P.b_re[dir][(g * 64 + n) * 16 + q0 + j], bi = P.b_im[dir][(g * 64 + n) * 16 + q0 + j];
      o[j] = part == 0 ? (wr_ * br - wi_ * bi) : (wr_ * bi + wi_ * br);
    }
    u32x4 ov = {pk2(o[0], o[1]), pk2(o[2], o[3]), pk2(o[4], o[5]), pk2(o[6], o[7])};
    *(u32x4*)(MS + ((size_t)(g * 256 + row) * 1024 + kc * 8)) = ov;
  }
}

DI void phase2(const Params& P, LAS unsigned char* lds) {
  const int tid = threadIdx.x, lane = tid & 63, wid = tid >> 6, wr = wid >> 2, wc = wid & 3, fr = lane & 15, fq = lane >> 4;
  const bf16_t* hB = (const bf16_t*)(P.ws + OFF_HB); const bf16_t* W = (const bf16_t*)(P.ws + OFF_WINT);
  bf16_t* U5 = (bf16_t*)(P.ws + OFF_U5); bf16_t* ZA = (bf16_t*)(P.ws + OFF_ZA); bf16_t* ZB = (bf16_t*)(P.ws + OFF_ZB);
  bf16_t* QKV = (bf16_t*)(P.ws + OFF_QKVRAW); float* BA = (float*)(P.ws + OFF_BA);
  constexpr int NT = 13, NTILES = 256 * NT;
  const int bid = blockIdx.x, nbk = gridDim.x, nj = bid < NTILES ? (NTILES - bid + nbk - 1) / nbk : 0;
  auto tile_of = [&](int j, int& tm, int& tn) { const int id = bid + j * nbk, grp = id / (8 * NT), ig = id % (8 * NT); tm = grp * 8 + (ig & 7); tn = ig >> 3; };
  gemm256_stream<true, true>(nj, DM / 64, DM, DM,
    [&](int j, const bf16_t*& A, const bf16_t*& Bt) { int tm, tn; tile_of(j, tm, tn); A = hB + (size_t)tm * 256 * DM; Bt = W + (size_t)tn * 256 * DM; },
    [&](int j, f32x4 (&acc)[2][2][4][2]) {
      int tm, tn; tile_of(j, tm, tn);
#pragma unroll
      for (int ai = 0; ai < 2; ++ai)
#pragma unroll
        for (int m = 0; m < 4; ++m) {
          const int t = tm * 256 + ai * 128 + wr * 64 + m * 16 + fr;
#pragma unroll
          for (int bj = 0; bj < 2; ++bj) {
            const int col = tn * 256 + bj * 128 + wc * 32 + fq * 8;
            const f32x4 v0 = acc[ai][bj][m][0], v1 = acc[ai][bj][m][1];
            if (tn == 12) { if (col < INC) { *(f32x4*)(BA + (size_t)t * 16 + (col - 3072)) = v0; *(f32x4*)(BA + (size_t)t * 16 + (col - 3072) + 4) = v1; } continue; }
            const u32x4 o = {pk2(v0[0], v0[1]), pk2(v0[2], v0[3]), pk2(v1[0], v1[1]), pk2(v1[2], v1[3])};
            if (tn < 2) { const int g = col >> 4, q = col & 15; *(u32x4*)(U5 + ((size_t)(g * 1024 + (t >> 6)) * 1280 + (t & 63) * 16 + q)) = o; }
            else if (tn < 4) *(u32x4*)(ZA + (size_t)t * 512 + (col - 512)) = o;
            else if (tn < 10) *(u32x4*)(QKV + (size_t)t * 1536 + (col - 1024)) = o;
            else *(u32x4*)(ZB + (size_t)t * 512 + (col - 2560)) = o;
          }
        }
    }, lds);
}

DI void phase3(const Params& P, LAS unsigned char* lds) {
  const int tid = threadIdx.x, lane = tid & 63, wid = tid >> 6, wr = wid >> 2, wc = wid & 3, fr = lane & 15, fq = lane >> 4;
  const bf16_t* MS = (const bf16_t*)(P.ws + OFF_MS); const bf16_t* U5 = (const bf16_t*)(P.ws + OFF_U5);
  float* SC = P.out;
  const int nrep3a_ = (REP_PHASE == 30) ? P.p_hi - 7 : 1;
  for (int rep3a_ = 0; rep3a_ < nrep3a_; ++rep3a_)
  for (int id = blockIdx.x; id < 128; id += gridDim.x) {
    const int g = id >> 2, tn = id & 3;
    f32x4 acc[2][2][4][2];
    gemm256<false>(MS + (size_t)(g * 256) * 1024, 1024, U5 + (size_t)(g * 1024 + tn * 256) * 1280, 1280, 1024, lds, acc);
#pragma unroll
    for (int ai = 0; ai < 2; ++ai)
#pragma unroll
      for (int bj = 0; bj < 2; ++bj)
#pragma unroll
        for (int m = 0; m < 4; ++m)
#pragma unroll
          for (int n = 0; n < 2; ++n) {
            const int row0 = ai * 128 + wr * 64 + m * 16 + fq * 4, col = tn * 256 + bj * 128 + wc * 32 + n * 16 + fr;
            *(f32x4*)(SC + ((size_t)(g * 1024 + col) * 256 + row0)) = acc[ai][bj][m][n];
          }
  }
  const bf16_t* QKV = (const bf16_t*)(P.ws + OFF_QKVRAW);
  const int nbk = gridDim.x, vb = (blockIdx.x + nbk - (128 % nbk)) % nbk;
  const int nrep3b_ = (REP_PHASE == 31) ? P.p_hi - 7 : 1;
  for (int rep3b_ = 0; rep3b_ < nrep3b_; ++rep3b_)
  for (int it = vb * NWV + wid; it < 16 * 128 * 3; it += nbk * NWV) {
    const int part = it % 3, c = (it / 3) & 127, b = it / (3 * 128), h = lane >> 4;
    const int colq = part * 512 + lane * 8;
    float wt[5][8];
#pragma unroll
    for (int k = 0; k < 5; ++k) {
      const f32x4 wa = *(const f32x4*)(P.conv_w + k * 1536 + colq), wb = *(const f32x4*)(P.conv_w + k * 1536 + colq + 4);
#pragma unroll
      for (int e = 0; e < 4; ++e) { wt[k][e] = wa[e]; wt[k][4 + e] = wb[e]; }
    }
    bf16_t* dst = (bf16_t*)(P.ws + (part == 0 ? OFF_QN : part == 1 ? OFF_KN : OFF_VN)) + (size_t)(b * 4 + h) * SEQ * 128 + (lane & 15) * 8;
    const int l0 = c * 32;
#pragma unroll 1
    for (int i0 = 0; i0 < 32; i0 += 8) {
      u32x4 u[12];
#pragma unroll
      for (int k = 0; k < 12; ++k) {
        const int l = l0 + i0 - 2 + k;
        u[k] = (l >= 0 && l < SEQ) ? *(const u32x4*)(QKV + (size_t)(b * SEQ + l) * 1536 + colq) : u32x4{0u, 0u, 0u, 0u};
      }
#pragma unroll
      for (int i = 0; i < 8; ++i) {
        float y[8];
#pragma unroll
        for (int e = 0; e < 8; ++e) y[e] = 0.f;
#pragma unroll
        for (int k = 0; k < 5; ++k)
#pragma unroll
          for (int e = 0; e < 4; ++e) { y[2 * e] += wt[k][2 * e] * bflo(u[i + k][e]); y[2 * e + 1] += wt[k][2 * e + 1] * bfhi(u[i + k][e]); }
        float ss = 0.f;
#pragma unroll
        for (int e = 0; e < 8; ++e) { y[e] = siluf_(y[e]); ss += y[e] * y[e]; }
        if (part < 2) {
#pragma unroll
          for (int o = 1; o < 16; o <<= 1) ss += __shfl_xor(ss, o);
          float sc = rsqrtf(ss + 1e-6f); if (part == 0) sc *= 0.08838834764831845f;
#pragma unroll
          for (int e = 0; e < 8; ++e) y[e] *= sc;
        }
        *(u32x4*)(dst + (size_t)(l0 + i0 + i) * 128) = u32x4{pk2(y[0], y[1]), pk2(y[2], y[3]), pk2(y[4], y[5]), pk2(y[6], y[7])};
      }
    }
  }
}

struct PrepIn { u32x4 k[4], q[4], v[4]; float be, al; };
DI void dn_prep_issue(const Params& P, PrepIn& I, int item, int tid) {
  const int cc = item & 63, hd = (item >> 6) & 7, b = item >> 9, dir = hd >> 2, h = hd & 3;
  const size_t base = (size_t)(b * 4 + h) * SEQ * 128;
  const bf16_t* Qn = (const bf16_t*)(P.ws + OFF_QN) + base; const bf16_t* Kn = (const bf16_t*)(P.ws + OFF_KN) + base; const bf16_t* Vn = (const bf16_t*)(P.ws + OFF_VN) + base;
#pragma unroll
  for (int k = 0; k < 4; ++k) {
    const int idx = tid + 256 * k, row = idx >> 4, ch = idx & 15, p = cc * 64 + row, l = dir ? (SEQ - 1 - p) : p;
    I.k[k] = *(const u32x4*)(Kn + (size_t)l * 128 + ch * 8); I.q[k] = *(const u32x4*)(Qn + (size_t)l * 128 + ch * 8); I.v[k] = *(const u32x4*)(Vn + (size_t)l * 128 + ch * 8);
  }
  if (tid < 64) {
    const float* BA = (const float*)(P.ws + OFF_BA);
    const int p = cc * 64 + tid, l = dir ? (SEQ - 1 - p) : p; const size_t t = (size_t)b * SEQ + l;
    I.be = BA[t * 16 + dir * 4 + h]; I.al = BA[t * 16 + 8 + dir * 4 + h];
  }
}
DI void dn_prep_loop(const Params& P, char* sm, int first, int stride, int tid) {
  const int lane = tid & 63, w = tid >> 6, r = lane & 31, hh = lane >> 5;
  bf16_t* sK = (bf16_t*)sm;
  bf16_t* sQ = sK + 64 * 132;
  bf16_t* sRv = sQ;
  bf16_t* sLm = sQ + 128 * 68;
  bf16_t* sTt = sLm + 64 * 68;
  bf16_t* sRk = sLm;
  bf16_t* sT = sTt + 64 * 68;
  float* sg = (float*)(sT + 64 * 68);
  float* sbeta = sg + 64;
  float* seg = sbeta + 64;
  bf16_t* sV = (bf16_t*)(seg + 64);
  float* GC = (float*)(P.ws + OFF_GC);
  PrepIn I;
  if (first < 8192) dn_prep_issue(P, I, first, tid);
  for (int item = first; item < 8192; item += stride) {
  const int cc = item & 63, hd = (item >> 6) & 7, dir = hd >> 2, h = hd & 3;
  lds_barrier();
#pragma unroll
  for (int k = 0; k < 4; ++k) {
    const int idx = tid + 256 * k, row = idx >> 4, ch = idx & 15;
    *(u32x2*)(sK + row * 132 + ch * 8) = u32x2{I.k[k][0], I.k[k][1]}; *(u32x2*)(sK + row * 132 + ch * 8 + 4) = u32x2{I.k[k][2], I.k[k][3]};
    *(u32x2*)(sQ + row * 132 + ch * 8) = u32x2{I.q[k][0], I.q[k][1]}; *(u32x2*)(sQ + row * 132 + ch * 8 + 4) = u32x2{I.q[k][2], I.q[k][3]};
    *(u32x2*)(sV + row * 132 + ch * 8) = u32x2{I.v[k][0], I.v[k][1]}; *(u32x2*)(sV + row * 132 + ch * 8 + 4) = u32x2{I.v[k][2], I.v[k][3]};
  }
  for (int e = tid; e < 64 * 68 / 2; e += 256) { ((unsigned*)sT)[e] = 0u; ((unsigned*)sTt)[e] = 0u; }
  if (tid < 64) {
    const float be = sigmoidf_(I.be);
    const float g = -expf(P.a_log[dir][h]) * softplusf_(I.al + P.dt_bias[dir][h]);
    float gc = g;
#pragma unroll
    for (int o = 1; o < 64; o <<= 1) { const float v = __shfl_up(gc, o); if (lane >= o) gc += v; }
    sg[tid] = gc; sbeta[tid] = be; seg[tid] = expf(gc); GC[(size_t)item * 64 + tid] = gc;
  }
  if (item + stride < 8192) dn_prep_issue(P, I, item + stride, tid);
  lds_barrier();
  {
    const int mi = w >> 1, ni = w & 1;
    f32x16 kk, qk;
#pragma unroll
    for (int i = 0; i < 16; ++i) { kk[i] = 0.f; qk[i] = 0.f; }
#pragma unroll
    for (int ks = 0; ks < 8; ++ks) {
      const bf16x8 bf = ldfrag(sK, 32 * ni + r, 132, 16 * ks + 4 * hh);
      const bf16x8 ak = ldfrag(sK, 32 * mi + r, 132, 16 * ks + 4 * hh);
      const bf16x8 aq = ldfrag(sQ, 32 * mi + r, 132, 16 * ks + 4 * hh);
      kk = MFMA32(ak, bf, kk); qk = MFMA32(aq, bf, qk);
    }
    lds_barrier();
    bf16_t* ATT = (bf16_t*)(P.ws + OFF_ATT) + (size_t)item * 4096;
    const int j = 32 * ni + r; const float gj = sg[j];
#pragma unroll
    for (int reg = 0; reg < 16; ++reg) {
      const int i = 32 * mi + crow(reg, hh);
      const float d = __expf(i >= j ? sg[i] - gj : 0.f);
      sLm[i * 68 + j] = f2bf((i > j) ? sbeta[i] * kk[reg] * d : 0.f);
      for (int rep = 0; rep <= DUPST; ++rep) { ATT[i * 64 + j] = f2bf((i >= j) ? qk[reg] * d : 0.f); asm volatile("" ::: "memory"); }
    }
  }
  lds_barrier();
  if (tid < 64) {
    const int blk = tid >> 4, c = tid & 15;
    float x[16];
#pragma unroll
    for (int i = 0; i < 16; ++i) {
      float a = (i == c) ? 1.f : 0.f;
      const bf16_t* lrow = sLm + (16 * blk + i) * 68 + 16 * blk;
#pragma unroll
      for (int j = 0; j < i; ++j) a -= bf2f(lrow[j]) * x[j];
      x[i] = a;
    }
#pragma unroll
    for (int i = 0; i < 16; ++i) { const bf16_t v = f2bf(x[i]); sT[(16 * blk + i) * 68 + 16 * blk + c] = v; sTt[(16 * blk + c) * 68 + 16 * blk + i] = v; }
  }
  lds_barrier();
  if (w < 2) {
    const int a = w;
    f32x16 X, Y;
#pragma unroll
    for (int i = 0; i < 16; ++i) { X[i] = 0.f; Y[i] = 0.f; }
    {
      bf16x8 A = ldfrag(sLm, 32 * a + r, 68, 32 * a + 4 * hh);
      if (r < 16) A = bf16x8{0, 0, 0, 0, 0, 0, 0, 0};
      X = MFMA32(A, ldfrag(sTt, 32 * a + r, 68, 32 * a + 4 * hh), X);
    }
#pragma unroll
    for (int s = 0; s < 2; ++s) Y = MFMA32(ldfrag(sT, 32 * a + r, 68, 32 * a + 16 * s + 4 * hh), pack8(X, s), Y);
    if (r < 16) {
#pragma unroll
      for (int reg = 8; reg < 16; ++reg) {
        const int i = crow(reg, hh); const bf16_t v = f2bf(-Y[reg]);
        sT[(32 * a + i) * 68 + 32 * a + r] = v; sTt[(32 * a + r) * 68 + 32 * a + i] = v;
      }
    }
  }
  lds_barrier();
  if (w == 0) {
    f32x16 X, Y;
#pragma unroll
    for (int i = 0; i < 16; ++i) { X[i] = 0.f; Y[i] = 0.f; }
#pragma unroll
    for (int s = 0; s < 2; ++s) X = MFMA32(ldfrag(sLm, 32 + r, 68, 16 * s + 4 * hh), ldfrag(sTt, r, 68, 16 * s + 4 * hh), X);
#pragma unroll
    for (int s = 0; s < 2; ++s) Y = MFMA32(ldfrag(sT, 32 + r, 68, 32 + 16 * s + 4 * hh), pack8(X, s), Y);
#pragma unroll
    for (int reg = 0; reg < 16; ++reg) sT[(32 + crow(reg, hh)) * 68 + r] = f2bf(-Y[reg]);
  }
  lds_barrier();
  {
    const int c = tid;
    if (c < 128) {
#pragma unroll 2
      for (int i0 = 0; i0 < 64; i0 += 16) {
        float x[16];
#pragma unroll
        for (int i = 0; i < 16; ++i) x[i] = bf2f(sV[(i0 + i) * 132 + c]) * sbeta[i0 + i];
#pragma unroll
        for (int i = 0; i < 16; i += 4) *(u32x2*)(sRv + c * 68 + i0 + i) = u32x2{pk2(x[i], x[i + 1]), pk2(x[i + 2], x[i + 3])};
      }
    } else {
      const int d = c - 128;
      bf16_t* Kt = (bf16_t*)(P.ws + OFF_KTT) + (size_t)item * 8192 + d * 64;
      const float gl = sg[63];
#pragma unroll 2
      for (int i = 0; i < 64; i += 8) {
        float y[8], kt[8];
#pragma unroll
        for (int e = 0; e < 8; ++e) {
          const float kv = bf2f(sK[(i + e) * 132 + d]), ge = seg[i + e];
          y[e] = kv * sbeta[i + e] * ge; kt[e] = kv * __expf(gl - sg[i + e]);
        }
        *(u32x2*)(sRk + d * 68 + i) = u32x2{pk2(y[0], y[1]), pk2(y[2], y[3])}; *(u32x2*)(sRk + d * 68 + i + 4) = u32x2{pk2(y[4], y[5]), pk2(y[6], y[7])};
        *(u32x4*)(Kt + i) = u32x4{pk2(kt[0], kt[1]), pk2(kt[2], kt[3]), pk2(kt[4], kt[5]), pk2(kt[6], kt[7])};
      }
    }
  }
  lds_barrier();
  {
    bf16_t* Ut = (bf16_t*)(P.ws + OFF_UT) + (size_t)item * 8192;
    bf16_t* Wc = (bf16_t*)(P.ws + OFF_WC) + (size_t)item * 8192;
#pragma unroll
    for (int mi = 0; mi < 2; ++mi) {
      f32x16 du, dw;
#pragma unroll
      for (int i = 0; i < 16; ++i) { du[i] = 0.f; dw[i] = 0.f; }
#pragma unroll
      for (int s = 0; s < 4; ++s) {
        if (mi == 0 && s >= 2) continue;
        const bf16x8 tf = ldfrag(sT, 32 * mi + r, 68, 16 * s + 4 * hh);
        du = MFMA32(tf, ldfrag(sRv, 32 * w + r, 68, 16 * s + 4 * hh), du);
        dw = MFMA32(ldfrag(sRk, 32 * w + r, 68, 16 * s + 4 * hh), tf, dw);
      }
#pragma unroll
      for (int g4 = 0; g4 < 4; ++g4) {
        for (int rep = 0; rep <= DUPST; ++rep) {
        *(u32x2*)(Ut + (32 * w + r) * 64 + 32 * mi + 8 * g4 + 4 * hh) = u32x2{pk2(du[4 * g4], du[4 * g4 + 1]), pk2(du[4 * g4 + 2], du[4 * g4 + 3])};
        *(u32x2*)(Wc + (32 * mi + r) * 128 + 32 * w + 8 * g4 + 4 * hh) = u32x2{pk2(dw[4 * g4], dw[4 * g4 + 1]), pk2(dw[4 * g4 + 2], dw[4 * g4 + 3])};
        asm volatile("" ::: "memory"); }
      }
    }
  }
  }
}
DI void phase4(const Params& P, char* smem) {
  const int tid = threadIdx.x;
  {
    const float* SC = P.out; bf16_t* U5 = (bf16_t*)(P.ws + OFF_U5); const f32x2* PW = (const f32x2*)(P.ws + OFF_PW);
    const int nrep0_ = (REP_PHASE == 40) ? P.p_hi - 7 : 1;
    for (int rep0_ = 0; rep0_ < nrep0_; ++rep0_)
    for (int it = blockIdx.x; it < 128; it += gridDim.x) {
      const int g = it >> 2, b = (it & 3) * 4 + (tid >> 7), dir = (tid >> 6) & 1, n = tid & 63;
      const f32x2 a = PW[((g * 2 + dir) * 65 + 64) * 64 + n];
      float xr = 0.f, xi = 0.f;
#pragma unroll 8
      for (int s = 0; s < 64; ++s) {
        const int c = dir ? 63 - s : s; const size_t nn = (size_t)g * 1024 + b * 64 + c;
        U5[nn * 1280 + 1024 + dir * 128 + n] = f2bf(xr); U5[nn * 1280 + 1024 + dir * 128 + 64 + n] = f2bf(xi);
        const float sr = SC[nn * 256 + dir * 128 + n], si = SC[nn * 256 + dir * 128 + 64 + n];
        const float nr = a[0] * xr - a[1] * xi + sr, ni = a[0] * xi + a[1] * xr + si;
        xr = nr; xi = ni;
      }
    }
  }
  const int hb = tid >> 8;
  dn_prep_loop(P, smem + hb * 78336, blockIdx.x * 2 + hb, (REP_PHASE == 41) ? gridDim.x * 2 / (P.p_hi - 7) : gridDim.x * 2, tid & 255);
}

constexpr int RB_BYTES = 60160;
struct DnLd { u64_t v[32]; float g; };
DI void dn_issue(const Params& P, DnLd& L, int seq, int cc, int lw, int lane) {
  const int b = seq >> 3, hd = seq & 7, dir = hd >> 2, h = hd & 3;
  const size_t item = (size_t)seq * 64 + cc;
  if (lw == 0) {
    const bf16_t* Wg = (const bf16_t*)(P.ws + OFF_WC) + item * 8192;
#pragma unroll
    for (int k = 0; k < 32; ++k) { const int idx = lane + 64 * k; L.v[k] = ld8_pinned(Wg + (idx >> 5) * 128 + (idx & 31) * 4); }
  } else if (lw == 1) {
    const bf16_t* Qn = (const bf16_t*)(P.ws + OFF_QN) + (size_t)(b * 4 + h) * SEQ * 128;
#pragma unroll
    for (int k = 0; k < 32; ++k) {
      const int idx = lane + 64 * k, row = idx >> 5, p = cc * 64 + row, l = dir ? (SEQ - 1 - p) : p;
      L.v[k] = ld8_pinned(Qn + (size_t)l * 128 + (idx & 31) * 4);
    }
  } else if (lw == 2) {
    const bf16_t* Kg = (const bf16_t*)(P.ws + OFF_KTT) + item * 8192;
#pragma unroll
    for (int k = 0; k < 32; ++k) { const int idx = lane + 64 * k; L.v[k] = ld8_pinned(Kg + (idx >> 4) * 64 + (idx & 15) * 4); }
  } else {
    const bf16_t* Ag = (const bf16_t*)(P.ws + OFF_ATT) + item * 4096;
#pragma unroll
    for (int k = 0; k < 16; ++k) { const int idx = lane + 64 * k; L.v[k] = ld8_pinned(Ag + (idx >> 4) * 64 + (idx & 15) * 4); }
    L.g = ld4_pinned((const float*)(P.ws + OFF_GC) + item * 64 + lane);
  }
}
DI void dn_commit(const DnLd& L, char* buf, int lw, int lane) {
  bf16_t* sW = (bf16_t*)buf; bf16_t* sQ = sW + 64 * 132; bf16_t* sA = sQ + 64 * 132; bf16_t* sKt = sA + 64 * 68;
  if (lw == 0) {
#pragma unroll
    for (int k = 0; k < 32; ++k) { const int idx = lane + 64 * k; *(u64_t*)(sW + (idx >> 5) * 132 + (idx & 31) * 4) = L.v[k]; }
  } else if (lw == 1) {
#pragma unroll
    for (int k = 0; k < 32; ++k) { const int idx = lane + 64 * k; *(u64_t*)(sQ + (idx >> 5) * 132 + (idx & 31) * 4) = L.v[k]; }
  } else if (lw == 2) {
#pragma unroll
    for (int k = 0; k < 32; ++k) { const int idx = lane + 64 * k; *(u64_t*)(sKt + (idx >> 4) * 68 + (idx & 15) * 4) = L.v[k]; }
  } else {
#pragma unroll
    for (int k = 0; k < 16; ++k) { const int idx = lane + 64 * k; *(u64_t*)(sA + (idx >> 4) * 68 + (idx & 15) * 4) = L.v[k]; }
    ((float*)(buf + 59904))[lane] = L.g;
  }
}
DI void dn_recur(const Params& P, char* smem, int seq) {
  const int tid = threadIdx.x, lane = tid & 63, w = __builtin_amdgcn_readfirstlane(tid >> 6), r = lane & 31, hh = lane >> 5;
  const int b = seq >> 3, hd = seq & 7, dir = hd >> 2, h = hd & 3;
  __syncthreads();
  if (w >= 4) {
    const int lw = w - 4;
    DnLd LA, LB;
    dn_issue(P, LA, seq, 0, lw, lane);
    dn_commit(LA, smem, lw, lane);
    dn_issue(P, LA, seq, 1, lw, lane);
    dn_issue(P, LB, seq, 2, lw, lane);
    lds_barrier();
    for (int cc = 0; cc < 64; cc += 2) {
      for (int rep = 0; rep <= DUPL; ++rep) { dn_commit(LA, smem + RB_BYTES, lw, lane); asm volatile("" ::: "memory"); }
      for (int rep = 0; rep <= DUPL; ++rep) { dn_issue(P, LA, seq, min(cc + 3, 63), lw, lane); asm volatile("" ::: "memory"); }
      lds_barrier();
      for (int rep = 0; rep <= DUPL; ++rep) { dn_commit(LB, smem, lw, lane); asm volatile("" ::: "memory"); }
      for (int rep = 0; rep <= DUPL; ++rep) { dn_issue(P, LB, seq, min(cc + 4, 63), lw, lane); asm volatile("" ::: "memory"); }
      lds_barrier();
    }
  } else {
    const int dv0 = 32 * w;
    const float* GC = (const float*)(P.ws + OFF_GC);
    bf16_t* O = (bf16_t*)P.out + (size_t)dir * NTOK * 512;
    f32x16 S[4];
#pragma unroll
    for (int t = 0; t < 4; ++t)
#pragma unroll
      for (int i = 0; i < 16; ++i) S[t][i] = 0.f;
    lds_barrier();
    for (int cc = 0; cc < 64; ++cc) {
      const size_t item = (size_t)seq * 64 + cc;
      const bf16_t* sW = (const bf16_t*)(smem + (cc & 1) * RB_BYTES); const bf16_t* sQ = sW + 64 * 132; const bf16_t* sA = sQ + 64 * 132; const bf16_t* sKt = sA + 64 * 68;
      const bf16_t* Ug = (const bf16_t*)(P.ws + OFF_UT) + item * 8192;
      f32x16 vn[2];
#pragma unroll
      for (int m = 0; m < 2; ++m)
#pragma unroll
        for (int g4 = 0; g4 < 4; ++g4) {
          const u32x2 u = *(const u32x2*)(Ug + (dv0 + r) * 64 + 32 * m + 8 * g4 + 4 * hh);
          vn[m][4 * g4 + 0] = bflo(u[0]); vn[m][4 * g4 + 1] = bfhi(u[0]); vn[m][4 * g4 + 2] = bflo(u[1]); vn[m][4 * g4 + 3] = bfhi(u[1]);
        }
      const float* sG = (const float*)(smem + (cc & 1) * RB_BYTES + 59904);
      const float egl = __expf(sG[63]);
      f32x16 aW[2], aQ[2];
#pragma unroll
      for (int m = 0; m < 2; ++m)
#pragma unroll
        for (int i = 0; i < 16; ++i) { aW[m][i] = 0.f; aQ[m][i] = 0.f; }
      bf16x8 fa[2][4];
      fa[0][0] = ldfrag(sW, r, 132, 4 * hh); fa[0][1] = ldfrag(sW, 32 + r, 132, 4 * hh);
      fa[0][2] = ldfrag(sQ, r, 132, 4 * hh); fa[0][3] = ldfrag(sQ, 32 + r, 132, 4 * hh);
#pragma unroll
      for (int ks = 0; ks < 8; ++ks) {
        const int cur = ks & 1, nxt = cur ^ 1;
        if (ks + 1 < 8) {
          fa[nxt][0] = ldfrag(sW, r, 132, 16 * (ks + 1) + 4 * hh); fa[nxt][1] = ldfrag(sW, 32 + r, 132, 16 * (ks + 1) + 4 * hh);
          fa[nxt][2] = ldfrag(sQ, r, 132, 16 * (ks + 1) + 4 * hh); fa[nxt][3] = ldfrag(sQ, 32 + r, 132, 16 * (ks + 1) + 4 * hh);
        }
        const bf16x8 sf = pack8(S[ks >> 1], ks & 1);
        aW[0] = MFMA32(fa[cur][0], sf, aW[0]); aW[1] = MFMA32(fa[cur][1], sf, aW[1]);
        aQ[0] = MFMA32(fa[cur][2], sf, aQ[0]); aQ[1] = MFMA32(fa[cur][3], sf, aQ[1]);
      }
      bf16x8 fA[4];
#pragma unroll
      for (int ks = 0; ks < 4; ++ks) fA[ks] = ldfrag(sA, r, 68, 16 * ks + 4 * hh);
#pragma unroll
      for (int m = 0; m < 2; ++m)
#pragma unroll
        for (int i = 0; i < 16; ++i) aQ[m][i] *= __expf(sG[32 * m + crow(i, hh)]);
#pragma unroll
      for (int m = 0; m < 2; ++m)
#pragma unroll
        for (int i = 0; i < 16; ++i) vn[m][i] -= aW[m][i];
      bf16x8 vf[4];
      vf[0] = pack8(vn[0], 0); vf[1] = pack8(vn[0], 1); vf[2] = pack8(vn[1], 0); vf[3] = pack8(vn[1], 1);
      bf16x8 fk[2][4];
#pragma unroll
      for (int ks = 0; ks < 4; ++ks) aQ[0] = MFMA32(fA[ks], vf[ks], aQ[0]);
#pragma unroll
      for (int ks = 0; ks < 4; ++ks) fA[ks] = ldfrag(sA, 32 + r, 68, 16 * ks + 4 * hh);
#pragma unroll
      for (int ks = 0; ks < 4; ++ks) fk[0][ks] = ldfrag(sKt, r, 68, 16 * ks + 4 * hh);
#pragma unroll
      for (int ks = 0; ks < 4; ++ks) aQ[1] = MFMA32(fA[ks], vf[ks], aQ[1]);
#pragma unroll
      for (int t = 0; t < 4; ++t) {
        const int cur = t & 1, nxt = cur ^ 1;
        if (t + 1 < 4) {
#pragma unroll
          for (int ks = 0; ks < 4; ++ks) fk[nxt][ks] = ldfrag(sKt, 32 * (t + 1) + r, 68, 16 * ks + 4 * hh);
        }
#pragma unroll
        for (int i = 0; i < 16; ++i) S[t][i] *= egl;
#pragma unroll
        for (int ks = 0; ks < 4; ++ks) S[t] = MFMA32(fk[cur][ks], vf[ks], S[t]);
      }
      {
        bf16_t* Ob = O + (size_t)b * SEQ * 512 + h * 128 + dv0 + r;
#pragma unroll
        for (int m = 0; m < 2; ++m)
#pragma unroll
          for (int i = 0; i < 16; ++i) {
            const int p = cc * 64 + 32 * m + crow(i, hh), l = dir ? (SEQ - 1 - p) : p;
            Ob[(size_t)l * 512] = f2bf(aQ[m][i]);
          }
      }
      lds_barrier();
    }
  }
}

DI void phase6(const Params& P, LAS unsigned char* lds, int ctr_off) {
  const int tid = threadIdx.x, lane = tid & 63, wid = tid >> 6, wr = wid >> 2, wc = wid & 3, fr = lane & 15, fq = lane >> 4;
  const bf16_t* MY = (const bf16_t*)(P.ws + OFF_MY); const bf16_t* U5 = (const bf16_t*)(P.ws + OFF_U5);
  bf16_t* Y5 = (bf16_t*)(P.ws + OFF_Y5);
  unsigned* ctr = (unsigned*)(P.ws + OFF_CTR) + ctr_off;
  LAS unsigned* sid = (LAS unsigned*)(lds + 131072);
  const int q0 = blockIdx.x & 7, pref = (blockIdx.x < 128 && gridDim.x > 128) ? 1 : 0;
  int step = 0;
  for (;;) {
    const int q = (q0 + (step >> 1)) & 7, part = pref ^ (step & 1), lim = part ? 16 : 48;
    __syncthreads();
    if (tid == 0) *sid = atomicAdd(ctr + part * 8 + q, 1u);
    __syncthreads();
    const int got = (int)*sid;
    if (got >= lim) { if (++step >= 16) break; continue; }
    const int idl = part ? 48 + got : got;
    const int g = q + 8 * (idl >> 4), tn = (idl >> 2) & 3, tm = idl & 3;
    f32x4 acc[2][2][4][2];
    gemm256<false>(MY + (size_t)(g * 1024 + tm * 256) * 1280, 1280, U5 + (size_t)(g * 1024 + tn * 256) * 1280, 1280, 1280, lds, acc);
#pragma unroll
    for (int ai = 0; ai < 2; ++ai)
#pragma unroll
      for (int bj = 0; bj < 2; ++bj)
#pragma unroll
        for (int m = 0; m < 4; ++m)
#pragma unroll
          for (int n = 0; n < 2; ++n) {
            const int row0 = tm * 256 + ai * 128 + wr * 64 + m * 16 + fq * 4, col = tn * 256 + bj * 128 + wc * 32 + n * 16 + fr;
            const int t = row0 >> 4, p = row0 & 15; const size_t tok = (size_t)col * 64 + t;
            const f32x4 v = acc[ai][bj][m][n];
            const u32x2 o = {pk2(gelu_tanh(v[0]), gelu_tanh(v[1])), pk2(gelu_tanh(v[2]), gelu_tanh(v[3]))};
            *(u32x2*)(Y5 + tok * 512 + g * 16 + p) = o;
          }
  }
}

DI void phase7(const Params& P, LAS unsigned char* lds) {
  const int tid = threadIdx.x, lane = tid & 63, wid = tid >> 6, wr = wid >> 2, wc = wid & 3, fr = lane & 15, fq = lane >> 4;
  const bf16_t* Y5 = (const bf16_t*)(P.ws + OFF_Y5); const bf16_t* GW = (const bf16_t*)(P.ws + OFF_GLUWT);
  const bf16_t* ZA = (const bf16_t*)(P.ws + OFF_ZA); const bf16_t* ZB = (const bf16_t*)(P.ws + OFF_ZB);
  bf16_t* YAB = (bf16_t*)(P.ws + OFF_YAB);
#pragma unroll 1
  for (int pass = 0; pass < 2; ++pass) {
  const bool gemm_now = (pass == 0) != (((blockIdx.x >> 3) & 1) != 0);
  if (gemm_now) {
  {
    const int bid = blockIdx.x, nbk = gridDim.x, nj = bid < 1024 ? (1024 - bid + nbk - 1) / nbk : 0;
    auto tile_of = [&](int j, int& tm, int& tn) { const int id = bid + j * nbk, grp = id >> 5, ig = id & 31; tm = grp * 8 + (ig & 7); tn = ig >> 3; };
    gemm256_stream<true, true>(nj, 8, 512, 512,
      [&](int j, const bf16_t*& A, const bf16_t*& Bt) { int tm, tn; tile_of(j, tm, tn); A = Y5 + (size_t)tm * 256 * 512; Bt = GW + (size_t)tn * 256 * 512; },
      [&](int j, f32x4 (&acc)[2][2][4][2]) {
        int tm, tn; tile_of(j, tm, tn);
        const int jc = tn * 128 + wc * 32 + fq * 8;
        f32x4 bv[2], bg[2];
#pragma unroll
        for (int n = 0; n < 2; ++n) { bv[n] = *(const f32x4*)(P.glu_b + jc + 4 * n); bg[n] = *(const f32x4*)(P.glu_b + 512 + jc + 4 * n); }
#pragma unroll
        for (int ai = 0; ai < 2; ++ai)
#pragma unroll
          for (int m = 0; m < 4; ++m) {
            const size_t t = (size_t)tm * 256 + ai * 128 + wr * 64 + m * 16 + fr;
            const u32x4 z = *(const u32x4*)(ZA + t * 512 + jc);
            float y[8];
#pragma unroll
            for (int n = 0; n < 2; ++n)
#pragma unroll
              for (int e = 0; e < 4; ++e) {
                const unsigned zz = z[2 * n + (e >> 1)]; const float zf = (e & 1) ? bfhi(zz) : bflo(zz);
                y[4 * n + e] = (acc[ai][0][m][n][e] + bv[n][e]) * sigmoidf_(acc[ai][1][m][n][e] + bg[n][e]) * siluf_(zf);
              }
            *(u32x4*)(YAB + t * 1024 + jc) = u32x4{pk2(y[0], y[1]), pk2(y[2], y[3]), pk2(y[4], y[5]), pk2(y[6], y[7])};
          }
      }, lds);
  }
  } else {
  const bf16_t* Of = (const bf16_t*)P.out; const bf16_t* Ob = Of + (size_t)NTOK * 512;
  float nw[8];
#pragma unroll
  for (int e = 0; e < 8; ++e) nw[e] = P.dn_norm_w[(lane & 15) * 8 + e];
  for (int t0 = (blockIdx.x * NWV + wid) * 4; t0 < NTOK; t0 += gridDim.x * NWV * 4) {
    u32x4 a[4], bq[4], z[4];
#pragma unroll
    for (int u = 0; u < 4; ++u) {
      const size_t off = (size_t)(t0 + u) * 512 + lane * 8;
      a[u] = *(const u32x4*)(Of + off); bq[u] = *(const u32x4*)(Ob + off); z[u] = *(const u32x4*)(ZB + off);
    }
#pragma unroll
    for (int u = 0; u < 4; ++u) {
      float o[8]; float ss = 0.f;
#pragma unroll
      for (int e = 0; e < 4; ++e) { o[2 * e] = bflo(a[u][e]) + bflo(bq[u][e]); o[2 * e + 1] = bfhi(a[u][e]) + bfhi(bq[u][e]); }
#pragma unroll
      for (int e = 0; e < 8; ++e) ss += o[e] * o[e];
#pragma unroll
      for (int sft = 1; sft < 16; sft <<= 1) ss += __shfl_xor(ss, sft);
      const float rs = rsqrtf(ss * (1.f / 128.f) + 1e-6f);
      float y[8];
#pragma unroll
      for (int e = 0; e < 4; ++e) { y[2 * e] = o[2 * e] * rs * nw[2 * e] * siluf_(bflo(z[u][e])); y[2 * e + 1] = o[2 * e + 1] * rs * nw[2 * e + 1] * siluf_(bfhi(z[u][e])); }
      *(u32x4*)(YAB + (size_t)(t0 + u) * 1024 + 512 + lane * 8) = u32x4{pk2(y[0], y[1]), pk2(y[2], y[3]), pk2(y[4], y[5]), pk2(y[6], y[7])};
    }
  }
  }
  }
}

DI void phase8_norm(const Params& P, const float* sss, int tm) {
  const int tid = threadIdx.x, lane = tid & 63, wid = tid >> 6;
  __syncthreads();
  for (int rr = 0; rr < 32; rr += 4) {
    f32x4 v[4][4];
#pragma unroll
    for (int u = 0; u < 4; ++u) {
      const f32x4* xr = (const f32x4*)(P.out + ((size_t)tm * 256 + wid * 32 + rr + u) * DM) + lane;
#pragma unroll
      for (int j = 0; j < 4; ++j) v[u][j] = xr[64 * j];
    }
#pragma unroll
    for (int u = 0; u < 4; ++u) {
      const int row = wid * 32 + rr + u;
      const f32x4 p4 = *(const f32x4*)(sss + row * 4);
      const float rstd = rsqrtf((p4[0] + p4[1] + p4[2] + p4[3]) * (1.f / DM) + 1e-6f);
      f32x4* xr = (f32x4*)(P.out + ((size_t)tm * 256 + row) * DM) + lane;
#pragma unroll
      for (int j = 0; j < 4; ++j) {
        const f32x4 fw = *(const f32x4*)(P.final_norm_w + lane * 4 + 256 * j);
        f32x4 o;
#pragma unroll
        for (int e = 0; e < 4; ++e) o[e] = v[u][j][e] * rstd * fw[e];
        xr[64 * j] = o;
      }
    }
  }
  __syncthreads();
}
DI void phase8(const Params& P, LAS unsigned char* lds) {
  const int tid = threadIdx.x, lane = tid & 63, wid = tid >> 6, wr = wid >> 2, wc = wid & 3, fr = lane & 15, fq = lane >> 4;
  const bf16_t* YAB = (const bf16_t*)(P.ws + OFF_YAB); const bf16_t* W = (const bf16_t*)(P.ws + OFF_WOUTT);
  const float* mod = (const float*)(P.ws + OFF_MOD);
  float* sss = (float*)((char*)lds + 131072 + 64);
  for (int id = blockIdx.x * 4; id < 1024; id = ((id & 3) == 3) ? id - 3 + gridDim.x * 4 : id + 1) {
    const int tm = id >> 2, tn = id & 3;
    if (tn == 0) { for (int e = tid; e < 1024; e += NTHR) sss[e] = 0.f; }
    {
      f32x4 acc[2][2][4][2];
      gemm256<true, true>(YAB + (size_t)tm * 256 * 1024, 1024, W + (size_t)tn * 256 * 1024, 1024, 1024, lds, acc);
      f32x4 gvv[2][2];
#pragma unroll
      for (int bj = 0; bj < 2; ++bj)
#pragma unroll
        for (int n = 0; n < 2; ++n) gvv[bj][n] = *(const f32x4*)(mod + ((tm * 256) >> 12) * 3072 + 2048 + tn * 256 + bj * 128 + wc * 32 + fq * 8 + 4 * n);
#pragma unroll
      for (int ai = 0; ai < 2; ++ai)
#pragma unroll
        for (int m = 0; m < 4; ++m) {
          const size_t t = (size_t)tm * 256 + ai * 128 + wr * 64 + m * 16 + fr;
          float ssv = 0.f;
#pragma unroll
          for (int bj = 0; bj < 2; ++bj)
#pragma unroll
            for (int n = 0; n < 2; ++n) {
              const int col = tn * 256 + bj * 128 + wc * 32 + fq * 8 + 4 * n;
              const f32x4 xv = *(const f32x4*)(P.x + t * DM + col), gv = gvv[bj][n];
              f32x4 o;
#pragma unroll
              for (int e = 0; e < 4; ++e) { o[e] = xv[e] + gv[e] * acc[ai][bj][m][n][e]; ssv += o[e] * o[e]; }
              *(f32x4*)(P.out + t * DM + col) = o;
            }
          ssv += __shfl_xor(ssv, 16); ssv += __shfl_xor(ssv, 32);
          if (fq == 0) sss[(ai * 128 + wr * 64 + m * 16 + fr) * 4 + wc] += ssv;
        }
    }
    if (tn == 3) phase8_norm(P, sss, tm);
  }
}
DI void phase9(const Params& P) {
  const int tid = threadIdx.x, lane = tid & 63, wid = tid >> 6;
  for (int row0 = (blockIdx.x * NWV + wid) * 4; row0 < NTOK; row0 += gridDim.x * NWV * 4) {
    f32x4 v[4][4];
#pragma unroll
    for (int u = 0; u < 4; ++u) {
      const f32x4* xr = (const f32x4*)(P.out + (size_t)(row0 + u) * DM) + lane;
#pragma unroll
      for (int j = 0; j < 4; ++j) v[u][j] = xr[64 * j];
    }
#pragma unroll
    for (int u = 0; u < 4; ++u) {
      f32x4* xr = (f32x4*)(P.out + (size_t)(row0 + u) * DM) + lane;
      float s = 0.f;
#pragma unroll
      for (int j = 0; j < 4; ++j) s += v[u][j][0] * v[u][j][0] + v[u][j][1] * v[u][j][1] + v[u][j][2] * v[u][j][2] + v[u][j][3] * v[u][j][3];
      const float rstd = rsqrtf(wave_sum(s) * (1.f / DM) + 1e-6f);
#pragma unroll
      for (int j = 0; j < 4; ++j) {
        const f32x4 fw = *(const f32x4*)(P.final_norm_w + lane * 4 + 256 * j);
        f32x4 o;
#pragma unroll
        for (int e = 0; e < 4; ++e) o[e] = v[u][j][e] * rstd * fw[e];
        xr[64 * j] = o;
      }
    }
  }
}

#ifndef SPLIT56
#define SPLIT56 0
#endif
DI void phase5(const Params& P, char* smem, LAS unsigned char* lds) {
  for (int seq = blockIdx.x; seq < 128; seq += gridDim.x) dn_recur(P, smem, seq);
  if (!SPLIT56) phase6(P, lds, 0);
}
constexpr int LDS_BYTES = 160 * 1024;
__global__ void __launch_bounds__(NTHR) hybrid_fwd(Params P) {
  extern __shared__ __attribute__((aligned(16))) unsigned char lds_raw[];
  LAS unsigned char* lds = (LAS unsigned char*)lds_raw;
  char* smem = (char*)lds_raw;
  cg::grid_group grid = cg::this_grid();
#define SEAM(p) if (P.p_lo < (p) && P.p_hi >= (p)) grid.sync()
#ifndef PH_MASK
#define PH_MASK 0x3ff
#endif
#define RUN(p, call) if (((PH_MASK >> (p)) & 1) && P.p_lo <= (p) && P.p_hi >= (p)) { const int nrep_ = (REP_PHASE == (p)) ? P.p_hi - 7 : 1; for (int rep_ = 0; rep_ < nrep_; ++rep_) { if (rep_) grid.sync(); call; } }
  RUN(0, phase0(P, smem));
  SEAM(1);
  RUN(1, phase1(P, smem));
  SEAM(2);
  RUN(2, phase2(P, lds));
  SEAM(3);
  RUN(3, phase3(P, lds));
  SEAM(4);
  RUN(4, phase4(P, smem));
  SEAM(5);
  RUN(5, phase5(P, smem, lds));
  if (SPLIT56) { SEAM(6); RUN(6, phase6(P, lds, 0)); }
  SEAM(7);
  RUN(7, phase7(P, lds));
  SEAM(8);
  RUN(8, phase8(P, lds));
}

extern "C" void kernel_launch(void* const* d_in, const int* in_sizes, int n_in, void* d_out, int out_size, void* d_ws, size_t ws_size, hipStream_t stream) {
  static int grid_blocks = 0;
  if (!grid_blocks) {
    int dev = 0, cus = 0, per_cu = 0;
    (void)hipGetDevice(&dev);
    (void)hipDeviceGetAttribute(&cus, hipDeviceAttributeMultiprocessorCount, dev);
    (void)hipFuncSetAttribute((const void*)hybrid_fwd, hipFuncAttributeMaxDynamicSharedMemorySize, LDS_BYTES);
    (void)hipOccupancyMaxActiveBlocksPerMultiprocessor(&per_cu, (const void*)hybrid_fwd, NTHR, LDS_BYTES);
    if (per_cu < 1) per_cu = 1;
    if (per_cu > 1) per_cu = 1;
    grid_blocks = cus * per_cu;
    if (ws_size < WS_END) fprintf(stderr, "workspace too small: %zu < %zu\n", ws_size, (size_t)WS_END);
  }
  Params p{};
  const float* const* in = (const float* const*)d_in;
  p.x = in[0]; p.c = in[1]; p.ada_w = in[2]; p.ada_b = in[3]; p.norm_w = in[4]; p.w_in = in[5]; p.conv_w = in[6];
  p.a_log[0] = in[7]; p.dt_bias[0] = in[8]; p.a_log[1] = in[9]; p.dt_bias[1] = in[10]; p.dn_norm_w = in[11];
  for (int d = 0; d < 2; ++d) {
    const int o = 12 + 7 * d;
    p.lam_re[d] = in[o]; p.lam_im[d] = in[o + 1]; p.log_step[d] = in[o + 2]; p.b_re[d] = in[o + 3]; p.b_im[d] = in[o + 4]; p.c_re[d] = in[o + 5]; p.c_im[d] = in[o + 6];
  }
  p.s5_d = in[26]; p.glu_w = in[27]; p.glu_b = in[28]; p.w_out = in[29]; p.final_norm_w = in[30];
  p.out = (float*)d_out; p.ws = (char*)d_ws;
#if N_LAUNCH_MODE == 1
  for (int ph = 0; ph <= 9; ++ph) {
    p.p_lo = ph; p.p_hi = ph;
    hipLaunchKernelGGL(hybrid_fwd, dim3(grid_blocks), dim3(NTHR), LDS_BYTES, stream, p);
  }
#else
  p.p_lo = 0; p.p_hi = 9;
  void* args[] = {&p};
  hipError_t e = hipLaunchCooperativeKernel((const void*)hybrid_fwd, dim3(grid_blocks), dim3(NTHR), args, LDS_BYTES, stream);
  if (e != hipSuccess) fprintf(stderr, "cooperative launch failed: %s (grid %d)\n", hipGetErrorString(e), grid_blocks);
#endif
}
```

```cpp
#include <hip/hip_runtime.h>
#include <hip/hip_cooperative_groups.h>
#include <cstdio>
#include <cstdint>
namespace cg = cooperative_groups;

#ifndef N_LAUNCH_MODE
#define N_LAUNCH_MODE 0
#endif
#ifndef REP_PHASE
#define REP_PHASE -1
#endif

#define DUPST 0
#ifndef DUPL
#define DUPL 0
#endif
#define DI __device__ __forceinline__
#define LAS __attribute__((address_space(3)))
constexpr int NTHR = 512, NWV = 8;
typedef unsigned short bf16_t;
typedef short bf16x8 __attribute__((ext_vector_type(8)));
typedef float f32x4 __attribute__((ext_vector_type(4)));
typedef float f32x2 __attribute__((ext_vector_type(2)));
typedef float f32x16 __attribute__((ext_vector_type(16)));
typedef unsigned u32x4 __attribute__((ext_vector_type(4)));
typedef unsigned u32x2 __attribute__((ext_vector_type(2)));
typedef __bf16 bf2_t __attribute__((ext_vector_type(2)));

constexpr int DM = 1024, NB = 16, SEQ = 4096, NTOK = NB * SEQ;
constexpr int INC = 3088, INP = 3328;
constexpr size_t MiB = 1u << 20;
constexpr size_t OFF_HB = 0;
constexpr size_t OFF_QKVRAW = 128 * MiB;
constexpr size_t OFF_WC = 0;
constexpr size_t OFF_UT = 128 * MiB;
constexpr size_t OFF_ATT = 256 * MiB;
constexpr size_t OFF_Y5 = 656 * MiB;
constexpr size_t OFF_U5 = 320 * MiB;
constexpr size_t OFF_ZA = 400 * MiB;
constexpr size_t OFF_ZB = 464 * MiB;
constexpr size_t OFF_QN = 528 * MiB;
constexpr size_t OFF_KN = 592 * MiB;
constexpr size_t OFF_VN = 656 * MiB;
constexpr size_t OFF_YAB = 528 * MiB;
constexpr size_t OFF_MY = 720 * MiB;
constexpr size_t OFF_MS = 800 * MiB;
constexpr size_t OFF_KTT = 816 * MiB;
constexpr size_t OFF_WINT = 944 * MiB;
constexpr size_t OFF_GLUWT = 952 * MiB;
constexpr size_t OFF_WOUTT = 953 * MiB;
constexpr size_t OFF_BA = 955 * MiB;
constexpr size_t OFF_GC = 959 * MiB;
constexpr size_t OFF_KTAB = 961 * MiB;
constexpr size_t OFF_PW = 965 * MiB;
constexpr size_t OFF_FB = 968 * MiB;
constexpr size_t OFF_MOD = 969 * MiB;
constexpr size_t OFF_CTR = 969 * MiB + 512 * 1024;
constexpr size_t WS_END = 970 * MiB;

struct Params {
  const float *x, *c, *ada_w, *ada_b, *norm_w, *w_in, *conv_w;
  const float *a_log[2], *dt_bias[2], *dn_norm_w;
  const float *lam_re[2], *lam_im[2], *log_step[2], *b_re[2], *b_im[2], *c_re[2], *c_im[2];
  const float *s5_d, *glu_w, *glu_b, *w_out, *final_norm_w;
  float* out;
  char* ws;
  int p_lo, p_hi;
};

DI unsigned pk2(float a, float b) { f32x2 v = {a, b}; bf2_t r = __builtin_convertvector(v, bf2_t); return __builtin_bit_cast(unsigned, r); }
DI bf16_t f2bf(float a) { return (bf16_t)(pk2(a, 0.f) & 0xffffu); }
DI float bf2f(bf16_t v) { return __uint_as_float(((unsigned)v) << 16); }
DI float bflo(unsigned u) { return __uint_as_float(u << 16); }
DI float bfhi(unsigned u) { return __uint_as_float(u & 0xffff0000u); }
DI float sigmoidf_(float x) { return 1.f / (1.f + __expf(-x)); }
DI float siluf_(float x) { return x / (1.f + __expf(-x)); }
DI float gelu_tanh(float x) { float u = 0.7978845608028654f * (x + 0.044715f * x * x * x); float e = __expf(2.f * u); float t = 1.f - 2.f / (e + 1.f); return 0.5f * x * (1.f + t); }
DI float softplusf_(float x) { return x > 15.f ? x : log1pf(expf(x)); }
DI float wave_sum(float v) {
#pragma unroll
  for (int o = 1; o < 64; o <<= 1) v += __shfl_xor(v, o);
  return v;
}
DI void lds_barrier() { asm volatile("s_waitcnt lgkmcnt(0)" ::: "memory"); __builtin_amdgcn_s_barrier(); asm volatile("" ::: "memory"); }
typedef unsigned long long u64_t;
DI u64_t ld8_pinned(const void* p) { return __hip_atomic_load((const u64_t*)p, __ATOMIC_RELAXED, __HIP_MEMORY_SCOPE_WORKGROUP); }
DI float ld4_pinned(const void* p) { return __builtin_bit_cast(float, __hip_atomic_load((const unsigned*)p, __ATOMIC_RELAXED, __HIP_MEMORY_SCOPE_WORKGROUP)); }
DI int crow(int reg, int h) { return (reg & 3) + 8 * (reg >> 2) + 4 * h; }
DI bf16x8 pack8(const f32x16& x, int s) {
  u32x4 p;
  p[0] = pk2(x[8 * s + 0], x[8 * s + 1]); p[1] = pk2(x[8 * s + 2], x[8 * s + 3]);
  p[2] = pk2(x[8 * s + 4], x[8 * s + 5]); p[3] = pk2(x[8 * s + 6], x[8 * s + 7]);
  return __builtin_bit_cast(bf16x8, p);
}
DI bf16x8 ldfrag(const bf16_t* base, int row, int stride, int col) {
  const bf16_t* p = base + row * stride + col;
  u32x2 lo = *(const u32x2*)p, hi = *(const u32x2*)(p + 8);
  u32x4 v = {lo[0], lo[1], hi[0], hi[1]};
  return __builtin_bit_cast(bf16x8, v);
}
#define MFMA32(a, b, c) __builtin_amdgcn_mfma_f32_32x32x16_bf16((a), (b), (c), 0, 0, 0)
#define MFMA16(a, b, c) __builtin_amdgcn_mfma_f32_16x16x32_bf16((a), (b), (c), 0, 0, 0)

constexpr int G_HTB = 128 * 64 * 2;
DI int lds_byte(int r, int c) { const int st = (r >> 4) * 2 + (c >> 5), rr = r & 15, cc = c & 31, ob = rr * 64 + cc * 2; return st * 1024 + (ob ^ (((ob >> 9) & 1) << 5)); }
DI void stage_rc(int b, int& R, int& C) { const int st = b / 1024, sb = b % 1024, swz = sb ^ (((sb >> 9) & 1) << 5); R = (st >> 1) * 16 + swz / 64; C = (st & 1) * 32 + (swz % 64) / 2; }
template <bool TRANS, bool PERM = false>
DI void gemm256(const bf16_t* __restrict__ A, int lda, const bf16_t* __restrict__ Bt, int ldb, int K, LAS unsigned char* lds, f32x4 (&acc)[2][2][4][2]) {
  const int tid = threadIdx.x, wid = __builtin_amdgcn_readfirstlane(tid >> 6), lane = tid & 63, wr = wid >> 2, wc = wid & 3, fr = lane & 15, fq = lane >> 4;
  unsigned voffA[2], voffB[2];
#pragma unroll
  for (int i = 0; i < 2; ++i) {
    int R, C; stage_rc(tid * 16 + i * 8192, R, C);
    const int Rb = PERM ? ((R & ~31) + 8 * ((R & 15) >> 2) + 4 * ((R >> 4) & 1) + (R & 3)) : R;
    voffA[i] = (unsigned)(R * lda + C) * 2u; voffB[i] = (unsigned)(Rb * ldb + C) * 2u;
  }
  const unsigned ldsw = (unsigned)wid * 1024u;
  const int aoff = lds_byte(wr * 64 + fr, fq * 8), boff = lds_byte(wc * 32 + fr, fq * 8);
  const char* cA0 = (const char*)A; const char* cA1 = cA0 + (size_t)128 * lda * 2;
  const char* cB0 = (const char*)Bt; const char* cB1 = cB0 + (size_t)128 * ldb * 2;
#define G_SA(b, h) (((b) * 2 + (h)) * G_HTB)
#define G_SB(b, h) ((4 + (b) * 2 + (h)) * G_HTB)
#define G_STAGE(bufoff, gbase, voff, kt) do { _Pragma("unroll") for (int _i = 0; _i < 2; ++_i) \
    __builtin_amdgcn_global_load_lds((const unsigned*)((gbase) + (size_t)(kt) * 128 + (voff)[_i]), (LAS unsigned*)(lds + (bufoff) + ldsw + _i * 8192), 16, 0, 0); } while (0)
#define G_LDA(dst, b, h) do { _Pragma("unroll") for (int m = 0; m < 4; ++m) _Pragma("unroll") for (int k = 0; k < 2; ++k) dst[m][k] = *(const LAS bf16x8*)(lds + G_SA(b, h) + aoff + m * 2048 + k * 1024); } while (0)
#define G_LDB(dst, b, h) do { _Pragma("unroll") for (int n = 0; n < 2; ++n) _Pragma("unroll") for (int k = 0; k < 2; ++k) dst[n][k] = *(const LAS bf16x8*)(lds + G_SB(b, h) + boff + n * 2048 + k * 1024); } while (0)
#define G_MMA(ai, bj, At_, Bt_) do { __builtin_amdgcn_s_setprio(1); _Pragma("unroll") for (int m = 0; m < 4; ++m) _Pragma("unroll") for (int n = 0; n < 2; ++n) _Pragma("unroll") for (int k = 0; k < 2; ++k) \
    acc[ai][bj][m][n] = TRANS ? MFMA16(Bt_[n][k], At_[m][k], acc[ai][bj][m][n]) : MFMA16(At_[m][k], Bt_[n][k], acc[ai][bj][m][n]); __builtin_amdgcn_s_setprio(0); } while (0)
#define G_WAIT_V(n) asm volatile("s_waitcnt vmcnt(" #n ")" ::: "memory")
#define G_WAIT_L(n) asm volatile("s_waitcnt lgkmcnt(" #n ")" ::: "memory")
#define G_BAR __builtin_amdgcn_s_barrier()
#define G_SCHED __builtin_amdgcn_sched_barrier(0)
#pragma unroll
  for (int a = 0; a < 2; ++a)
#pragma unroll
    for (int b = 0; b < 2; ++b)
#pragma unroll
      for (int m = 0; m < 4; ++m)
#pragma unroll
        for (int n = 0; n < 2; ++n) acc[a][b][m][n] = f32x4{0.f, 0.f, 0.f, 0.f};
  bf16x8 At[4][2], B0[2][2], B1[2][2];
  const int nt = K / 64;
  G_WAIT_V(0); G_WAIT_L(0); G_BAR;
  G_STAGE(G_SB(0, 0), cB0, voffB, 0); G_STAGE(G_SA(0, 0), cA0, voffA, 0);
  G_STAGE(G_SB(0, 1), cB1, voffB, 0); G_STAGE(G_SA(0, 1), cA1, voffA, 0);
  if (wr == 1) G_BAR;
  G_WAIT_V(4); G_BAR;
  G_STAGE(G_SB(1, 0), cB0, voffB, 1); G_STAGE(G_SA(1, 0), cA0, voffA, 1); G_STAGE(G_SB(1, 1), cB1, voffB, 1);
  G_WAIT_V(6); G_BAR;
  for (int t = 0; t < nt - 2; t += 2) {
    G_LDB(B0, 0, 0); G_SCHED; G_LDA(At, 0, 0); G_STAGE(G_SA(1, 1), cA1, voffA, t + 1);
    G_WAIT_L(8); G_BAR; G_WAIT_L(0); G_MMA(0, 0, At, B0); G_BAR; G_SCHED;
    G_LDB(B1, 0, 1); G_STAGE(G_SB(0, 0), cB0, voffB, t + 2);
    G_BAR; G_WAIT_L(0); G_MMA(0, 1, At, B1); G_BAR;
    G_LDA(At, 0, 1); G_STAGE(G_SA(0, 0), cA0, voffA, t + 2);
    G_BAR; G_WAIT_L(0); G_MMA(1, 0, At, B0); G_BAR; G_SCHED;
    G_STAGE(G_SB(0, 1), cB1, voffB, t + 2);
    G_WAIT_V(6); G_BAR; G_MMA(1, 1, At, B1); G_BAR;
    G_LDB(B0, 1, 0); G_SCHED; G_LDA(At, 1, 0); G_STAGE(G_SA(0, 1), cA1, voffA, t + 2);
    G_WAIT_L(8); G_BAR; G_WAIT_L(0); G_MMA(0, 0, At, B0); G_BAR; G_SCHED;
    G_LDB(B1, 1, 1); G_STAGE(G_SB(1, 0), cB0, voffB, t + 3);
    G_BAR; G_WAIT_L(0); G_MMA(0, 1, At, B1); G_BAR;
    G_LDA(At, 1, 1); G_STAGE(G_SA(1, 0), cA0, voffA, t + 3);
    G_BAR; G_WAIT_L(0); G_MMA(1, 0, At, B0); G_BAR; G_SCHED;
    G_STAGE(G_SB(1, 1), cB1, voffB, t + 3);
    G_WAIT_V(6); G_BAR; G_MMA(1, 1, At, B1); G_BAR;
  }
  { G_LDB(B0, 0, 0); G_LDA(At, 0, 0); G_STAGE(G_SA(1, 1), cA1, voffA, nt - 1);
    G_BAR; G_WAIT_L(0); G_MMA(0, 0, At, B0); G_BAR;
    G_LDB(B1, 0, 1); G_BAR; G_WAIT_L(0); G_MMA(0, 1, At, B1); G_BAR;
    G_LDA(At, 0, 1); G_WAIT_V(4); G_BAR; G_WAIT_L(0); G_MMA(1, 0, At, B0); G_MMA(1, 1, At, B1); G_BAR; }
  { G_LDB(B0, 1, 0); G_LDA(At, 1, 0); G_WAIT_V(2); G_BAR; G_WAIT_L(0); G_MMA(0, 0, At, B0); G_BAR;
    G_LDB(B1, 1, 1); G_WAIT_V(0); G_BAR; G_WAIT_L(0); G_MMA(0, 1, At, B1); G_BAR;
    G_LDA(At, 1, 1); G_BAR; G_WAIT_L(0); G_MMA(1, 0, At, B0); G_MMA(1, 1, At, B1); G_BAR; }
  if (wr == 0) G_BAR;
}

template <bool TRANS, bool PERM, class TileFn, class EpiFn>
DI void gemm256_stream(int nj, int nt, int lda, int ldb, TileFn tilefn, EpiFn epifn, LAS unsigned char* lds) {
  if (nj <= 0) return;
  const int tid = threadIdx.x, wid = __builtin_amdgcn_readfirstlane(tid >> 6), lane = tid & 63, wr = wid >> 2, wc = wid & 3, fr = lane & 15, fq = lane >> 4;
  unsigned voffA[2], voffB[2];
#pragma unroll
  for (int i = 0; i < 2; ++i) {
    int R, C; stage_rc(tid * 16 + i * 8192, R, C);
    const int Rb = PERM ? ((R & ~31) + 8 * ((R & 15) >> 2) + 4 * ((R >> 4) & 1) + (R & 3)) : R;
    voffA[i] = (unsigned)(R * lda + C) * 2u; voffB[i] = (unsigned)(Rb * ldb + C) * 2u;
  }
  const unsigned ldsw = (unsigned)wid * 1024u;
  const int aoff = lds_byte(wr * 64 + fr, fq * 8), boff = lds_byte(wc * 32 + fr, fq * 8);
  const size_t hA = (size_t)128 * lda * 2, hB = (size_t)128 * ldb * 2;
  const char *cA, *cB, *nA, *nB;
  { const bf16_t *a, *b; tilefn(0, a, b); cA = (const char*)a; cB = (const char*)b; nA = cA; nB = cB; if (nj > 1) { tilefn(1, a, b); nA = (const char*)a; nB = (const char*)b; } }
  int j = 0, tbeg = 0, tend = nt;
#define GS_A(g, h) (((g) < tend ? cA + (size_t)((g) - tbeg) * 128 : nA + (size_t)((g) - tend) * 128) + (h) * hA)
#define GS_B(g, h) (((g) < tend ? cB + (size_t)((g) - tbeg) * 128 : nB + (size_t)((g) - tend) * 128) + (h) * hB)
#define GS_STAGE(bufoff, gptr, voff) do { const char* _p = (gptr); _Pragma("unroll") for (int _i = 0; _i < 2; ++_i) \
    __builtin_amdgcn_global_load_lds((const unsigned*)(_p + (voff)[_i]), (LAS unsigned*)(lds + (bufoff) + ldsw + _i * 8192), 16, 0, 0); } while (0)
  f32x4 acc[2][2][4][2];
#pragma unroll
  for (int a = 0; a < 2; ++a)
#pragma unroll
    for (int b = 0; b < 2; ++b)
#pragma unroll
      for (int m = 0; m < 4; ++m)
#pragma unroll
        for (int n = 0; n < 2; ++n) acc[a][b][m][n] = f32x4{0.f, 0.f, 0.f, 0.f};
  bf16x8 At[4][2], B0[2][2], B1[2][2];
  const int total = nj * nt;
  G_WAIT_V(0); G_WAIT_L(0); G_BAR;
  GS_STAGE(G_SB(0, 0), GS_B(0, 0), voffB); GS_STAGE(G_SA(0, 0), GS_A(0, 0), voffA);
  GS_STAGE(G_SB(0, 1), GS_B(0, 1), voffB); GS_STAGE(G_SA(0, 1), GS_A(0, 1), voffA);
  if (wr == 1) G_BAR;
  G_WAIT_V(4); G_BAR;
  GS_STAGE(G_SB(1, 0), GS_B(1, 0), voffB); GS_STAGE(G_SA(1, 0), GS_A(1, 0), voffA); GS_STAGE(G_SB(1, 1), GS_B(1, 1), voffB);
  G_WAIT_V(6); G_BAR;
  for (int t = 0; t < total - 2; t += 2) {
    G_LDB(B0, 0, 0); G_SCHED; G_LDA(At, 0, 0); GS_STAGE(G_SA(1, 1), GS_A(t + 1, 1), voffA);
    G_WAIT_L(8); G_BAR; G_WAIT_L(0); G_MMA(0, 0, At, B0); G_BAR; G_SCHED;
    G_LDB(B1, 0, 1); GS_STAGE(G_SB(0, 0), GS_B(t + 2, 0), voffB);
    G_BAR; G_WAIT_L(0); G_MMA(0, 1, At, B1); G_BAR;
    G_LDA(At, 0, 1); GS_STAGE(G_SA(0, 0), GS_A(t + 2, 0), voffA);
    G_BAR; G_WAIT_L(0); G_MMA(1, 0, At, B0); G_BAR; G_SCHED;
    GS_STAGE(G_SB(0, 1), GS_B(t + 2, 1), voffB);
    G_WAIT_V(6); G_BAR; G_MMA(1, 1, At, B1); G_BAR;
    G_LDB(B0, 1, 0); G_SCHED; G_LDA(At, 1, 0); GS_STAGE(G_SA(0, 1), GS_A(t + 2, 1), voffA);
    G_WAIT_L(8); G_BAR; G_WAIT_L(0); G_MMA(0, 0, At, B0); G_BAR; G_SCHED;
    G_LDB(B1, 1, 1); GS_STAGE(G_SB(1, 0), GS_B(t + 3, 0), voffB);
    G_BAR; G_WAIT_L(0); G_MMA(0, 1, At, B1); G_BAR;
    G_LDA(At, 1, 1); GS_STAGE(G_SA(1, 0), GS_A(t + 3, 0), voffA);
    G_BAR; G_WAIT_L(0); G_MMA(1, 0, At, B0); G_BAR; G_SCHED;
    GS_STAGE(G_SB(1, 1), GS_B(t + 3, 1), voffB);
    G_WAIT_V(6); G_BAR; G_MMA(1, 1, At, B1); G_BAR;
    if (t + 2 == tend) {
      epifn(j, acc);
#pragma unroll
      for (int a = 0; a < 2; ++a)
#pragma unroll
        for (int b = 0; b < 2; ++b)
#pragma unroll
          for (int m = 0; m < 4; ++m)
#pragma unroll
            for (int n = 0; n < 2; ++n) acc[a][b][m][n] = f32x4{0.f, 0.f, 0.f, 0.f};
      ++j; tbeg = tend; tend += nt; cA = nA; cB = nB;
      if (j + 1 < nj) { const bf16_t *a, *b; tilefn(j + 1, a, b); nA = (const char*)a; nB = (const char*)b; }
    }
  }
  { G_LDB(B0, 0, 0); G_LDA(At, 0, 0); GS_STAGE(G_SA(1, 1), GS_A(total - 1, 1), voffA);
    G_BAR; G_WAIT_L(0); G_MMA(0, 0, At, B0); G_BAR;
    G_LDB(B1, 0, 1); G_BAR; G_WAIT_L(0); G_MMA(0, 1, At, B1); G_BAR;
    G_LDA(At, 0, 1); G_WAIT_V(4); G_BAR; G_WAIT_L(0); G_MMA(1, 0, At, B0); G_MMA(1, 1, At, B1); G_BAR; }
  { G_LDB(B0, 1, 0); G_LDA(At, 1, 0); G_WAIT_V(2); G_BAR; G_WAIT_L(0); G_MMA(0, 0, At, B0); G_BAR;
    G_LDB(B1, 1, 1); G_WAIT_V(0); G_BAR; G_WAIT_L(0); G_MMA(0, 1, At, B1); G_BAR;
    G_LDA(At, 1, 1); G_BAR; G_WAIT_L(0); G_MMA(1, 0, At, B0); G_MMA(1, 1, At, B1); G_BAR; }
  if (wr == 0) G_BAR;
  epifn(j, acc);
}

DI void p0_mod_item(const Params& P, char* smem, int it) {
  float* ssil = (float*)smem;
  float* sred = ssil + 16 * 1024;
  const int tid = threadIdx.x, cl = tid & 31, ks = tid >> 5, col = it * 32 + cl;
  __syncthreads();
  for (int e = tid; e < 16 * 1024; e += NTHR) ssil[e] = siluf_(P.c[e]);
  __syncthreads();
  float acc[16];
#pragma unroll
  for (int b = 0; b < 16; ++b) acc[b] = 0.f;
#pragma unroll 1
  for (int k0 = ks * 64; k0 < ks * 64 + 64; k0 += 16) {
    float w[16];
#pragma unroll
    for (int u = 0; u < 16; ++u) w[u] = P.ada_w[(size_t)(k0 + u) * 3072 + col];
#pragma unroll
    for (int u = 0; u < 16; ++u)
#pragma unroll
      for (int b = 0; b < 16; ++b) acc[b] += ssil[b * 1024 + k0 + u] * w[u];
  }
#pragma unroll
  for (int b = 0; b < 16; ++b) sred[(ks * 16 + b) * 32 + cl] = acc[b];
  __syncthreads();
  {
    const int b = tid >> 5;
    float s = P.ada_b[col];
#pragma unroll
    for (int k2 = 0; k2 < 16; ++k2) s += sred[(k2 * 16 + b) * 32 + cl];
    ((float*)(P.ws + OFF_MOD))[b * 3072 + col] = s;
  }
}
DI void p0_transpose_item(const float* __restrict__ src, int N, int K, int k0, int srcn0, int nvalid, bf16_t* __restrict__ dst, int dstn0, float* s, int tid) {
  const int n = tid & 31, kr = tid >> 5;
#pragma unroll
  for (int i = 0; i < 8; ++i) { const int k = kr + 8 * i; s[k * 33 + n] = (n < nvalid) ? src[(size_t)(k0 + k) * N + srcn0 + n] : 0.f; }
  __syncthreads();
  const int on = tid >> 3, kc = tid & 7;
  u32x4 o;
  o[0] = pk2(s[(kc * 8 + 0) * 33 + on], s[(kc * 8 + 1) * 33 + on]); o[1] = pk2(s[(kc * 8 + 2) * 33 + on], s[(kc * 8 + 3) * 33 + on]);
  o[2] = pk2(s[(kc * 8 + 4) * 33 + on], s[(kc * 8 + 5) * 33 + on]); o[3] = pk2(s[(kc * 8 + 6) * 33 + on], s[(kc * 8 + 7) * 33 + on]);
  *(u32x4*)(dst + (size_t)(dstn0 + on) * K + k0 + kc * 8) = o;
  __syncthreads();
}
DI void s5_lambda(const Params& P, int g, int dir, int n, float& dt, float& lr, float& li) {
  dt = expf(P.log_step[dir][g]); lr = P.lam_re[dir][g * 64 + n]; li = P.lam_im[dir][g * 64 + n];
}
DI void cpow(float dt, float lr, float li, float e, float& re, float& im) {
  const float mag = __expf(lr * dt * e), x = li * dt * e;
  const float n = rintf(x * 0.15915494309189535f);
  const float y = fmaf(n, -6.2831854820251465f, x) + n * 1.7484556000744883e-7f;
  re = mag * __cosf(y); im = mag * __sinf(y);
}
DI void s5_f(float dt, float lr, float li, float& fre, float& fim) {
  float ar, ai; cpow(dt, lr, li, 1.f, ar, ai);
  const float nr = ar - 1.f, ni = ai, den = lr * lr + li * li;
  fre = (nr * lr + ni * li) / den; fim = (ni * lr - nr * li) / den;
}
DI void p0_ktab_item(const Params& P, float* sm, int it, int tid) {
  const int tau = it & 63, dir = (it >> 6) & 1, g = it >> 7;
  float* sw = sm;
  float* sG = sw + 128;
  float* sC = sG + 2048;
  if (tid < 64) {
    float dt, lr, li; s5_lambda(P, g, dir, tid, dt, lr, li);
    float fr_, fi_, ar, ai; s5_f(dt, lr, li, fr_, fi_); cpow(dt, lr, li, (float)tau, ar, ai);
    sw[tid * 2] = fr_ * ar - fi_ * ai; sw[tid * 2 + 1] = fr_ * ai + fi_ * ar;
  }
  for (int e = tid; e < 1024; e += 256) { sC[e * 2] = P.c_re[dir][g * 1024 + e]; sC[e * 2 + 1] = P.c_im[dir][g * 1024 + e]; }
  __syncthreads();
  for (int e = tid; e < 1024; e += 256) {
    const int n = e >> 4;
    const float br = P.b_re[dir][g * 1024 + e], bi = P.b_im[dir][g * 1024 + e], wr_ = sw[n * 2], wi_ = sw[n * 2 + 1];
    sG[e * 2] = wr_ * br - wi_ * bi; sG[e * 2 + 1] = wr_ * bi + wi_ * br;
  }
  __syncthreads();
  const int p = tid >> 4, q = tid & 15;
  float acc = 0.f;
  for (int n = 0; n < 64; ++n) acc += sC[(p * 64 + n) * 2] * sG[(n * 16 + q) * 2] - sC[(p * 64 + n) * 2 + 1] * sG[(n * 16 + q) * 2 + 1];
  ((float*)(P.ws + OFF_KTAB))[(size_t)it * 256 + tid] = acc;
  __syncthreads();
}
DI void phase0(const Params& P, char* smem) {
  const int bid = blockIdx.x, nb = gridDim.x, tid = threadIdx.x, hb = tid >> 8, t2 = tid & 255;
  {
    f32x2* PW = (f32x2*)(P.ws + OFF_PW); f32x2* FB = (f32x2*)(P.ws + OFF_FB);
    const int total = 32 * 2 * 65 * 64;
    for (int e = bid * NTHR + tid; e < total; e += nb * NTHR) {
      const int n = e & 63, ex = (e >> 6) % 65, gd = (e >> 6) / 65, dir = gd & 1, g = gd >> 1;
      float dt, lr, li; s5_lambda(P, g, dir, n, dt, lr, li);
      float re, im; cpow(dt, lr, li, (float)ex, re, im);
      PW[e] = f32x2{re, im};
      if (ex == 0) { float fr_, fi_; s5_f(dt, lr, li, fr_, fi_); FB[gd * 64 + n] = f32x2{fr_, fi_}; }
    }
  }
  if (bid == 0 && tid < 16) ((unsigned*)(P.ws + OFF_CTR))[tid] = 0u;
  for (int it = bid; it < 96; it += nb) p0_mod_item(P, smem, it);
}
DI void p1_compute(const Params& P, char* smem) {
  const int bid = blockIdx.x, nb = gridDim.x, tid = threadIdx.x, hb = tid >> 8, t2 = tid & 255;
  __syncthreads();
  constexpr int I1 = 1664, I2 = 256, I3 = 512;
  float* str = (float*)smem + hb * (64 * 33);
  for (int it = bid * 2 + hb; it < I1 + I2 + I3; it += nb * 2) {
    int r = it;
    if (r < I1) {
      const int kb = r / 104, nt = r % 104, n0 = nt * 32; int nvalid = INC - n0; nvalid = nvalid < 0 ? 0 : (nvalid > 32 ? 32 : nvalid);
      p0_transpose_item(P.w_in, INC, DM, kb * 64, n0, nvalid, (bf16_t*)(P.ws + OFF_WINT), n0, str, t2); continue;
    } r -= I1;
    if (r < I2) {
      const int kb = r / 32, nt = r % 32, n0 = nt * 32, t = n0 >> 8, i = n0 & 255;
      const int src0 = (i < 128) ? t * 128 + i : 512 + t * 128 + (i - 128);
      p0_transpose_item(P.glu_w, 1024, 512, kb * 64, src0, 32, (bf16_t*)(P.ws + OFF_GLUWT), n0, str, t2); continue;
    } r -= I2;
    { const int kb = r / 32, nt = r % 32; p0_transpose_item(P.w_out, 1024, 1024, kb * 64, nt * 32, 32, (bf16_t*)(P.ws + OFF_WOUTT), nt * 32, str, t2); }
  }
  __syncthreads();
  float* skt = (float*)smem + hb * 4352;
  for (int it = bid * 2 + hb; it < 4096; it += nb * 2) p0_ktab_item(P, skt, it, t2);
}
DI void phase1(const Params& P, char* smem) {
  const int bid = blockIdx.x, nb = gridDim.x, tid = threadIdx.x, lane = tid & 63, wid = tid >> 6;
  const float* mod = (const float*)(P.ws + OFF_MOD);
  bf16_t* hB = (bf16_t*)(P.ws + OFF_HB);
#pragma unroll 1
  for (int pass = 0; pass < 2; ++pass) {
  const bool rows_now = (pass == 0) != (((blockIdx.x >> 3) & 1) != 0);
  if (rows_now) {
  for (int row0 = (bid * NWV + wid) * 4; row0 < NTOK; row0 += nb * NWV * 4) {
    f32x4 v[4][4];
#pragma unroll
    for (int u = 0; u < 4; ++u) {
      const f32x4* xr = (const f32x4*)(P.x + (size_t)(row0 + u) * DM) + lane;
#pragma unroll
      for (int j = 0; j < 4; ++j) v[u][j] = xr[64 * j];
    }
#pragma unroll
    for (int u = 0; u < 4; ++u) {
      const int row = row0 + u, b = row >> 12;
      float s = 0.f;
#pragma unroll
      for (int j = 0; j < 4; ++j) s += v[u][j][0] * v[u][j][0] + v[u][j][1] * v[u][j][1] + v[u][j][2] * v[u][j][2] + v[u][j][3] * v[u][j][3];
      const float rstd = rsqrtf(wave_sum(s) * (1.f / DM) + 1e-6f);
#pragma unroll
      for (int j = 0; j < 4; ++j) {
        const int col = lane * 4 + 256 * j;
        const f32x4 nw = *(const f32x4*)(P.norm_w + col), sh = *(const f32x4*)(mod + b * 3072 + col), sc = *(const f32x4*)(mod + b * 3072 + 1024 + col);
        float h[4];
#pragma unroll
        for (int e = 0; e < 4; ++e) h[e] = v[u][j][e] * rstd * nw[e] * (1.f + sc[e]) + sh[e];
        u32x2 o = {pk2(h[0], h[1]), pk2(h[2], h[3])};
        *(u32x2*)(hB + (size_t)row * DM + col) = o;
      }
    }
  }
  } else {
  p1_compute(P, smem);
  __syncthreads();
  const float* KT = (const float*)(P.ws + OFF_KTAB);
  const f32x2* PW = (const f32x2*)(P.ws + OFF_PW); const f32x2* FB = (const f32x2*)(P.ws + OFF_FB);
  bf16_t* MY = (bf16_t*)(P.ws + OFF_MY); bf16_t* MS = (bf16_t*)(P.ws + OFF_MS);
  const int totalS = 32 * 256 * 128;
  for (int e = bid * NTHR + tid; e < totalS; e += nb * NTHR) {
    const int kc = e & 127, row = (e >> 7) & 255, g = e >> 15, dir = row >> 7, part = (row >> 6) & 1, n = row & 63;
    const int s = kc >> 1, q0 = (kc & 1) * 8, ex = dir == 0 ? 63 - s : s;
    const f32x2 a = PW[((g * 2 + dir) * 65 + ex) * 64 + n], f = FB[(g * 2 + dir) * 64 + n];
    const float wr_ = a[0] * f[0] - a[1] * f[1], wi_ = a[0] * f[1] + a[1] * f[0];
    float o[8];
#pragma unroll
    for (int j = 0; j < 8; ++j) {
      const float br = P.b_re[dir][(g * 64 + n) * 16 + q0 + j], bi = P.b_im[dir][(g * 64 + n) * 16 + q0 + j];
      o[j] = part == 0 ? (wr_ * br - wi_ * bi) : (wr_ * bi + wi_ * br);
    }
    u32x4 ov = {pk2(o[0], o[1]), pk2(o[2], o[3]), pk2(o[4], o[5]), pk2(o[6], o[7])};
    *(u32x4*)(MS + ((size_t)(g * 256 + row) * 1024 + kc * 8)) = ov;
  }
  }
  }
}
DI void p3_mygen(const Params& P) {
  const int bid = blockIdx.x, nb = gridDim.x, tid = threadIdx.x;
  const float* KT = (const float*)(P.ws + OFF_KTAB);
  const f32x2* PW = (const f32x2*)(P.ws + OFF_PW); const f32x2* FB = (const f32x2*)(P.ws + OFF_FB);
  bf16_t* MY = (bf16_t*)(P.ws + OFF_MY); bf16_t* MS = (bf16_t*)(P.ws + OFF_MS);
  const int totalY = 32 * 1024 * 160;
  for (int e = bid * NTHR + tid; e < totalY; e += nb * NTHR) {
    const int kc = e % 160, row = (e / 160) & 1023, g = e / (160 * 1024), t = row >> 4, p = row & 15;
    float o[8];
    if (kc < 128) {
      const int s = kc >> 1, q0 = (kc & 1) * 8;
      if (t == s) {
        const float* k0 = KT + ((size_t)((g * 2 + 0) * 64 + 0) * 256 + p * 16 + q0); const float* k1 = KT + ((size_t)((g * 2 + 1) * 64 + 0) * 256 + p * 16 + q0);
#pragma unroll
        for (int j = 0; j < 8; ++j) o[j] = k0[j] + k1[j] + ((q0 + j == p) ? P.s5_d[g * 16 + p] : 0.f);
      } else {
        const int dir = t > s ? 0 : 1, tau = t > s ? t - s : s - t;
        const float* k0 = KT + ((size_t)((g * 2 + dir) * 64 + tau) * 256 + p * 16 + q0);
#pragma unroll
        for (int j = 0; j < 8; ++j) o[j] = k0[j];
      }
    } else {
      const int c2 = (kc - 128) * 8, dir = c2 >> 7, part = (c2 >> 6) & 1, n0 = c2 & 63;
      const int ex = dir == 0 ? t + 1 : 64 - t;
#pragma unroll
      for (int j = 0; j < 8; ++j) {
        const int n = n0 + j; const f32x2 a = PW[((g * 2 + dir) * 65 + ex) * 64 + n];
        const float cr = P.c_re[dir][(g * 16 + p) * 64 + n], ci = P.c_im[dir][(g * 16 + p) * 64 + n];
        o[j] = part == 0 ? (cr * a[0] - ci * a[1]) : -(cr * a[1] + ci * a[0]);
      }
    }
    u32x4 ov = {pk2(o[0], o[1]), pk2(o[2], o[3]), pk2(o[4], o[5]), pk2(o[6], o[7])};
    *(u32x4*)(MY + ((size_t)(g * 1024 + row) * 1280 + kc * 8)) = ov;
  }
}
DI void phase2(const Params& P, LAS unsigned char* lds) {
  const int tid = threadIdx.x, lane = tid & 63, wid = tid >> 6, wr = wid >> 2, wc = wid & 3, fr = lane & 15, fq = lane >> 4;
  const bf16_t* hB = (const bf16_t*)(P.ws + OFF_HB); const bf16_t* W = (const bf16_t*)(P.ws + OFF_WINT);
  bf16_t* U5 = (bf16_t*)(P.ws + OFF_U5); bf16_t* ZA = (bf16_t*)(P.ws + OFF_ZA); bf16_t* ZB = (bf16_t*)(P.ws + OFF_ZB);
  bf16_t* QKV = (bf16_t*)(P.ws + OFF_QKVRAW); float* BA = (float*)(P.ws + OFF_BA);
  constexpr int NT = 13, NTILES = 256 * NT;
  const int bid = blockIdx.x, nbk = gridDim.x, nj = bid < NTILES ? (NTILES - bid + nbk - 1) / nbk : 0;
  auto tile_of = [&](int j, int& tm, int& tn) { const int id = bid + j * nbk, grp = id / (8 * NT), ig = id % (8 * NT); tm = grp * 8 + (ig & 7); tn = ig >> 3; };
  gemm256_stream<true, true>(nj, DM / 64, DM, DM,
    [&](int j, const bf16_t*& A, const bf16_t*& Bt) { int tm, tn; tile_of(j, tm, tn); A = hB + (size_t)tm * 256 * DM; Bt = W + (size_t)tn * 256 * DM; },
    [&](int j, f32x4 (&acc)[2][2][4][2]) {
      int tm, tn; tile_of(j, tm, tn);
#pragma unroll
      for (int ai = 0; ai < 2; ++ai)
#pragma unroll
        for (int m = 0; m < 4; ++m) {
          const int t = tm * 256 + ai * 128 + wr * 64 + m * 16 + fr;
#pragma unroll
          for (int bj = 0; bj < 2; ++bj) {
            const int col = tn * 256 + bj * 128 + wc * 32 + fq * 8;
            const f32x4 v0 = acc[ai][bj][m][0], v1 = acc[ai][bj][m][1];
            if (tn == 12) { if (col < INC) { *(f32x4*)(BA + (size_t)t * 16 + (col - 3072)) = v0; *(f32x4*)(BA + (size_t)t * 16 + (col - 3072) + 4) = v1; } continue; }
            const u32x4 o = {pk2(v0[0], v0[1]), pk2(v0[2], v0[3]), pk2(v1[0], v1[1]), pk2(v1[2], v1[3])};
            if (tn < 2) { const int g = col >> 4, q = col & 15; *(u32x4*)(U5 + ((size_t)(g * 1024 + (t >> 6)) * 1280 + (t & 63) * 16 + q)) = o; }
            else if (tn < 4) *(u32x4*)(ZA + (size_t)t * 512 + (col - 512)) = o;
            else if (tn < 10) *(u32x4*)(QKV + (size_t)t * 1536 + (col - 1024)) = o;
            else *(u32x4*)(ZB + (size_t)t * 512 + (col - 2560)) = o;
          }
        }
    }, lds);
}

DI void phase3(const Params& P, LAS unsigned char* lds) {
  const int tid = threadIdx.x, lane = tid & 63, wid = tid >> 6, wr = wid >> 2, wc = wid & 3, fr = lane & 15, fq = lane >> 4;
  const bf16_t* MS = (const bf16_t*)(P.ws + OFF_MS); const bf16_t* U5 = (const bf16_t*)(P.ws + OFF_U5);
  float* SC = P.out;
  const int nrep3a_ = (REP_PHASE == 30) ? P.p_hi - 7 : 1;
  for (int rep3a_ = 0; rep3a_ < nrep3a_; ++rep3a_)
  for (int id = blockIdx.x; id < 128; id += gridDim.x) {
    const int g = id >> 2, tn = id & 3;
    f32x4 acc[2][2][4][2];
    gemm256<false>(MS + (size_t)(g * 256) * 1024, 1024, U5 + (size_t)(g * 1024 + tn * 256) * 1280, 1280, 1024, lds, acc);
#pragma unroll
    for (int ai = 0; ai < 2; ++ai)
#pragma unroll
      for (int bj = 0; bj < 2; ++bj)
#pragma unroll
        for (int m = 0; m < 4; ++m)
#pragma unroll
          for (int n = 0; n < 2; ++n) {
            const int row0 = ai * 128 + wr * 64 + m * 16 + fq * 4, col = tn * 256 + bj * 128 + wc * 32 + n * 16 + fr;
            *(f32x4*)(SC + ((size_t)(g * 1024 + col) * 256 + row0)) = acc[ai][bj][m][n];
          }
  }
  const bf16_t* QKV = (const bf16_t*)(P.ws + OFF_QKVRAW);
  const int nbk = gridDim.x, vb = (blockIdx.x + nbk - (128 % nbk)) % nbk;
  const int nrep3b_ = (REP_PHASE == 31) ? P.p_hi - 7 : 1;
  for (int rep3b_ = 0; rep3b_ < nrep3b_; ++rep3b_)
  for (int it = vb * NWV + wid; it < 16 * 128 * 3; it += nbk * NWV) {
    const int part = it % 3, c = (it / 3) & 127, b = it / (3 * 128), h = lane >> 4;
    const int colq = part * 512 + lane * 8;
    float wt[5][8];
#pragma unroll
    for (int k = 0; k < 5; ++k) {
      const f32x4 wa = *(const f32x4*)(P.conv_w + k * 1536 + colq), wb = *(const f32x4*)(P.conv_w + k * 1536 + colq + 4);
#pragma unroll
      for (int e = 0; e < 4; ++e) { wt[k][e] = wa[e]; wt[k][4 + e] = wb[e]; }
    }
    bf16_t* dst = (bf16_t*)(P.ws + (part == 0 ? OFF_QN : part == 1 ? OFF_KN : OFF_VN)) + (size_t)(b * 4 + h) * SEQ * 128 + (lane & 15) * 8;
    const int l0 = c * 32;
#pragma unroll 1
    for (int i0 = 0; i0 < 32; i0 += 8) {
      u32x4 u[12];
#pragma unroll
      for (int k = 0; k < 12; ++k) {
        const int l = l0 + i0 - 2 + k;
        u[k] = (l >= 0 && l < SEQ) ? *(const u32x4*)(QKV + (size_t)(b * SEQ + l) * 1536 + colq) : u32x4{0u, 0u, 0u, 0u};
      }
#pragma unroll
      for (int i = 0; i < 8; ++i) {
        float y[8];
#pragma unroll
        for (int e = 0; e < 8; ++e) y[e] = 0.f;
#pragma unroll
        for (int k = 0; k < 5; ++k)
#pragma unroll
          for (int e = 0; e < 4; ++e) { y[2 * e] += wt[k][2 * e] * bflo(u[i + k][e]); y[2 * e + 1] += wt[k][2 * e + 1] * bfhi(u[i + k][e]); }
        float ss = 0.f;
#pragma unroll
        for (int e = 0; e < 8; ++e) { y[e] = siluf_(y[e]); ss += y[e] * y[e]; }
        if (part < 2) {
#pragma unroll
          for (int o = 1; o < 16; o <<= 1) ss += __shfl_xor(ss, o);
          float sc = rsqrtf(ss + 1e-6f); if (part == 0) sc *= 0.08838834764831845f;
#pragma unroll
          for (int e = 0; e < 8; ++e) y[e] *= sc;
        }
        *(u32x4*)(dst + (size_t)(l0 + i0 + i) * 128) = u32x4{pk2(y[0], y[1]), pk2(y[2], y[3]), pk2(y[4], y[5]), pk2(y[6], y[7])};
      }
    }
  }
  p3_mygen(P);
}

struct PrepIn { u32x4 k[4], q[4], v[4]; float be, al; };
DI void dn_prep_issue(const Params& P, PrepIn& I, int item, int tid) {
  const int cc = item & 63, hd = (item >> 6) & 7, b = item >> 9, dir = hd >> 2, h = hd & 3;
  const size_t base = (size_t)(b * 4 + h) * SEQ * 128;
  const bf16_t* Qn = (const bf16_t*)(P.ws + OFF_QN) + base; const bf16_t* Kn = (const bf16_t*)(P.ws + OFF_KN) + base; const bf16_t* Vn = (const bf16_t*)(P.ws + OFF_VN) + base;
#pragma unroll
  for (int k = 0; k < 4; ++k) {
    const int idx = tid + 256 * k, row = idx >> 4, ch = idx & 15, p = cc * 64 + row, l = dir ? (SEQ - 1 - p) : p;
    I.k[k] = *(const u32x4*)(Kn + (size_t)l * 128 + ch * 8); I.q[k] = *(const u32x4*)(Qn + (size_t)l * 128 + ch * 8); I.v[k] = *(const u32x4*)(Vn + (size_t)l * 128 + ch * 8);
  }
  if (tid < 64) {
    const float* BA = (const float*)(P.ws + OFF_BA);
    const int p = cc * 64 + tid, l = dir ? (SEQ - 1 - p) : p; const size_t t = (size_t)b * SEQ + l;
    I.be = BA[t * 16 + dir * 4 + h]; I.al = BA[t * 16 + 8 + dir * 4 + h];
  }
}
DI void dn_prep_loop(const Params& P, char* sm, int first, int stride, int tid) {
  const int lane = tid & 63, w = tid >> 6, r = lane & 31, hh = lane >> 5;
  bf16_t* sK = (bf16_t*)sm;
  bf16_t* sQ = sK + 64 * 132;
  bf16_t* sRv = sQ;
  bf16_t* sLm = sQ + 128 * 68;
  bf16_t* sTt = sLm + 64 * 68;
  bf16_t* sRk = sLm;
  bf16_t* sT = sTt + 64 * 68;
  float* sg = (float*)(sT + 64 * 68);
  float* sbeta = sg + 64;
  float* seg = sbeta + 64;
  bf16_t* sV = (bf16_t*)(seg + 64);
  float* GC = (float*)(P.ws + OFF_GC);
  PrepIn I;
  if (first < 8192) dn_prep_issue(P, I, first, tid);
  for (int item = first; item < 8192; item += stride) {
  const int cc = item & 63, hd = (item >> 6) & 7, dir = hd >> 2, h = hd & 3;
  lds_barrier();
#pragma unroll
  for (int k = 0; k < 4; ++k) {
    const int idx = tid + 256 * k, row = idx >> 4, ch = idx & 15;
    *(u32x2*)(sK + row * 132 + ch * 8) = u32x2{I.k[k][0], I.k[k][1]}; *(u32x2*)(sK + row * 132 + ch * 8 + 4) = u32x2{I.k[k][2], I.k[k][3]};
    *(u32x2*)(sQ + row * 132 + ch * 8) = u32x2{I.q[k][0], I.q[k][1]}; *(u32x2*)(sQ + row * 132 + ch * 8 + 4) = u32x2{I.q[k][2], I.q[k][3]};
    *(u32x2*)(sV + row * 132 + ch * 8) = u32x2{I.v[k][0], I.v[k][1]}; *(u32x2*)(sV + row * 132 + ch * 8 + 4) = u32x2{I.v[k][2], I.v[k][3]};
  }
  for (int e = tid; e < 64 * 68 / 2; e += 256) { ((unsigned*)sT)[e] = 0u; ((unsigned*)sTt)[e] = 0u; }
  if (tid < 64) {
    const float be = sigmoidf_(I.be);
    const float g = -expf(P.a_log[dir][h]) * softplusf_(I.al + P.dt_bias[dir][h]);
    float gc = g;
#pragma unroll
    for (int o = 1; o < 64; o <<= 1) { const float v = __shfl_up(gc, o); if (lane >= o) gc += v; }
    sg[tid] = gc; sbeta[tid] = be; seg[tid] = expf(gc); GC[(size_t)item * 64 + tid] = gc;
  }
  if (item + stride < 8192) dn_prep_issue(P, I, item + stride, tid);
  lds_barrier();
  {
    const int mi = w >> 1, ni = w & 1;
    f32x16 kk, qk;
#pragma unroll
    for (int i = 0; i < 16; ++i) { kk[i] = 0.f; qk[i] = 0.f; }
#pragma unroll
    for (int ks = 0; ks < 8; ++ks) {
      const bf16x8 bf = ldfrag(sK, 32 * ni + r, 132, 16 * ks + 4 * hh);
      const bf16x8 ak = ldfrag(sK, 32 * mi + r, 132, 16 * ks + 4 * hh);
      const bf16x8 aq = ldfrag(sQ, 32 * mi + r, 132, 16 * ks + 4 * hh);
      kk = MFMA32(ak, bf, kk); qk = MFMA32(aq, bf, qk);
    }
    lds_barrier();
    bf16_t* ATT = (bf16_t*)(P.ws + OFF_ATT) + (size_t)item * 4096;
    const int j = 32 * ni + r; const float gj = sg[j];
#pragma unroll
    for (int reg = 0; reg < 16; ++reg) {
      const int i = 32 * mi + crow(reg, hh);
      const float d = __expf(i >= j ? sg[i] - gj : 0.f);
      sLm[i * 68 + j] = f2bf((i > j) ? sbeta[i] * kk[reg] * d : 0.f);
      for (int rep = 0; rep <= DUPST; ++rep) { ATT[i * 64 + j] = f2bf((i >= j) ? qk[reg] * d : 0.f); asm volatile("" ::: "memory"); }
    }
  }
  lds_barrier();
  if (tid < 64) {
    const int blk = tid >> 4, c = tid & 15;
    float x[16];
#pragma unroll
    for (int i = 0; i < 16; ++i) {
      float a = (i == c) ? 1.f : 0.f;
      const bf16_t* lrow = sLm + (16 * blk + i) * 68 + 16 * blk;
#pragma unroll
      for (int j = 0; j < i; ++j) a -= bf2f(lrow[j]) * x[j];
      x[i] = a;
    }
#pragma unroll
    for (int i = 0; i < 16; ++i) { const bf16_t v = f2bf(x[i]); sT[(16 * blk + i) * 68 + 16 * blk + c] = v; sTt[(16 * blk + c) * 68 + 16 * blk + i] = v; }
  }
  lds_barrier();
  if (w < 2) {
    const int a = w;
    f32x16 X, Y;
#pragma unroll
    for (int i = 0; i < 16; ++i) { X[i] = 0.f; Y[i] = 0.f; }
    {
      bf16x8 A = ldfrag(sLm, 32 * a + r, 68, 32 * a + 4 * hh);
      if (r < 16) A = bf16x8{0, 0, 0, 0, 0, 0, 0, 0};
      X = MFMA32(A, ldfrag(sTt, 32 * a + r, 68, 32 * a + 4 * hh), X);
    }
#pragma unroll
    for (int s = 0; s < 2; ++s) Y = MFMA32(ldfrag(sT, 32 * a + r, 68, 32 * a + 16 * s + 4 * hh), pack8(X, s), Y);
    if (r < 16) {
#pragma unroll
      for (int reg = 8; reg < 16; ++reg) {
        const int i = crow(reg, hh); const bf16_t v = f2bf(-Y[reg]);
        sT[(32 * a + i) * 68 + 32 * a + r] = v; sTt[(32 * a + r) * 68 + 32 * a + i] = v;
      }
    }
  }
  lds_barrier();
  if (w == 0) {
    f32x16 X, Y;
#pragma unroll
    for (int i = 0; i < 16; ++i) { X[i] = 0.f; Y[i] = 0.f; }
#pragma unroll
    for (int s = 0; s < 2; ++s) X = MFMA32(ldfrag(sLm, 32 + r, 68, 16 * s + 4 * hh), ldfrag(sTt, r, 68, 16 * s + 4 * hh), X);
#pragma unroll
    for (int s = 0; s < 2; ++s) Y = MFMA32(ldfrag(sT, 32 + r, 68, 32 + 16 * s + 4 * hh), pack8(X, s), Y);
#pragma unroll
    for (int reg = 0; reg < 16; ++reg) sT[(32 + crow(reg, hh)) * 68 + r] = f2bf(-Y[reg]);
  }
  lds_barrier();
  {
    const int c = tid;
    if (c < 128) {
#pragma unroll 2
      for (int i0 = 0; i0 < 64; i0 += 16) {
        float x[16];
#pragma unroll
        for (int i = 0; i < 16; ++i) x[i] = bf2f(sV[(i0 + i) * 132 + c]) * sbeta[i0 + i];
#pragma unroll
        for (int i = 0; i < 16; i += 4) *(u32x2*)(sRv + c * 68 + i0 + i) = u32x2{pk2(x[i], x[i + 1]), pk2(x[i + 2], x[i + 3])};
      }
    } else {
      const int d = c - 128;
      bf16_t* Kt = (bf16_t*)(P.ws + OFF_KTT) + (size_t)item * 8192 + d * 64;
      const float gl = sg[63];
#pragma unroll 2
      for (int i = 0; i < 64; i += 8) {
        float y[8], kt[8];
#pragma unroll
        for (int e = 0; e < 8; ++e) {
          const float kv = bf2f(sK[(i + e) * 132 + d]), ge = seg[i + e];
          y[e] = kv * sbeta[i + e] * ge; kt[e] = kv * __expf(gl - sg[i + e]);
        }
        *(u32x2*)(sRk + d * 68 + i) = u32x2{pk2(y[0], y[1]), pk2(y[2], y[3])}; *(u32x2*)(sRk + d * 68 + i + 4) = u32x2{pk2(y[4], y[5]), pk2(y[6], y[7])};
        *(u32x4*)(Kt + i) = u32x4{pk2(kt[0], kt[1]), pk2(kt[2], kt[3]), pk2(kt[4], kt[5]), pk2(kt[6], kt[7])};
      }
    }
  }
  lds_barrier();
  {
    bf16_t* Ut = (bf16_t*)(P.ws + OFF_UT) + (size_t)item * 8192;
    bf16_t* Wc = (bf16_t*)(P.ws + OFF_WC) + (size_t)item * 8192;
#pragma unroll
    for (int mi = 0; mi < 2; ++mi) {
      f32x16 du, dw;
#pragma unroll
      for (int i = 0; i < 16; ++i) { du[i] = 0.f; dw[i] = 0.f; }
#pragma unroll
      for (int s = 0; s < 4; ++s) {
        if (mi == 0 && s >= 2) continue;
        const bf16x8 tf = ldfrag(sT, 32 * mi + r, 68, 16 * s + 4 * hh);
        du = MFMA32(tf, ldfrag(sRv, 32 * w + r, 68, 16 * s + 4 * hh), du);
        dw = MFMA32(ldfrag(sRk, 32 * w + r, 68, 16 * s + 4 * hh), tf, dw);
      }
#pragma unroll
      for (int g4 = 0; g4 < 4; ++g4) {
        for (int rep = 0; rep <= DUPST; ++rep) {
        *(u32x2*)(Ut + (32 * w + r) * 64 + 32 * mi + 8 * g4 + 4 * hh) = u32x2{pk2(du[4 * g4], du[4 * g4 + 1]), pk2(du[4 * g4 + 2], du[4 * g4 + 3])};
        *(u32x2*)(Wc + (32 * mi + r) * 128 + 32 * w + 8 * g4 + 4 * hh) = u32x2{pk2(dw[4 * g4], dw[4 * g4 + 1]), pk2(dw[4 * g4 + 2], dw[4 * g4 + 3])};
        asm volatile("" ::: "memory"); }
      }
    }
  }
  }
}
DI void phase4(const Params& P, char* smem) {
  const int tid = threadIdx.x;
  {
    const float* SC = P.out; bf16_t* U5 = (bf16_t*)(P.ws + OFF_U5); const f32x2* PW = (const f32x2*)(P.ws + OFF_PW);
    const int nrep0_ = (REP_PHASE == 40) ? P.p_hi - 7 : 1;
    for (int rep0_ = 0; rep0_ < nrep0_; ++rep0_)
    for (int it = blockIdx.x; it < 128; it += gridDim.x) {
      const int g = it >> 2, b = (it & 3) * 4 + (tid >> 7), dir = (tid >> 6) & 1, n = tid & 63;
      const f32x2 a = PW[((g * 2 + dir) * 65 + 64) * 64 + n];
      float xr = 0.f, xi = 0.f;
#pragma unroll 8
      for (int s = 0; s < 64; ++s) {
        const int c = dir ? 63 - s : s; const size_t nn = (size_t)g * 1024 + b * 64 + c;
        U5[nn * 1280 + 1024 + dir * 128 + n] = f2bf(xr); U5[nn * 1280 + 1024 + dir * 128 + 64 + n] = f2bf(xi);
        const float sr = SC[nn * 256 + dir * 128 + n], si = SC[nn * 256 + dir * 128 + 64 + n];
        const float nr = a[0] * xr - a[1] * xi + sr, ni = a[0] * xi + a[1] * xr + si;
        xr = nr; xi = ni;
      }
    }
  }
  const int hb = tid >> 8;
  dn_prep_loop(P, smem + hb * 78336, blockIdx.x * 2 + hb, (REP_PHASE == 41) ? gridDim.x * 2 / (P.p_hi - 7) : gridDim.x * 2, tid & 255);
}

constexpr int RB_BYTES = 60160;
struct DnLd { u64_t v[32]; float g; };
DI void dn_issue(const Params& P, DnLd& L, int seq, int cc, int lw, int lane) {
  const int b = seq >> 3, hd = seq & 7, dir = hd >> 2, h = hd & 3;
  const size_t item = (size_t)seq * 64 + cc;
  if (lw == 0) {
    const bf16_t* Wg = (const bf16_t*)(P.ws + OFF_WC) + item * 8192;
#pragma unroll
    for (int k = 0; k < 32; ++k) { const int idx = lane + 64 * k; L.v[k] = ld8_pinned(Wg + (idx >> 5) * 128 + (idx & 31) * 4); }
  } else if (lw == 1) {
    const bf16_t* Qn = (const bf16_t*)(P.ws + OFF_QN) + (size_t)(b * 4 + h) * SEQ * 128;
#pragma unroll
    for (int k = 0; k < 32; ++k) {
      const int idx = lane + 64 * k, row = idx >> 5, p = cc * 64 + row, l = dir ? (SEQ - 1 - p) : p;
      L.v[k] = ld8_pinned(Qn + (size_t)l * 128 + (idx & 31) * 4);
    }
  } else if (lw == 2) {
    const bf16_t* Kg = (const bf16_t*)(P.ws + OFF_KTT) + item * 8192;
#pragma unroll
    for (int k = 0; k < 32; ++k) { const int idx = lane + 64 * k; L.v[k] = ld8_pinned(Kg + (idx >> 4) * 64 + (idx & 15) * 4); }
  } else {
    const bf16_t* Ag = (const bf16_t*)(P.ws + OFF_ATT) + item * 4096;
#pragma unroll
    for (int k = 0; k < 16; ++k) { const int idx = lane + 64 * k; L.v[k] = ld8_pinned(Ag + (idx >> 4) * 64 + (idx & 15) * 4); }
    L.g = ld4_pinned((const float*)(P.ws + OFF_GC) + item * 64 + lane);
  }
}
DI void dn_commit(const DnLd& L, char* buf, int lw, int lane) {
  bf16_t* sW = (bf16_t*)buf; bf16_t* sQ = sW + 64 * 132; bf16_t* sA = sQ + 64 * 132; bf16_t* sKt = sA + 64 * 68;
  if (lw == 0) {
#pragma unroll
    for (int k = 0; k < 32; ++k) { const int idx = lane + 64 * k; *(u64_t*)(sW + (idx >> 5) * 132 + (idx & 31) * 4) = L.v[k]; }
  } else if (lw == 1) {
#pragma unroll
    for (int k = 0; k < 32; ++k) { const int idx = lane + 64 * k; *(u64_t*)(sQ + (idx >> 5) * 132 + (idx & 31) * 4) = L.v[k]; }
  } else if (lw == 2) {
#pragma unroll
    for (int k = 0; k < 32; ++k) { const int idx = lane + 64 * k; *(u64_t*)(sKt + (idx >> 4) * 68 + (idx & 15) * 4) = L.v[k]; }
  } else {
#pragma unroll
    for (int k = 0; k < 16; ++k) { const int idx = lane + 64 * k; *(u64_t*)(sA + (idx >> 4) * 68 + (idx & 15) * 4) = L.v[k]; }
    ((float*)(buf + 59904))[lane] = L.g;
  }
}
DI void dn_recur(const Params& P, char* smem, int seq) {
  const int tid = threadIdx.x, lane = tid & 63, w = __builtin_amdgcn_readfirstlane(tid >> 6), r = lane & 31, hh = lane >> 5;
  const int b = seq >> 3, hd = seq & 7, dir = hd >> 2, h = hd & 3;
  __syncthreads();
  if (w >= 4) {
    const int lw = w - 4;
    DnLd LA, LB;
    dn_issue(P, LA, seq, 0, lw, lane);
    dn_commit(LA, smem, lw, lane);
    dn_issue(P, LA, seq, 1, lw, lane);
    dn_issue(P, LB, seq, 2, lw, lane);
    lds_barrier();
    for (int cc = 0; cc < 64; cc += 2) {
      for (int rep = 0; rep <= DUPL; ++rep) { dn_commit(LA, smem + RB_BYTES, lw, lane); asm volatile("" ::: "memory"); }
      for (int rep = 0; rep <= DUPL; ++rep) { dn_issue(P, LA, seq, min(cc + 3, 63), lw, lane); asm volatile("" ::: "memory"); }
      lds_barrier();
      for (int rep = 0; rep <= DUPL; ++rep) { dn_commit(LB, smem, lw, lane); asm volatile("" ::: "memory"); }
      for (int rep = 0; rep <= DUPL; ++rep) { dn_issue(P, LB, seq, min(cc + 4, 63), lw, lane); asm volatile("" ::: "memory"); }
      lds_barrier();
    }
  } else {
    const int dv0 = 32 * w;
    const float* GC = (const float*)(P.ws + OFF_GC);
    bf16_t* O = (bf16_t*)P.out + (size_t)dir * NTOK * 512;
    f32x16 S[4];
#pragma unroll
    for (int t = 0; t < 4; ++t)
#pragma unroll
      for (int i = 0; i < 16; ++i) S[t][i] = 0.f;
    lds_barrier();
    for (int cc = 0; cc < 64; ++cc) {
      const size_t item = (size_t)seq * 64 + cc;
      const bf16_t* sW = (const bf16_t*)(smem + (cc & 1) * RB_BYTES); const bf16_t* sQ = sW + 64 * 132; const bf16_t* sA = sQ + 64 * 132; const bf16_t* sKt = sA + 64 * 68;
      const bf16_t* Ug = (const bf16_t*)(P.ws + OFF_UT) + item * 8192;
      f32x16 vn[2];
#pragma unroll
      for (int m = 0; m < 2; ++m)
#pragma unroll
        for (int g4 = 0; g4 < 4; ++g4) {
          const u32x2 u = *(const u32x2*)(Ug + (dv0 + r) * 64 + 32 * m + 8 * g4 + 4 * hh);
          vn[m][4 * g4 + 0] = bflo(u[0]); vn[m][4 * g4 + 1] = bfhi(u[0]); vn[m][4 * g4 + 2] = bflo(u[1]); vn[m][4 * g4 + 3] = bfhi(u[1]);
        }
      const float* sG = (const float*)(smem + (cc & 1) * RB_BYTES + 59904);
      const float egl = __expf(sG[63]);
      f32x16 aW[2], aQ[2];
#pragma unroll
      for (int m = 0; m < 2; ++m)
#pragma unroll
        for (int i = 0; i < 16; ++i) { aW[m][i] = 0.f; aQ[m][i] = 0.f; }
      bf16x8 fa[2][4];
      fa[0][0] = ldfrag(sW, r, 132, 4 * hh); fa[0][1] = ldfrag(sW, 32 + r, 132, 4 * hh);
      fa[0][2] = ldfrag(sQ, r, 132, 4 * hh); fa[0][3] = ldfrag(sQ, 32 + r, 132, 4 * hh);
#pragma unroll
      for (int ks = 0; ks < 8; ++ks) {
        const int cur = ks & 1, nxt = cur ^ 1;
        if (ks + 1 < 8) {
          fa[nxt][0] = ldfrag(sW, r, 132, 16 * (ks + 1) + 4 * hh); fa[nxt][1] = ldfrag(sW, 32 + r, 132, 16 * (ks + 1) + 4 * hh);
          fa[nxt][2] = ldfrag(sQ, r, 132, 16 * (ks + 1) + 4 * hh); fa[nxt][3] = ldfrag(sQ, 32 + r, 132, 16 * (ks + 1) + 4 * hh);
        }
        const bf16x8 sf = pack8(S[ks >> 1], ks & 1);
        aW[0] = MFMA32(fa[cur][0], sf, aW[0]); aW[1] = MFMA32(fa[cur][1], sf, aW[1]);
        aQ[0] = MFMA32(fa[cur][2], sf, aQ[0]); aQ[1] = MFMA32(fa[cur][3], sf, aQ[1]);
      }
      bf16x8 fA[4];
#pragma unroll
      for (int ks = 0; ks < 4; ++ks) fA[ks] = ldfrag(sA, r, 68, 16 * ks + 4 * hh);
#pragma unroll
      for (int m = 0; m < 2; ++m)
#pragma unroll
        for (int i = 0; i < 16; ++i) aQ[m][i] *= __expf(sG[32 * m + crow(i, hh)]);
#pragma unroll
      for (int m = 0; m < 2; ++m)
#pragma unroll
        for (int i = 0; i < 16; ++i) vn[m][i] -= aW[m][i];
      bf16x8 vf[4];
      vf[0] = pack8(vn[0], 0); vf[1] = pack8(vn[0], 1); vf[2] = pack8(vn[1], 0); vf[3] = pack8(vn[1], 1);
      bf16x8 fk[2][4];
#pragma unroll
      for (int ks = 0; ks < 4; ++ks) aQ[0] = MFMA32(fA[ks], vf[ks], aQ[0]);
#pragma unroll
      for (int ks = 0; ks < 4; ++ks) fA[ks] = ldfrag(sA, 32 + r, 68, 16 * ks + 4 * hh);
#pragma unroll
      for (int ks = 0; ks < 4; ++ks) fk[0][ks] = ldfrag(sKt, r, 68, 16 * ks + 4 * hh);
#pragma unroll
      for (int ks = 0; ks < 4; ++ks) aQ[1] = MFMA32(fA[ks], vf[ks], aQ[1]);
#pragma unroll
      for (int t = 0; t < 4; ++t) {
        const int cur = t & 1, nxt = cur ^ 1;
        if (t + 1 < 4) {
#pragma unroll
          for (int ks = 0; ks < 4; ++ks) fk[nxt][ks] = ldfrag(sKt, 32 * (t + 1) + r, 68, 16 * ks + 4 * hh);
        }
#pragma unroll
        for (int i = 0; i < 16; ++i) S[t][i] *= egl;
#pragma unroll
        for (int ks = 0; ks < 4; ++ks) S[t] = MFMA32(fk[cur][ks], vf[ks], S[t]);
      }
      {
        bf16_t* Ob = O + (size_t)b * SEQ * 512 + h * 128 + dv0 + r;
#pragma unroll
        for (int m = 0; m < 2; ++m)
#pragma unroll
          for (int i = 0; i < 16; ++i) {
            const int p = cc * 64 + 32 * m + crow(i, hh), l = dir ? (SEQ - 1 - p) : p;
            Ob[(size_t)l * 512] = f2bf(aQ[m][i]);
          }
      }
      lds_barrier();
    }
  }
}

DI void phase6(const Params& P, LAS unsigned char* lds, int ctr_off) {
  const int tid = threadIdx.x, lane = tid & 63, wid = tid >> 6, wr = wid >> 2, wc = wid & 3, fr = lane & 15, fq = lane >> 4;
  const bf16_t* MY = (const bf16_t*)(P.ws + OFF_MY); const bf16_t* U5 = (const bf16_t*)(P.ws + OFF_U5);
  bf16_t* Y5 = (bf16_t*)(P.ws + OFF_Y5);
  unsigned* ctr = (unsigned*)(P.ws + OFF_CTR) + ctr_off;
  LAS unsigned* sid = (LAS unsigned*)(lds + 131072);
  const int q0 = blockIdx.x & 7, pref = (blockIdx.x < 128 && gridDim.x > 128) ? 1 : 0;
  int step = 0;
  for (;;) {
    const int q = (q0 + (step >> 1)) & 7, part = pref ^ (step & 1), lim = part ? 16 : 48;
    __syncthreads();
    if (tid == 0) *sid = atomicAdd(ctr + part * 8 + q, 1u);
    __syncthreads();
    const int got = (int)*sid;
    if (got >= lim) { if (++step >= 16) break; continue; }
    const int idl = part ? 48 + got : got;
    const int g = q + 8 * (idl >> 4), tn = (idl >> 2) & 3, tm = idl & 3;
    f32x4 acc[2][2][4][2];
    gemm256<false>(MY + (size_t)(g * 1024 + tm * 256) * 1280, 1280, U5 + (size_t)(g * 1024 + tn * 256) * 1280, 1280, 1280, lds, acc);
#pragma unroll
    for (int ai = 0; ai < 2; ++ai)
#pragma unroll
      for (int bj = 0; bj < 2; ++bj)
#pragma unroll
        for (int m = 0; m < 4; ++m)
#pragma unroll
          for (int n = 0; n < 2; ++n) {
            const int row0 = tm * 256 + ai * 128 + wr * 64 + m * 16 + fq * 4, col = tn * 256 + bj * 128 + wc * 32 + n * 16 + fr;
            const int t = row0 >> 4, p = row0 & 15; const size_t tok = (size_t)col * 64 + t;
            const f32x4 v = acc[ai][bj][m][n];
            const u32x2 o = {pk2(gelu_tanh(v[0]), gelu_tanh(v[1])), pk2(gelu_tanh(v[2]), gelu_tanh(v[3]))};
            *(u32x2*)(Y5 + tok * 512 + g * 16 + p) = o;
          }
  }
}

DI void phase7(const Params& P, LAS unsigned char* lds) {
  const int tid = threadIdx.x, lane = tid & 63, wid = tid >> 6, wr = wid >> 2, wc = wid & 3, fr = lane & 15, fq = lane >> 4;
  const bf16_t* Y5 = (const bf16_t*)(P.ws + OFF_Y5); const bf16_t* GW = (const bf16_t*)(P.ws + OFF_GLUWT);
  const bf16_t* ZA = (const bf16_t*)(P.ws + OFF_ZA); const bf16_t* ZB = (const bf16_t*)(P.ws + OFF_ZB);
  bf16_t* YAB = (bf16_t*)(P.ws + OFF_YAB);
#pragma unroll 1
  for (int pass = 0; pass < 2; ++pass) {
  const bool gemm_now = (pass == 0) != (((blockIdx.x >> 3) & 1) != 0);
  if (gemm_now) {
  {
    const int bid = blockIdx.x, nbk = gridDim.x, nj = bid < 1024 ? (1024 - bid + nbk - 1) / nbk : 0;
    auto tile_of = [&](int j, int& tm, int& tn) { const int id = bid + j * nbk, grp = id >> 5, ig = id & 31; tm = grp * 8 + (ig & 7); tn = ig >> 3; };
    gemm256_stream<true, true>(nj, 8, 512, 512,
      [&](int j, const bf16_t*& A, const bf16_t*& Bt) { int tm, tn; tile_of(j, tm, tn); A = Y5 + (size_t)tm * 256 * 512; Bt = GW + (size_t)tn * 256 * 512; },
      [&](int j, f32x4 (&acc)[2][2][4][2]) {
        int tm, tn; tile_of(j, tm, tn);
        const int jc = tn * 128 + wc * 32 + fq * 8;
        f32x4 bv[2], bg[2];
#pragma unroll
        for (int n = 0; n < 2; ++n) { bv[n] = *(const f32x4*)(P.glu_b + jc + 4 * n); bg[n] = *(const f32x4*)(P.glu_b + 512 + jc + 4 * n); }
#pragma unroll
        for (int ai = 0; ai < 2; ++ai)
#pragma unroll
          for (int m = 0; m < 4; ++m) {
            const size_t t = (size_t)tm * 256 + ai * 128 + wr * 64 + m * 16 + fr;
            const u32x4 z = *(const u32x4*)(ZA + t * 512 + jc);
            float y[8];
#pragma unroll
            for (int n = 0; n < 2; ++n)
#pragma unroll
              for (int e = 0; e < 4; ++e) {
                const unsigned zz = z[2 * n + (e >> 1)]; const float zf = (e & 1) ? bfhi(zz) : bflo(zz);
                y[4 * n + e] = (acc[ai][0][m][n][e] + bv[n][e]) * sigmoidf_(acc[ai][1][m][n][e] + bg[n][e]) * siluf_(zf);
              }
            *(u32x4*)(YAB + t * 1024 + jc) = u32x4{pk2(y[0], y[1]), pk2(y[2], y[3]), pk2(y[4], y[5]), pk2(y[6], y[7])};
          }
      }, lds);
  }
  } else {
  const bf16_t* Of = (const bf16_t*)P.out; const bf16_t* Ob = Of + (size_t)NTOK * 512;
  float nw[8];
#pragma unroll
  for (int e = 0; e < 8; ++e) nw[e] = P.dn_norm_w[(lane & 15) * 8 + e];
  for (int t0 = (blockIdx.x * NWV + wid) * 4; t0 < NTOK; t0 += gridDim.x * NWV * 4) {
    u32x4 a[4], bq[4], z[4];
#pragma unroll
    for (int u = 0; u < 4; ++u) {
      const size_t off = (size_t)(t0 + u) * 512 + lane * 8;
      a[u] = *(const u32x4*)(Of + off); bq[u] = *(const u32x4*)(Ob + off); z[u] = *(const u32x4*)(ZB + off);
    }
#pragma unroll
    for (int u = 0; u < 4; ++u) {
      float o[8]; float ss = 0.f;
#pragma unroll
      for (int e = 0; e < 4; ++e) { o[2 * e] = bflo(a[u][e]) + bflo(bq[u][e]); o[2 * e + 1] = bfhi(a[u][e]) + bfhi(bq[u][e]); }
#pragma unroll
      for (int e = 0; e < 8; ++e) ss += o[e] * o[e];
#pragma unroll
      for (int sft = 1; sft < 16; sft <<= 1) ss += __shfl_xor(ss, sft);
      const float rs = rsqrtf(ss * (1.f / 128.f) + 1e-6f);
      float y[8];
#pragma unroll
      for (int e = 0; e < 4; ++e) { y[2 * e] = o[2 * e] * rs * nw[2 * e] * siluf_(bflo(z[u][e])); y[2 * e + 1] = o[2 * e + 1] * rs * nw[2 * e + 1] * siluf_(bfhi(z[u][e])); }
      *(u32x4*)(YAB + (size_t)(t0 + u) * 1024 + 512 + lane * 8) = u32x4{pk2(y[0], y[1]), pk2(y[2], y[3]), pk2(y[4], y[5]), pk2(y[6], y[7])};
    }
  }
  }
  }
}

DI void phase8_norm(const Params& P, const float* sss, int tm) {
  const int tid = threadIdx.x, lane = tid & 63, wid = tid >> 6;
  __syncthreads();
  for (int rr = 0; rr < 32; rr += 4) {
    f32x4 v[4][4];
#pragma unroll
    for (int u = 0; u < 4; ++u) {
      const f32x4* xr = (const f32x4*)(P.out + ((size_t)tm * 256 + wid * 32 + rr + u) * DM) + lane;
#pragma unroll
      for (int j = 0; j < 4; ++j) v[u][j] = xr[64 * j];
    }
#pragma unroll
    for (int u = 0; u < 4; ++u) {
      const int row = wid * 32 + rr + u;
      const f32x4 p4 = *(const f32x4*)(sss + row * 4);
      const float rstd = rsqrtf((p4[0] + p4[1] + p4[2] + p4[3]) * (1.f / DM) + 1e-6f);
      f32x4* xr = (f32x4*)(P.out + ((size_t)tm * 256 + row) * DM) + lane;
#pragma unroll
      for (int j = 0; j < 4; ++j) {
        const f32x4 fw = *(const f32x4*)(P.final_norm_w + lane * 4 + 256 * j);
        f32x4 o;
#pragma unroll
        for (int e = 0; e < 4; ++e) o[e] = v[u][j][e] * rstd * fw[e];
        xr[64 * j] = o;
      }
    }
  }
  __syncthreads();
}
DI void phase8(const Params& P, LAS unsigned char* lds) {
  const int tid = threadIdx.x, lane = tid & 63, wid = tid >> 6, wr = wid >> 2, wc = wid & 3, fr = lane & 15, fq = lane >> 4;
  const bf16_t* YAB = (const bf16_t*)(P.ws + OFF_YAB); const bf16_t* W = (const bf16_t*)(P.ws + OFF_WOUTT);
  const float* mod = (const float*)(P.ws + OFF_MOD);
  float* sss = (float*)((char*)lds + 131072 + 64);
  for (int id = blockIdx.x * 4; id < 1024; id = ((id & 3) == 3) ? id - 3 + gridDim.x * 4 : id + 1) {
    const int tm = id >> 2, tn = id & 3;
    if (tn == 0) { for (int e = tid; e < 1024; e += NTHR) sss[e] = 0.f; }
    {
      f32x4 acc[2][2][4][2];
      gemm256<true, true>(YAB + (size_t)tm * 256 * 1024, 1024, W + (size_t)tn * 256 * 1024, 1024, 1024, lds, acc);
      f32x4 gvv[2][2];
#pragma unroll
      for (int bj = 0; bj < 2; ++bj)
#pragma unroll
        for (int n = 0; n < 2; ++n) gvv[bj][n] = *(const f32x4*)(mod + ((tm * 256) >> 12) * 3072 + 2048 + tn * 256 + bj * 128 + wc * 32 + fq * 8 + 4 * n);
#pragma unroll
      for (int ai = 0; ai < 2; ++ai)
#pragma unroll
        for (int m = 0; m < 4; ++m) {
          const size_t t = (size_t)tm * 256 + ai * 128 + wr * 64 + m * 16 + fr;
          float ssv = 0.f;
#pragma unroll
          for (int bj = 0; bj < 2; ++bj)
#pragma unroll
            for (int n = 0; n < 2; ++n) {
              const int col = tn * 256 + bj * 128 + wc * 32 + fq * 8 + 4 * n;
              const f32x4 xv = *(const f32x4*)(P.x + t * DM + col), gv = gvv[bj][n];
              f32x4 o;
#pragma unroll
              for (int e = 0; e < 4; ++e) { o[e] = xv[e] + gv[e] * acc[ai][bj][m][n][e]; ssv += o[e] * o[e]; }
              *(f32x4*)(P.out + t * DM + col) = o;
            }
          ssv += __shfl_xor(ssv, 16); ssv += __shfl_xor(ssv, 32);
          if (fq == 0) sss[(ai * 128 + wr * 64 + m * 16 + fr) * 4 + wc] += ssv;
        }
    }
    if (tn == 3) phase8_norm(P, sss, tm);
  }
}
DI void phase9(const Params& P) {
  const int tid = threadIdx.x, lane = tid & 63, wid = tid >> 6;
  for (int row0 = (blockIdx.x * NWV + wid) * 4; row0 < NTOK; row0 += gridDim.x * NWV * 4) {
    f32x4 v[4][4];
#pragma unroll
    for (int u = 0; u < 4; ++u) {
      const f32x4* xr = (const f32x4*)(P.out + (size_t)(row0 + u) * DM) + lane;
#pragma unroll
      for (int j = 0; j < 4; ++j) v[u][j] = xr[64 * j];
    }
#pragma unroll
    for (int u = 0; u < 4; ++u) {
      f32x4* xr = (f32x4*)(P.out + (size_t)(row0 + u) * DM) + lane;
      float s = 0.f;
#pragma unroll
      for (int j = 0; j < 4; ++j) s += v[u][j][0] * v[u][j][0] + v[u][j][1] * v[u][j][1] + v[u][j][2] * v[u][j][2] + v[u][j][3] * v[u][j][3];
      const float rstd = rsqrtf(wave_sum(s) * (1.f / DM) + 1e-6f);
#pragma unroll
      for (int j = 0; j < 4; ++j) {
        const f32x4 fw = *(const f32x4*)(P.final_norm_w + lane * 4 + 256 * j);
        f32x4 o;
#pragma unroll
        for (int e = 0; e < 4; ++e) o[e] = v[u][j][e] * rstd * fw[e];
        xr[64 * j] = o;
      }
    }
  }
}

#ifndef SPLIT56
#define SPLIT56 0
#endif
DI void phase5(const Params& P, char* smem, LAS unsigned char* lds) {
  for (int seq = blockIdx.x; seq < 128; seq += gridDim.x) dn_recur(P, smem, seq);
  if (!SPLIT56) phase6(P, lds, 0);
}
constexpr int LDS_BYTES = 160 * 1024;
__global__ void __launch_bounds__(NTHR) hybrid_fwd(Params P) {
  extern __shared__ __attribute__((aligned(16))) unsigned char lds_raw[];
  LAS unsigned char* lds = (LAS unsigned char*)lds_raw;
  char* smem = (char*)lds_raw;
  cg::grid_group grid = cg::this_grid();
#define SEAM(p) if (P.p_lo < (p) && P.p_hi >= (p)) grid.sync()
#ifndef PH_MASK
#define PH_MASK 0x3ff
#endif
#define RUN(p, call) if (((PH_MASK >> (p)) & 1) && P.p_lo <= (p) && P.p_hi >= (p)) { const int nrep_ = (REP_PHASE == (p)) ? P.p_hi - 7 : 1; for (int rep_ = 0; rep_ < nrep_; ++rep_) { if (rep_) grid.sync(); call; } }
  RUN(0, phase0(P, smem));
  SEAM(1);
  RUN(1, phase1(P, smem));
  SEAM(2);
  RUN(2, phase2(P, lds));
  SEAM(3);
  RUN(3, phase3(P, lds));
  SEAM(4);
  RUN(4, phase4(P, smem));
  SEAM(5);
  RUN(5, phase5(P, smem, lds));
  if (SPLIT56) { SEAM(6); RUN(6, phase6(P, lds, 0)); }
  SEAM(7);
  RUN(7, phase7(P, lds));
  SEAM(8);
  RUN(8, phase8(P, lds));
}

extern "C" void kernel_launch(void* const* d_in, const int* in_sizes, int n_in, void* d_out, int out_size, void* d_ws, size_t ws_size, hipStream_t stream) {
  static int grid_blocks = 0;
  if (!grid_blocks) {
    int dev = 0, cus = 0, per_cu = 0;
    (void)hipGetDevice(&dev);
    (void)hipDeviceGetAttribute(&cus, hipDeviceAttributeMultiprocessorCount, dev);
    (void)hipFuncSetAttribute((const void*)hybrid_fwd, hipFuncAttributeMaxDynamicSharedMemorySize, LDS_BYTES);
    (void)hipOccupancyMaxActiveBlocksPerMultiprocessor(&per_cu, (const void*)hybrid_fwd, NTHR, LDS_BYTES);
    if (per_cu < 1) per_cu = 1;
    if (per_cu > 1) per_cu = 1;
    grid_blocks = cus * per_cu;
    if (ws_size < WS_END) fprintf(stderr, "workspace too small: %zu < %zu\n", ws_size, (size_t)WS_END);
  }
  Params p{};
  const float* const* in = (const float* const*)d_in;
  p.x = in[0]; p.c = in[1]; p.ada_w = in[2]; p.ada_b = in[3]; p.norm_w = in[4]; p.w_in = in[5]; p.conv_w = in[6];
  p.a_log[0] = in[7]; p.dt_bias[0] = in[8]; p.a_log[1] = in[9]; p.dt_bias[1] = in[10]; p.dn_norm_w = in[11];
  for (int d = 0; d < 2; ++d) {
    const int o = 12 + 7 * d;
    p.lam_re[d] = in[o]; p.lam_im[d] = in[o + 1]; p.log_step[d] = in[o + 2]; p.b_re[d] = in[o + 3]; p.b_im[d] = in[o + 4]; p.c_re[d] = in[o + 5]; p.c_im[d] = in[o + 6];
  }
  p.s5_d = in[26]; p.glu_w = in[27]; p.glu_b = in[28]; p.w_out = in[29]; p.final_norm_w = in[30];
  p.out = (float*)d_out; p.ws = (char*)d_ws;
#if N_LAUNCH_MODE == 1
  for (int ph = 0; ph <= 9; ++ph) {
    p.p_lo = ph; p.p_hi = ph;
    hipLaunchKernelGGL(hybrid_fwd, dim3(grid_blocks), dim3(NTHR), LDS_BYTES, stream, p);
  }
#else
  p.p_lo = 0; p.p_hi = 9;
  void* args[] = {&p};
  hipError_t e = hipLaunchCooperativeKernel((const void*)hybrid_fwd, dim3(grid_blocks), dim3(NTHR), args, LDS_BYTES, stream);
  if (e != hipSuccess) fprintf(stderr, "cooperative launch failed: %s (grid %d)\n", hipGetErrorString(e), grid_blocks);
#endif
}
```

```cpp
#include <hip/hip_runtime.h>
#include <hip/hip_cooperative_groups.h>
#include <cstdio>
#include <cstdint>
namespace cg = cooperative_groups;

#ifndef N_LAUNCH_MODE
#define N_LAUNCH_MODE 0
#endif
#ifndef REP_PHASE
#define REP_PHASE -1
#endif

#define DUPST 0
#ifndef DUPL
#define DUPL 0
#endif
#define DI __device__ __forceinline__
#define LAS __attribute__((address_space(3)))
constexpr int NTHR = 512, NWV = 8;
typedef unsigned short bf16_t;
typedef short bf16x8 __attribute__((ext_vector_type(8)));
typedef float f32x4 __attribute__((ext_vector_type(4)));
typedef float f32x2 __attribute__((ext_vector_type(2)));
typedef float f32x16 __attribute__((ext_vector_type(16)));
typedef unsigned u32x4 __attribute__((ext_vector_type(4)));
typedef unsigned u32x2 __attribute__((ext_vector_type(2)));
typedef __bf16 bf2_t __attribute__((ext_vector_type(2)));

constexpr int DM = 1024, NB = 16, SEQ = 4096, NTOK = NB * SEQ;
constexpr int INC = 3088, INP = 3328;
constexpr size_t MiB = 1u << 20;
constexpr size_t OFF_HB = 0;
constexpr size_t OFF_QKVRAW = 128 * MiB;
constexpr size_t OFF_WC = 0;
constexpr size_t OFF_UT = 128 * MiB;
constexpr size_t OFF_ATT = 256 * MiB;
constexpr size_t OFF_Y5 = 656 * MiB;
constexpr size_t OFF_U5 = 320 * MiB;
constexpr size_t OFF_ZA = 400 * MiB;
constexpr size_t OFF_ZB = 464 * MiB;
constexpr size_t OFF_QN = 528 * MiB;
constexpr size_t OFF_KN = 592 * MiB;
constexpr size_t OFF_VN = 656 * MiB;
constexpr size_t OFF_YAB = 528 * MiB;
constexpr size_t OFF_MY = 720 * MiB;
constexpr size_t OFF_MS = 800 * MiB;
constexpr size_t OFF_KTT = 816 * MiB;
constexpr size_t OFF_WINT = 944 * MiB;
constexpr size_t OFF_GLUWT = 952 * MiB;
constexpr size_t OFF_WOUTT = 953 * MiB;
constexpr size_t OFF_BA = 955 * MiB;
constexpr size_t OFF_GC = 959 * MiB;
constexpr size_t OFF_KTAB = 961 * MiB;
constexpr size_t OFF_PW = 965 * MiB;
constexpr size_t OFF_FB = 968 * MiB;
constexpr size_t OFF_MOD = 969 * MiB;
constexpr size_t OFF_CTR = 969 * MiB + 512 * 1024;
constexpr size_t WS_END = 970 * MiB;

struct Params {
  const float *x, *c, *ada_w, *ada_b, *norm_w, *w_in, *conv_w;
  const float *a_log[2], *dt_bias[2], *dn_norm_w;
  const float *lam_re[2], *lam_im[2], *log_step[2], *b_re[2], *b_im[2], *c_re[2], *c_im[2];
  const float *s5_d, *glu_w, *glu_b, *w_out, *final_norm_w;
  float* out;
  char* ws;
  int p_lo, p_hi;
};

DI unsigned pk2(float a, float b) { f32x2 v = {a, b}; bf2_t r = __builtin_convertvector(v, bf2_t); return __builtin_bit_cast(unsigned, r); }
DI bf16_t f2bf(float a) { return (bf16_t)(pk2(a, 0.f) & 0xffffu); }
DI float bf2f(bf16_t v) { return __uint_as_float(((unsigned)v) << 16); }
DI float bflo(unsigned u) { return __uint_as_float(u << 16); }
DI float bfhi(unsigned u) { return __uint_as_float(u & 0xffff0000u); }
DI float sigmoidf_(float x) { return 1.f / (1.f + __expf(-x)); }
DI float siluf_(float x) { return x / (1.f + __expf(-x)); }
DI float gelu_tanh(float x) { float u = 0.7978845608028654f * (x + 0.044715f * x * x * x); float e = __expf(2.f * u); float t = 1.f - 2.f / (e + 1.f); return 0.5f * x * (1.f + t); }
DI float softplusf_(float x) { return x > 15.f ? x : log1pf(expf(x)); }
DI float wave_sum(float v) {
#pragma unroll
  for (int o = 1; o < 64; o <<= 1) v += __shfl_xor(v, o);
  return v;
}
DI void lds_barrier() { asm volatile("s_waitcnt lgkmcnt(0)" ::: "memory"); __builtin_amdgcn_s_barrier(); asm volatile("" ::: "memory"); }
typedef unsigned long long u64_t;
DI u64_t ld8_pinned(const void* p) { return __hip_atomic_load((const u64_t*)p, __ATOMIC_RELAXED, __HIP_MEMORY_SCOPE_WORKGROUP); }
DI float ld4_pinned(const void* p) { return __builtin_bit_cast(float, __hip_atomic_load((const unsigned*)p, __ATOMIC_RELAXED, __HIP_MEMORY_SCOPE_WORKGROUP)); }
DI int crow(int reg, int h) { return (reg & 3) + 8 * (reg >> 2) + 4 * h; }
DI bf16x8 pack8(const f32x16& x, int s) {
  u32x4 p;
  p[0] = pk2(x[8 * s + 0], x[8 * s + 1]); p[1] = pk2(x[8 * s + 2], x[8 * s + 3]);
  p[2] = pk2(x[8 * s + 4], x[8 * s + 5]); p[3] = pk2(x[8 * s + 6], x[8 * s + 7]);
  return __builtin_bit_cast(bf16x8, p);
}
DI bf16x8 ldfrag(const bf16_t* base, int row, int stride, int col) {
  const bf16_t* p = base + row * stride + col;
  u32x2 lo = *(const u32x2*)p, hi = *(const u32x2*)(p + 8);
  u32x4 v = {lo[0], lo[1], hi[0], hi[1]};
  return __builtin_bit_cast(bf16x8, v);
}
#define MFMA32(a, b, c) __builtin_amdgcn_mfma_f32_32x32x16_bf16((a), (b), (c), 0, 0, 0)
#define MFMA16(a, b, c) __builtin_amdgcn_mfma_f32_16x16x32_bf16((a), (b), (c), 0, 0, 0)

constexpr int G_HTB = 128 * 64 * 2;
DI int lds_byte(int r, int c) { const int st = (r >> 4) * 2 + (c >> 5), rr = r & 15, cc = c & 31, ob = rr * 64 + cc * 2; return st * 1024 + (ob ^ (((ob >> 9) & 1) << 5)); }
DI void stage_rc(int b, int& R, int& C) { const int st = b / 1024, sb = b % 1024, swz = sb ^ (((sb >> 9) & 1) << 5); R = (st >> 1) * 16 + swz / 64; C = (st & 1) * 32 + (swz % 64) / 2; }
template <bool TRANS, bool PERM = false>
DI void gemm256(const bf16_t* __restrict__ A, int lda, const bf16_t* __restrict__ Bt, int ldb, int K, LAS unsigned char* lds, f32x4 (&acc)[2][2][4][2]) {
  const int tid = threadIdx.x, wid = __builtin_amdgcn_readfirstlane(tid >> 6), lane = tid & 63, wr = wid >> 2, wc = wid & 3, fr = lane & 15, fq = lane >> 4;
  unsigned voffA[2], voffB[2];
#pragma unroll
  for (int i = 0; i < 2; ++i) {
    int R, C; stage_rc(tid * 16 + i * 8192, R, C);
    const int Rb = PERM ? ((R & ~31) + 8 * ((R & 15) >> 2) + 4 * ((R >> 4) & 1) + (R & 3)) : R;
    voffA[i] = (unsigned)(R * lda + C) * 2u; voffB[i] = (unsigned)(Rb * ldb + C) * 2u;
  }
  const unsigned ldsw = (unsigned)wid * 1024u;
  const int aoff = lds_byte(wr * 64 + fr, fq * 8), boff = lds_byte(wc * 32 + fr, fq * 8);
  const char* cA0 = (const char*)A; const char* cA1 = cA0 + (size_t)128 * lda * 2;
  const char* cB0 = (const char*)Bt; const char* cB1 = cB0 + (size_t)128 * ldb * 2;
#define G_SA(b, h) (((b) * 2 + (h)) * G_HTB)
#define G_SB(b, h) ((4 + (b) * 2 + (h)) * G_HTB)
#define G_STAGE(bufoff, gbase, voff, kt) do { _Pragma("unroll") for (int _i = 0; _i < 2; ++_i) \
    __builtin_amdgcn_global_load_lds((const unsigned*)((gbase) + (size_t)(kt) * 128 + (voff)[_i]), (LAS unsigned*)(lds + (bufoff) + ldsw + _i * 8192), 16, 0, 0); } while (0)
#define G_LDA(dst, b, h) do { _Pragma("unroll") for (int m = 0; m < 4; ++m) _Pragma("unroll") for (int k = 0; k < 2; ++k) dst[m][k] = *(const LAS bf16x8*)(lds + G_SA(b, h) + aoff + m * 2048 + k * 1024); } while (0)
#define G_LDB(dst, b, h) do { _Pragma("unroll") for (int n = 0; n < 2; ++n) _Pragma("unroll") for (int k = 0; k < 2; ++k) dst[n][k] = *(const LAS bf16x8*)(lds + G_SB(b, h) + boff + n * 2048 + k * 1024); } while (0)
#define G_MMA(ai, bj, At_, Bt_) do { __builtin_amdgcn_s_setprio(1); _Pragma("unroll") for (int m = 0; m < 4; ++m) _Pragma("unroll") for (int n = 0; n < 2; ++n) _Pragma("unroll") for (int k = 0; k < 2; ++k) \
    acc[ai][bj][m][n] = TRANS ? MFMA16(Bt_[n][k], At_[m][k], acc[ai][bj][m][n]) : MFMA16(At_[m][k], Bt_[n][k], acc[ai][bj][m][n]); __builtin_amdgcn_s_setprio(0); } while (0)
#define G_WAIT_V(n) asm volatile("s_waitcnt vmcnt(" #n ")" ::: "memory")
#define G_WAIT_L(n) asm volatile("s_waitcnt lgkmcnt(" #n ")" ::: "memory")
#define G_BAR __builtin_amdgcn_s_barrier()
#define G_SCHED __builtin_amdgcn_sched_barrier(0)
#pragma unroll
  for (int a = 0; a < 2; ++a)
#pragma unroll
    for (int b = 0; b < 2; ++b)
#pragma unroll
      for (int m = 0; m < 4; ++m)
#pragma unroll
        for (int n = 0; n < 2; ++n) acc[a][b][m][n] = f32x4{0.f, 0.f, 0.f, 0.f};
  bf16x8 At[4][2], B0[2][2], B1[2][2];
  const int nt = K / 64;
  G_WAIT_V(0); G_WAIT_L(0); G_BAR;
  G_STAGE(G_SB(0, 0), cB0, voffB, 0); G_STAGE(G_SA(0, 0), cA0, voffA, 0);
  G_STAGE(G_SB(0, 1), cB1, voffB, 0); G_STAGE(G_SA(0, 1), cA1, voffA, 0);
  if (wr == 1) G_BAR;
  G_WAIT_V(4); G_BAR;
  G_STAGE(G_SB(1, 0), cB0, voffB, 1); G_STAGE(G_SA(1, 0), cA0, voffA, 1); G_STAGE(G_SB(1, 1), cB1, voffB, 1);
  G_WAIT_V(6); G_BAR;
  for (int t = 0; t < nt - 2; t += 2) {
    G_LDB(B0, 0, 0); G_SCHED; G_LDA(At, 0, 0); G_STAGE(G_SA(1, 1), cA1, voffA, t + 1);
    G_WAIT_L(8); G_BAR; G_WAIT_L(0); G_MMA(0, 0, At, B0); G_BAR; G_SCHED;
    G_LDB(B1, 0, 1); G_STAGE(G_SB(0, 0), cB0, voffB, t + 2);
    G_BAR; G_WAIT_L(0); G_MMA(0, 1, At, B1); G_BAR;
    G_LDA(At, 0, 1); G_STAGE(G_SA(0, 0), cA0, voffA, t + 2);
    G_BAR; G_WAIT_L(0); G_MMA(1, 0, At, B0); G_BAR; G_SCHED;
    G_STAGE(G_SB(0, 1), cB1, voffB, t + 2);
    G_WAIT_V(6); G_BAR; G_MMA(1, 1, At, B1); G_BAR;
    G_LDB(B0, 1, 0); G_SCHED; G_LDA(At, 1, 0); G_STAGE(G_SA(0, 1), cA1, voffA, t + 2);
    G_WAIT_L(8); G_BAR; G_WAIT_L(0); G_MMA(0, 0, At, B0); G_BAR; G_SCHED;
    G_LDB(B1, 1, 1); G_STAGE(G_SB(1, 0), cB0, voffB, t + 3);
    G_BAR; G_WAIT_L(0); G_MMA(0, 1, At, B1); G_BAR;
    G_LDA(At, 1, 1); G_STAGE(G_SA(1, 0), cA0, voffA, t + 3);
    G_BAR; G_WAIT_L(0); G_MMA(1, 0, At, B0); G_BAR; G_SCHED;
    G_STAGE(G_SB(1, 1), cB1, voffB, t + 3);
    G_WAIT_V(6); G_BAR; G_MMA(1, 1, At, B1); G_BAR;
  }
  { G_LDB(B0, 0, 0); G_LDA(At, 0, 0); G_STAGE(G_SA(1, 1), cA1, voffA, nt - 1);
    G_BAR; G_WAIT_L(0); G_MMA(0, 0, At, B0); G_BAR;
    G_LDB(B1, 0, 1); G_BAR; G_WAIT_L(0); G_MMA(0, 1, At, B1); G_BAR;
    G_LDA(At, 0, 1); G_WAIT_V(4); G_BAR; G_WAIT_L(0); G_MMA(1, 0, At, B0); G_MMA(1, 1, At, B1); G_BAR; }
  { G_LDB(B0, 1, 0); G_LDA(At, 1, 0); G_WAIT_V(2); G_BAR; G_WAIT_L(0); G_MMA(0, 0, At, B0); G_BAR;
    G_LDB(B1, 1, 1); G_WAIT_V(0); G_BAR; G_WAIT_L(0); G_MMA(0, 1, At, B1); G_BAR;
    G_LDA(At, 1, 1); G_BAR; G_WAIT_L(0); G_MMA(1, 0, At, B0); G_MMA(1, 1, At, B1); G_BAR; }
  if (wr == 0) G_BAR;
}

template <bool TRANS, bool PERM, class TileFn, class EpiFn>
DI void gemm256_stream(int nj, int nt, int lda, int ldb, TileFn tilefn, EpiFn epifn, LAS unsigned char* lds) {
  if (nj <= 0) return;
  const int tid = threadIdx.x, wid = __builtin_amdgcn_readfirstlane(tid >> 6), lane = tid & 63, wr = wid >> 2, wc = wid & 3, fr = lane & 15, fq = lane >> 4;
  unsigned voffA[2], voffB[2];
#pragma unroll
  for (int i = 0; i < 2; ++i) {
    int R, C; stage_rc(tid * 16 + i * 8192, R, C);
    const int Rb = PERM ? ((R & ~31) + 8 * ((R & 15) >> 2) + 4 * ((R >> 4) & 1) + (R & 3)) : R;
    voffA[i] = (unsigned)(R * lda + C) * 2u; voffB[i] = (unsigned)(Rb * ldb + C) * 2u;
  }
  const unsigned ldsw = (unsigned)wid * 1024u;
  const int aoff = lds_byte(wr * 64 + fr, fq * 8), boff = lds_byte(wc * 32 + fr, fq * 8);
  const size_t hA = (size_t)128 * lda * 2, hB = (size_t)128 * ldb * 2;
  const char *cA, *cB, *nA, *nB;
  { const bf16_t *a, *b; tilefn(0, a, b); cA = (const char*)a; cB = (const char*)b; nA = cA; nB = cB; if (nj > 1) { tilefn(1, a, b); nA = (const char*)a; nB = (const char*)b; } }
  int j = 0, tbeg = 0, tend = nt;
#define GS_A(g, h) (((g) < tend ? cA + (size_t)((g) - tbeg) * 128 : nA + (size_t)((g) - tend) * 128) + (h) * hA)
#define GS_B(g, h) (((g) < tend ? cB + (size_t)((g) - tbeg) * 128 : nB + (size_t)((g) - tend) * 128) + (h) * hB)
#define GS_STAGE(bufoff, gptr, voff) do { const char* _p = (gptr); _Pragma("unroll") for (int _i = 0; _i < 2; ++_i) \
    __builtin_amdgcn_global_load_lds((const unsigned*)(_p + (voff)[_i]), (LAS unsigned*)(lds + (bufoff) + ldsw + _i * 8192), 16, 0, 0); } while (0)
  f32x4 acc[2][2][4][2];
#pragma unroll
  for (int a = 0; a < 2; ++a)
#pragma unroll
    for (int b = 0; b < 2; ++b)
#pragma unroll
      for (int m = 0; m < 4; ++m)
#pragma unroll
        for (int n = 0; n < 2; ++n) acc[a][b][m][n] = f32x4{0.f, 0.f, 0.f, 0.f};
  bf16x8 At[4][2], B0[2][2], B1[2][2];
  const int total = nj * nt;
  G_WAIT_V(0); G_WAIT_L(0); G_BAR;
  GS_STAGE(G_SB(0, 0), GS_B(0, 0), voffB); GS_STAGE(G_SA(0, 0), GS_A(0, 0), voffA);
  GS_STAGE(G_SB(0, 1), GS_B(0, 1), voffB); GS_STAGE(G_SA(0, 1), GS_A(0, 1), voffA);
  if (wr == 1) G_BAR;
  G_WAIT_V(4); G_BAR;
  GS_STAGE(G_SB(1, 0), GS_B(1, 0), voffB); GS_STAGE(G_SA(1, 0), GS_A(1, 0), voffA); GS_STAGE(G_SB(1, 1), GS_B(1, 1), voffB);
  G_WAIT_V(6); G_BAR;
  for (int t = 0; t < total - 2; t += 2) {
    G_LDB(B0, 0, 0); G_SCHED; G_LDA(At, 0, 0); GS_STAGE(G_SA(1, 1), GS_A(t + 1, 1), voffA);
    G_WAIT_L(8); G_BAR; G_WAIT_L(0); G_MMA(0, 0, At, B0); G_BAR; G_SCHED;
    G_LDB(B1, 0, 1); GS_STAGE(G_SB(0, 0), GS_B(t + 2, 0), voffB);
    G_BAR; G_WAIT_L(0); G_MMA(0, 1, At, B1); G_BAR;
    G_LDA(At, 0, 1); GS_STAGE(G_SA(0, 0), GS_A(t + 2, 0), voffA);
    G_BAR; G_WAIT_L(0); G_MMA(1, 0, At, B0); G_BAR; G_SCHED;
    GS_STAGE(G_SB(0, 1), GS_B(t + 2, 1), voffB);
    G_WAIT_V(6); G_BAR; G_MMA(1, 1, At, B1); G_BAR;
    G_LDB(B0, 1, 0); G_SCHED; G_LDA(At, 1, 0); GS_STAGE(G_SA(0, 1), GS_A(t + 2, 1), voffA);
    G_WAIT_L(8); G_BAR; G_WAIT_L(0); G_MMA(0, 0, At, B0); G_BAR; G_SCHED;
    G_LDB(B1, 1, 1); GS_STAGE(G_SB(1, 0), GS_B(t + 3, 0), voffB);
    G_BAR; G_WAIT_L(0); G_MMA(0, 1, At, B1); G_BAR;
    G_LDA(At, 1, 1); GS_STAGE(G_SA(1, 0), GS_A(t + 3, 0), voffA);
    G_BAR; G_WAIT_L(0); G_MMA(1, 0, At, B0); G_BAR; G_SCHED;
    GS_STAGE(G_SB(1, 1), GS_B(t + 3, 1), voffB);
    G_WAIT_V(6); G_BAR; G_MMA(1, 1, At, B1); G_BAR;
    if (t + 2 == tend) {
      epifn(j, acc);
#pragma unroll
      for (int a = 0; a < 2; ++a)
#pragma unroll
        for (int b = 0; b < 2; ++b)
#pragma unroll
          for (int m = 0; m < 4; ++m)
#pragma unroll
            for (int n = 0; n < 2; ++n) acc[a][b][m][n] = f32x4{0.f, 0.f, 0.f, 0.f};
      ++j; tbeg = tend; tend += nt; cA = nA; cB = nB;
      if (j + 1 < nj) { const bf16_t *a, *b; tilefn(j + 1, a, b); nA = (const char*)a; nB = (const char*)b; }
    }
  }
  { G_LDB(B0, 0, 0); G_LDA(At, 0, 0); GS_STAGE(G_SA(1, 1), GS_A(total - 1, 1), voffA);
    G_BAR; G_WAIT_L(0); G_MMA(0, 0, At, B0); G_BAR;
    G_LDB(B1, 0, 1); G_BAR; G_WAIT_L(0); G_MMA(0, 1, At, B1); G_BAR;
    G_LDA(At, 0, 1); G_WAIT_V(4); G_BAR; G_WAIT_L(0); G_MMA(1, 0, At, B0); G_MMA(1, 1, At, B1); G_BAR; }
  { G_LDB(B0, 1, 0); G_LDA(At, 1, 0); G_WAIT_V(2); G_BAR; G_WAIT_L(0); G_MMA(0, 0, At, B0); G_BAR;
    G_LDB(B1, 1, 1); G_WAIT_V(0); G_BAR; G_WAIT_L(0); G_MMA(0, 1, At, B1); G_BAR;
    G_LDA(At, 1, 1); G_BAR; G_WAIT_L(0); G_MMA(1, 0, At, B0); G_MMA(1, 1, At, B1); G_BAR; }
  if (wr == 0) G_BAR;
  epifn(j, acc);
}

DI void p0_mod_item(const Params& P, char* smem, int it) {
  float* ssil = (float*)smem;
  float* sred = ssil + 16 * 1024;
  const int tid = threadIdx.x, cl = tid & 31, ks = tid >> 5, col = it * 32 + cl;
  __syncthreads();
  for (int e = tid; e < 16 * 1024; e += NTHR) ssil[e] = siluf_(P.c[e]);
  __syncthreads();
  float acc[16];
#pragma unroll
  for (int b = 0; b < 16; ++b) acc[b] = 0.f;
#pragma unroll 1
  for (int k0 = ks * 64; k0 < ks * 64 + 64; k0 += 16) {
    float w[16];
#pragma unroll
    for (int u = 0; u < 16; ++u) w[u] = P.ada_w[(size_t)(k0 + u) * 3072 + col];
#pragma unroll
    for (int u = 0; u < 16; ++u)
#pragma unroll
      for (int b = 0; b < 16; ++b) acc[b] += ssil[b * 1024 + k0 + u] * w[u];
  }
#pragma unroll
  for (int b = 0; b < 16; ++b) sred[(ks * 16 + b) * 32 + cl] = acc[b];
  __syncthreads();
  {
    const int b = tid >> 5;
    float s = P.ada_b[col];
#pragma unroll
    for (int k2 = 0; k2 < 16; ++k2) s += sred[(k2 * 16 + b) * 32 + cl];
    ((float*)(P.ws + OFF_MOD))[b * 3072 + col] = s;
  }
}
DI void p0_transpose_item(const float* __restrict__ src, int N, int K, int k0, int srcn0, int nvalid, bf16_t* __restrict__ dst, int dstn0, float* s, int tid) {
  const int n = tid & 31, kr = tid >> 5;
#pragma unroll
  for (int i = 0; i < 8; ++i) { const int k = kr + 8 * i; s[k * 33 + n] = (n < nvalid) ? src[(size_t)(k0 + k) * N + srcn0 + n] : 0.f; }
  __syncthreads();
  const int on = tid >> 3, kc = tid & 7;
  u32x4 o;
  o[0] = pk2(s[(kc * 8 + 0) * 33 + on], s[(kc * 8 + 1) * 33 + on]); o[1] = pk2(s[(kc * 8 + 2) * 33 + on], s[(kc * 8 + 3) * 33 + on]);
  o[2] = pk2(s[(kc * 8 + 4) * 33 + on], s[(kc * 8 + 5) * 33 + on]); o[3] = pk2(s[(kc * 8 + 6) * 33 + on], s[(kc * 8 + 7) * 33 + on]);
  *(u32x4*)(dst + (size_t)(dstn0 + on) * K + k0 + kc * 8) = o;
  __syncthreads();
}
DI void s5_lambda(const Params& P, int g, int dir, int n, float& dt, float& lr, float& li) {
  dt = expf(P.log_step[dir][g]); lr = P.lam_re[dir][g * 64 + n]; li = P.lam_im[dir][g * 64 + n];
}
DI void cpow(float dt, float lr, float li, float e, float& re, float& im) {
  const float mag = __expf(lr * dt * e), x = li * dt * e;
  const float n = rintf(x * 0.15915494309189535f);
  const float y = fmaf(n, -6.2831854820251465f, x) + n * 1.7484556000744883e-7f;
  re = mag * __cosf(y); im = mag * __sinf(y);
}
DI void s5_f(float dt, float lr, float li, float& fre, float& fim) {
  float ar, ai; cpow(dt, lr, li, 1.f, ar, ai);
  const float nr = ar - 1.f, ni = ai, den = lr * lr + li * li;
  fre = (nr * lr + ni * li) / den; fim = (ni * lr - nr * li) / den;
}
DI void p0_ktab_item(const Params& P, float* sm, int it, int tid) {
  const int tb = it & 7, dir = (it >> 3) & 1, g = it >> 4;
  float* sw = sm;
  float* sG = sw + 1024;
  float* sC = sG + 2048;
  for (int e = tid; e < 512; e += 256) {
    const int n = e & 63, tau = tb * 8 + (e >> 6);
    float dt, lr, li; s5_lambda(P, g, dir, n, dt, lr, li);
    float fr_, fi_, ar, ai; s5_f(dt, lr, li, fr_, fi_); cpow(dt, lr, li, (float)tau, ar, ai);
    sw[e * 2] = fr_ * ar - fi_ * ai; sw[e * 2 + 1] = fr_ * ai + fi_ * ar;
  }
  for (int e = tid; e < 1024; e += 256) { sC[e * 2] = P.c_re[dir][g * 1024 + e]; sC[e * 2 + 1] = P.c_im[dir][g * 1024 + e]; }
  float br[4], bi[4];
#pragma unroll
  for (int k = 0; k < 4; ++k) { const int e = tid + 256 * k; br[k] = P.b_re[dir][g * 1024 + e]; bi[k] = P.b_im[dir][g * 1024 + e]; }
  const int p = tid >> 4, q = tid & 15;
  for (int t8 = 0; t8 < 8; ++t8) {
    __syncthreads();
#pragma unroll
    for (int k = 0; k < 4; ++k) {
      const int e = tid + 256 * k, n = e >> 4;
      const float wr_ = sw[(t8 * 64 + n) * 2], wi_ = sw[(t8 * 64 + n) * 2 + 1];
      sG[e * 2] = wr_ * br[k] - wi_ * bi[k]; sG[e * 2 + 1] = wr_ * bi[k] + wi_ * br[k];
    }
    __syncthreads();
    float acc = 0.f;
#pragma unroll 8
    for (int n = 0; n < 64; ++n) acc += sC[(p * 64 + n) * 2] * sG[(n * 16 + q) * 2] - sC[(p * 64 + n) * 2 + 1] * sG[(n * 16 + q) * 2 + 1];
    ((float*)(P.ws + OFF_KTAB))[((size_t)(g * 2 + dir) * 64 + tb * 8 + t8) * 256 + tid] = acc;
  }
  __syncthreads();
}
DI void phase0(const Params& P, char* smem) {
  const int bid = blockIdx.x, nb = gridDim.x, tid = threadIdx.x, hb = tid >> 8, t2 = tid & 255;
  {
    f32x2* PW = (f32x2*)(P.ws + OFF_PW); f32x2* FB = (f32x2*)(P.ws + OFF_FB);
    const int total = 32 * 2 * 65 * 64;
    for (int e = bid * NTHR + tid; e < total; e += nb * NTHR) {
      const int n = e & 63, ex = (e >> 6) % 65, gd = (e >> 6) / 65, dir = gd & 1, g = gd >> 1;
      float dt, lr, li; s5_lambda(P, g, dir, n, dt, lr, li);
      float re, im; cpow(dt, lr, li, (float)ex, re, im);
      PW[e] = f32x2{re, im};
      if (ex == 0) { float fr_, fi_; s5_f(dt, lr, li, fr_, fi_); FB[gd * 64 + n] = f32x2{fr_, fi_}; }
    }
  }
  if (bid == 0 && tid < 16) ((unsigned*)(P.ws + OFF_CTR))[tid] = 0u;
  for (int it = bid; it < 96; it += nb) p0_mod_item(P, smem, it);
}
DI void p1_compute(const Params& P, char* smem) {
  const int bid = blockIdx.x, nb = gridDim.x, tid = threadIdx.x, hb = tid >> 8, t2 = tid & 255;
  __syncthreads();
  constexpr int I1 = 1664, I2 = 256, I3 = 512;
  float* str = (float*)smem + hb * (64 * 33);
  for (int it = bid * 2 + hb; it < I1 + I2 + I3; it += nb * 2) {
    int r = it;
    if (r < I1) {
      const int kb = r / 104, nt = r % 104, n0 = nt * 32; int nvalid = INC - n0; nvalid = nvalid < 0 ? 0 : (nvalid > 32 ? 32 : nvalid);
      p0_transpose_item(P.w_in, INC, DM, kb * 64, n0, nvalid, (bf16_t*)(P.ws + OFF_WINT), n0, str, t2); continue;
    } r -= I1;
    if (r < I2) {
      const int kb = r / 32, nt = r % 32, n0 = nt * 32, t = n0 >> 8, i = n0 & 255;
      const int src0 = (i < 128) ? t * 128 + i : 512 + t * 128 + (i - 128);
      p0_transpose_item(P.glu_w, 1024, 512, kb * 64, src0, 32, (bf16_t*)(P.ws + OFF_GLUWT), n0, str, t2); continue;
    } r -= I2;
    { const int kb = r / 32, nt = r % 32; p0_transpose_item(P.w_out, 1024, 1024, kb * 64, nt * 32, 32, (bf16_t*)(P.ws + OFF_WOUTT), nt * 32, str, t2); }
  }
  __syncthreads();
  float* skt = (float*)smem + hb * 5120;
  for (int it = bid * 2 + hb; it < 512; it += nb * 2) p0_ktab_item(P, skt, it, t2);
}
DI void phase1(const Params& P, char* smem) {
  const int bid = blockIdx.x, nb = gridDim.x, tid = threadIdx.x, lane = tid & 63, wid = tid >> 6;
  const float* mod = (const float*)(P.ws + OFF_MOD);
  bf16_t* hB = (bf16_t*)(P.ws + OFF_HB);
#pragma unroll 1
  for (int pass = 0; pass < 2; ++pass) {
  const bool rows_now = (pass == 0) != (((blockIdx.x >> 3) & 1) != 0);
  if (rows_now) {
  for (int row0 = (bid * NWV + wid) * 4; row0 < NTOK; row0 += nb * NWV * 4) {
    f32x4 v[4][4];
#pragma unroll
    for (int u = 0; u < 4; ++u) {
      const f32x4* xr = (const f32x4*)(P.x + (size_t)(row0 + u) * DM) + lane;
#pragma unroll
      for (int j = 0; j < 4; ++j) v[u][j] = xr[64 * j];
    }
#pragma unroll
    for (int u = 0; u < 4; ++u) {
      const int row = row0 + u, b = row >> 12;
      float s = 0.f;
#pragma unroll
      for (int j = 0; j < 4; ++j) s += v[u][j][0] * v[u][j][0] + v[u][j][1] * v[u][j][1] + v[u][j][2] * v[u][j][2] + v[u][j][3] * v[u][j][3];
      const float rstd = rsqrtf(wave_sum(s) * (1.f / DM) + 1e-6f);
#pragma unroll
      for (int j = 0; j < 4; ++j) {
        const int col = lane * 4 + 256 * j;
        const f32x4 nw = *(const f32x4*)(P.norm_w + col), sh = *(const f32x4*)(mod + b * 3072 + col), sc = *(const f32x4*)(mod + b * 3072 + 1024 + col);
        float h[4];
#pragma unroll
        for (int e = 0; e < 4; ++e) h[e] = v[u][j][e] * rstd * nw[e] * (1.f + sc[e]) + sh[e];
        u32x2 o = {pk2(h[0], h[1]), pk2(h[2], h[3])};
        *(u32x2*)(hB + (size_t)row * DM + col) = o;
      }
    }
  }
  } else {
  p1_compute(P, smem);
  __syncthreads();
  const float* KT = (const float*)(P.ws + OFF_KTAB);
  const f32x2* PW = (const f32x2*)(P.ws + OFF_PW); const f32x2* FB = (const f32x2*)(P.ws + OFF_FB);
  bf16_t* MY = (bf16_t*)(P.ws + OFF_MY); bf16_t* MS = (bf16_t*)(P.ws + OFF_MS);
  const int totalS = 32 * 256 * 128;
  for (int e = bid * NTHR + tid; e < totalS; e += nb * NTHR) {
    const int kc = e & 127, row = (e >> 7) & 255, g = e >> 15, dir = row >> 7, part = (row >> 6) & 1, n = row & 63;
    const int s = kc >> 1, q0 = (kc & 1) * 8, ex = dir == 0 ? 63 - s : s;
    const f32x2 a = PW[((g * 2 + dir) * 65 + ex) * 64 + n], f = FB[(g * 2 + dir) * 64 + n];
    const float wr_ = a[0] * f[0] - a[1] * f[1], wi_ = a[0] * f[1] + a[1] * f[0];
    float o[8];
#pragma unroll
    for (int j = 0; j < 8; ++j) {
      const float br = P.b_re[dir][(g * 64 + n) * 16 + q0 + j], bi = P.b_im[dir][(g * 64 + n) * 16 + q0 + j];
      o[j] = part == 0 ? (wr_ * br - wi_ * bi) : (wr_ * bi + wi_ * br);
    }
    u32x4 ov = {pk2(o[0], o[1]), pk2(o[2], o[3]), pk2(o[4], o[5]), pk2(o[6], o[7])};
    *(u32x4*)(MS + ((size_t)(g * 256 + row) * 1024 + kc * 8)) = ov;
  }
  }
  }
}
DI void p3_mygen(const Params& P) {
  const int bid = blockIdx.x, nb = gridDim.x, tid = threadIdx.x;
  const float* KT = (const float*)(P.ws + OFF_KTAB);
  const f32x2* PW = (const f32x2*)(P.ws + OFF_PW); const f32x2* FB = (const f32x2*)(P.ws + OFF_FB);
  bf16_t* MY = (bf16_t*)(P.ws + OFF_MY); bf16_t* MS = (bf16_t*)(P.ws + OFF_MS);
  const int totalY = 32 * 1024 * 160;
  for (int e = bid * NTHR + tid; e < totalY; e += nb * NTHR) {
    const int kc = e % 160, row = (e / 160) & 1023, g = e / (160 * 1024), t = row >> 4, p = row & 15;
    float o[8];
    if (kc < 128) {
      const int s = kc >> 1, q0 = (kc & 1) * 8;
      if (t == s) {
        const float* k0 = KT + ((size_t)((g * 2 + 0) * 64 + 0) * 256 + p * 16 + q0); const float* k1 = KT + ((size_t)((g * 2 + 1) * 64 + 0) * 256 + p * 16 + q0);
#pragma unroll
        for (int j = 0; j < 8; ++j) o[j] = k0[j] + k1[j] + ((q0 + j == p) ? P.s5_d[g * 16 + p] : 0.f);
      } else {
        const int dir = t > s ? 0 : 1, tau = t > s ? t - s : s - t;
        const float* k0 = KT + ((size_t)((g * 2 + dir) * 64 + tau) * 256 + p * 16 + q0);
#pragma unroll
        for (int j = 0; j < 8; ++j) o[j] = k0[j];
      }
    } else {
      const int c2 = (kc - 128) * 8, dir = c2 >> 7, part = (c2 >> 6) & 1, n0 = c2 & 63;
      const int ex = dir == 0 ? t + 1 : 64 - t;
#pragma unroll
      for (int j = 0; j < 8; ++j) {
        const int n = n0 + j; const f32x2 a = PW[((g * 2 + dir) * 65 + ex) * 64 + n];
        const float cr = P.c_re[dir][(g * 16 + p) * 64 + n], ci = P.c_im[dir][(g * 16 + p) * 64 + n];
        o[j] = part == 0 ? (cr * a[0] - ci * a[1]) : -(cr * a[1] + ci * a[0]);
      }
    }
    u32x4 ov = {pk2(o[0], o[1]), pk2(o[2], o[3]), pk2(o[4], o[5]), pk2(o[6], o[7])};
    *(u32x4*)(MY + ((size_t)(g * 1024 + row) * 1280 + kc * 8)) = ov;
  }
}
DI void phase2(const Params& P, LAS unsigned char* lds) {
  const int tid = threadIdx.x, lane = tid & 63, wid = tid >> 6, wr = wid >> 2, wc = wid & 3, fr = lane & 15, fq = lane >> 4;
  const bf16_t* hB = (const bf16_t*)(P.ws + OFF_HB); const bf16_t* W = (const bf16_t*)(P.ws + OFF_WINT);
  bf16_t* U5 = (bf16_t*)(P.ws + OFF_U5); bf16_t* ZA = (bf16_t*)(P.ws + OFF_ZA); bf16_t* ZB = (bf16_t*)(P.ws + OFF_ZB);
  bf16_t* QKV = (bf16_t*)(P.ws + OFF_QKVRAW); float* BA = (float*)(P.ws + OFF_BA);
  constexpr int NT = 13, NTILES = 256 * NT;
  const int bid = blockIdx.x, nbk = gridDim.x, nj = bid < NTILES ? (NTILES - bid + nbk - 1) / nbk : 0;
  auto tile_of = [&](int j, int& tm, int& tn) { const int id = bid + j * nbk, grp = id / (8 * NT), ig = id % (8 * NT); tm = grp * 8 + (ig & 7); tn = ig >> 3; };
  gemm256_stream<true, true>(nj, DM / 64, DM, DM,
    [&](int j, const bf16_t*& A, const bf16_t*& Bt) { int tm, tn; tile_of(j, tm, tn); A = hB + (size_t)tm * 256 * DM; Bt = W + (size_t)tn * 256 * DM; },
    [&](int j, f32x4 (&acc)[2][2][4][2]) {
      int tm, tn; tile_of(j, tm, tn);
#pragma unroll
      for (int ai = 0; ai < 2; ++ai)
#pragma unroll
        for (int m = 0; m < 4; ++m) {
          const int t = tm * 256 + ai * 128 + wr * 64 + m * 16 + fr;
#pragma unroll
          for (int bj = 0; bj < 2; ++bj) {
            const int col = tn * 256 + bj * 128 + wc * 32 + fq * 8;
            const f32x4 v0 = acc[ai][bj][m][0], v1 = acc[ai][bj][m][1];
            if (tn == 12) { if (col < INC) { *(f32x4*)(BA + (size_t)t * 16 + (col - 3072)) = v0; *(f32x4*)(BA + (size_t)t * 16 + (col - 3072) + 4) = v1; } continue; }
            const u32x4 o = {pk2(v0[0], v0[1]), pk2(v0[2], v0[3]), pk2(v1[0], v1[1]), pk2(v1[2], v1[3])};
            if (tn < 2) { const int g = col >> 4, q = col & 15; *(u32x4*)(U5 + ((size_t)(g * 1024 + (t >> 6)) * 1280 + (t & 63) * 16 + q)) = o; }
            else if (tn < 4) *(u32x4*)(ZA + (size_t)t * 512 + (col - 512)) = o;
            else if (tn < 10) *(u32x4*)(QKV + (size_t)t * 1536 + (col - 1024)) = o;
            else *(u32x4*)(ZB + (size_t)t * 512 + (col - 2560)) = o;
          }
        }
    }, lds);
}

DI void phase3(const Params& P, LAS unsigned char* lds) {
  const int tid = threadIdx.x, lane = tid & 63, wid = tid >> 6, wr = wid >> 2, wc = wid & 3, fr = lane & 15, fq = lane >> 4;
  const bf16_t* MS = (const bf16_t*)(P.ws + OFF_MS); const bf16_t* U5 = (const bf16_t*)(P.ws + OFF_U5);
  float* SC = P.out;
  const int nrep3a_ = (REP_PHASE == 30) ? P.p_hi - 7 : 1;
  for (int rep3a_ = 0; rep3a_ < nrep3a_; ++rep3a_)
  for (int id = blockIdx.x; id < 128; id += gridDim.x) {
    const int g = id >> 2, tn = id & 3;
    f32x4 acc[2][2][4][2];
    gemm256<false>(MS + (size_t)(g * 256) * 1024, 1024, U5 + (size_t)(g * 1024 + tn * 256) * 1280, 1280, 1024, lds, acc);
#pragma unroll
    for (int ai = 0; ai < 2; ++ai)
#pragma unroll
      for (int bj = 0; bj < 2; ++bj)
#pragma unroll
        for (int m = 0; m < 4; ++m)
#pragma unroll
          for (int n = 0; n < 2; ++n) {
            const int row0 = ai * 128 + wr * 64 + m * 16 + fq * 4, col = tn * 256 + bj * 128 + wc * 32 + n * 16 + fr;
            *(f32x4*)(SC + ((size_t)(g * 1024 + col) * 256 + row0)) = acc[ai][bj][m][n];
          }
  }
  const bf16_t* QKV = (const bf16_t*)(P.ws + OFF_QKVRAW);
  const int nbk = gridDim.x, vb = (blockIdx.x + nbk - (128 % nbk)) % nbk;
  const int nrep3b_ = (REP_PHASE == 31) ? P.p_hi - 7 : 1;
  for (int rep3b_ = 0; rep3b_ < nrep3b_; ++rep3b_)
  for (int it = vb * NWV + wid; it < 16 * 128 * 3; it += nbk * NWV) {
    const int part = it % 3, c = (it / 3) & 127, b = it / (3 * 128), h = lane >> 4;
    const int colq = part * 512 + lane * 8;
    float wt[5][8];
#pragma unroll
    for (int k = 0; k < 5; ++k) {
      const f32x4 wa = *(const f32x4*)(P.conv_w + k * 1536 + colq), wb = *(const f32x4*)(P.conv_w + k * 1536 + colq + 4);
#pragma unroll
      for (int e = 0; e < 4; ++e) { wt[k][e] = wa[e]; wt[k][4 + e] = wb[e]; }
    }
    bf16_t* dst = (bf16_t*)(P.ws + (part == 0 ? OFF_QN : part == 1 ? OFF_KN : OFF_VN)) + (size_t)(b * 4 + h) * SEQ * 128 + (lane & 15) * 8;
    const int l0 = c * 32;
#pragma unroll 1
    for (int i0 = 0; i0 < 32; i0 += 8) {
      u32x4 u[12];
#pragma unroll
      for (int k = 0; k < 12; ++k) {
        const int l = l0 + i0 - 2 + k;
        u[k] = (l >= 0 && l < SEQ) ? *(const u32x4*)(QKV + (size_t)(b * SEQ + l) * 1536 + colq) : u32x4{0u, 0u, 0u, 0u};
      }
#pragma unroll
      for (int i = 0; i < 8; ++i) {
        float y[8];
#pragma unroll
        for (int e = 0; e < 8; ++e) y[e] = 0.f;
#pragma unroll
        for (int k = 0; k < 5; ++k)
#pragma unroll
          for (int e = 0; e < 4; ++e) { y[2 * e] += wt[k][2 * e] * bflo(u[i + k][e]); y[2 * e + 1] += wt[k][2 * e + 1] * bfhi(u[i + k][e]); }
        float ss = 0.f;
#pragma unroll
        for (int e = 0; e < 8; ++e) { y[e] = siluf_(y[e]); ss += y[e] * y[e]; }
        if (part < 2) {
#pragma unroll
          for (int o = 1; o < 16; o <<= 1) ss += __shfl_xor(ss, o);
          float sc = rsqrtf(ss + 1e-6f); if (part == 0) sc *= 0.08838834764831845f;
#pragma unroll
          for (int e = 0; e < 8; ++e) y[e] *= sc;
        }
        *(u32x4*)(dst + (size_t)(l0 + i0 + i) * 128) = u32x4{pk2(y[0], y[1]), pk2(y[2], y[3]), pk2(y[4], y[5]), pk2(y[6], y[7])};
      }
    }
  }
  p3_mygen(P);
}

struct PrepIn { u32x4 k[4], q[4], v[4]; float be, al; };
DI void dn_prep_issue(const Params& P, PrepIn& I, int item, int tid) {
  const int cc = item & 63, hd = (item >> 6) & 7, b = item >> 9, dir = hd >> 2, h = hd & 3;
  const size_t base = (size_t)(b * 4 + h) * SEQ * 128;
  const bf16_t* Qn = (const bf16_t*)(P.ws + OFF_QN) + base; const bf16_t* Kn = (const bf16_t*)(P.ws + OFF_KN) + base; const bf16_t* Vn = (const bf16_t*)(P.ws + OFF_VN) + base;
#pragma unroll
  for (int k = 0; k < 4; ++k) {
    const int idx = tid + 256 * k, row = idx >> 4, ch = idx & 15, p = cc * 64 + row, l = dir ? (SEQ - 1 - p) : p;
    I.k[k] = *(const u32x4*)(Kn + (size_t)l * 128 + ch * 8); I.q[k] = *(const u32x4*)(Qn + (size_t)l * 128 + ch * 8); I.v[k] = *(const u32x4*)(Vn + (size_t)l * 128 + ch * 8);
  }
  if (tid < 64) {
    const float* BA = (const float*)(P.ws + OFF_BA);
    const int p = cc * 64 + tid, l = dir ? (SEQ - 1 - p) : p; const size_t t = (size_t)b * SEQ + l;
    I.be = BA[t * 16 + dir * 4 + h]; I.al = BA[t * 16 + 8 + dir * 4 + h];
  }
}
DI void dn_prep_loop(const Params& P, char* sm, int first, int stride, int tid) {
  const int lane = tid & 63, w = tid >> 6, r = lane & 31, hh = lane >> 5;
  bf16_t* sK = (bf16_t*)sm;
  bf16_t* sQ = sK + 64 * 132;
  bf16_t* sRv = sQ;
  bf16_t* sLm = sQ + 128 * 68;
  bf16_t* sTt = sLm + 64 * 68;
  bf16_t* sRk = sLm;
  bf16_t* sT = sTt + 64 * 68;
  float* sg = (float*)(sT + 64 * 68);
  float* sbeta = sg + 64;
  float* seg = sbeta + 64;
  bf16_t* sV = (bf16_t*)(seg + 64);
  float* GC = (float*)(P.ws + OFF_GC);
  PrepIn I;
  if (first < 8192) dn_prep_issue(P, I, first, tid);
  for (int item = first; item < 8192; item += stride) {
  const int cc = item & 63, hd = (item >> 6) & 7, dir = hd >> 2, h = hd & 3;
  lds_barrier();
#pragma unroll
  for (int k = 0; k < 4; ++k) {
    const int idx = tid + 256 * k, row = idx >> 4, ch = idx & 15;
    *(u32x2*)(sK + row * 132 + ch * 8) = u32x2{I.k[k][0], I.k[k][1]}; *(u32x2*)(sK + row * 132 + ch * 8 + 4) = u32x2{I.k[k][2], I.k[k][3]};
    *(u32x2*)(sQ + row * 132 + ch * 8) = u32x2{I.q[k][0], I.q[k][1]}; *(u32x2*)(sQ + row * 132 + ch * 8 + 4) = u32x2{I.q[k][2], I.q[k][3]};
    *(u32x2*)(sV + row * 132 + ch * 8) = u32x2{I.v[k][0], I.v[k][1]}; *(u32x2*)(sV + row * 132 + ch * 8 + 4) = u32x2{I.v[k][2], I.v[k][3]};
  }
  for (int e = tid; e < 64 * 68 / 2; e += 256) { ((unsigned*)sT)[e] = 0u; ((unsigned*)sTt)[e] = 0u; }
  if (tid < 64) {
    const float be = sigmoidf_(I.be);
    const float g = -expf(P.a_log[dir][h]) * softplusf_(I.al + P.dt_bias[dir][h]);
    float gc = g;
#pragma unroll
    for (int o = 1; o < 64; o <<= 1) { const float v = __shfl_up(gc, o); if (lane >= o) gc += v; }
    sg[tid] = gc; sbeta[tid] = be; seg[tid] = expf(gc); GC[(size_t)item * 64 + tid] = gc;
  }
  if (item + stride < 8192) dn_prep_issue(P, I, item + stride, tid);
  lds_barrier();
  {
    const int mi = w >> 1, ni = w & 1;
    f32x16 kk, qk;
#pragma unroll
    for (int i = 0; i < 16; ++i) { kk[i] = 0.f; qk[i] = 0.f; }
#pragma unroll
    for (int ks = 0; ks < 8; ++ks) {
      const bf16x8 bf = ldfrag(sK, 32 * ni + r, 132, 16 * ks + 4 * hh);
      const bf16x8 ak = ldfrag(sK, 32 * mi + r, 132, 16 * ks + 4 * hh);
      const bf16x8 aq = ldfrag(sQ, 32 * mi + r, 132, 16 * ks + 4 * hh);
      kk = MFMA32(ak, bf, kk); qk = MFMA32(aq, bf, qk);
    }
    lds_barrier();
    bf16_t* ATT = (bf16_t*)(P.ws + OFF_ATT) + (size_t)item * 4096;
    const int j = 32 * ni + r; const float gj = sg[j];
#pragma unroll
    for (int reg = 0; reg < 16; ++reg) {
      const int i = 32 * mi + crow(reg, hh);
      const float d = __expf(i >= j ? sg[i] - gj : 0.f);
      sLm[i * 68 + j] = f2bf((i > j) ? sbeta[i] * kk[reg] * d : 0.f);
      for (int rep = 0; rep <= DUPST; ++rep) { ATT[i * 64 + j] = f2bf((i >= j) ? qk[reg] * d : 0.f); asm volatile("" ::: "memory"); }
    }
  }
  lds_barrier();
  if (tid < 64) {
    const int blk = tid >> 4, c = tid & 15;
    float x[16];
#pragma unroll
    for (int i = 0; i < 16; ++i) {
      float a = (i == c) ? 1.f : 0.f;
      const bf16_t* lrow = sLm + (16 * blk + i) * 68 + 16 * blk;
#pragma unroll
      for (int j = 0; j < i; ++j) a -= bf2f(lrow[j]) * x[j];
      x[i] = a;
    }
#pragma unroll
    for (int i = 0; i < 16; ++i) { const bf16_t v = f2bf(x[i]); sT[(16 * blk + i) * 68 + 16 * blk + c] = v; sTt[(16 * blk + c) * 68 + 16 * blk + i] = v; }
  }
  lds_barrier();
  if (w < 2) {
    const int a = w;
    f32x16 X, Y;
#pragma unroll
    for (int i = 0; i < 16; ++i) { X[i] = 0.f; Y[i] = 0.f; }
    {
      bf16x8 A = ldfrag(sLm, 32 * a + r, 68, 32 * a + 4 * hh);
      if (r < 16) A = bf16x8{0, 0, 0, 0, 0, 0, 0, 0};
      X = MFMA32(A, ldfrag(sTt, 32 * a + r, 68, 32 * a + 4 * hh), X);
    }
#pragma unroll
    for (int s = 0; s < 2; ++s) Y = MFMA32(ldfrag(sT, 32 * a + r, 68, 32 * a + 16 * s + 4 * hh), pack8(X, s), Y);
    if (r < 16) {
#pragma unroll
      for (int reg = 8; reg < 16; ++reg) {
        const int i = crow(reg, hh); const bf16_t v = f2bf(-Y[reg]);
        sT[(32 * a + i) * 68 + 32 * a + r] = v; sTt[(32 * a + r) * 68 + 32 * a + i] = v;
      }
    }
  }
  lds_barrier();
  if (w == 0) {
    f32x16 X, Y;
#pragma unroll
    for (int i = 0; i < 16; ++i) { X[i] = 0.f; Y[i] = 0.f; }
#pragma unroll
    for (int s = 0; s < 2; ++s) X = MFMA32(ldfrag(sLm, 32 + r, 68, 16 * s + 4 * hh), ldfrag(sTt, r, 68, 16 * s + 4 * hh), X);
#pragma unroll
    for (int s = 0; s < 2; ++s) Y = MFMA32(ldfrag(sT, 32 + r, 68, 32 + 16 * s + 4 * hh), pack8(X, s), Y);
#pragma unroll
    for (int reg = 0; reg < 16; ++reg) sT[(32 + crow(reg, hh)) * 68 + r] = f2bf(-Y[reg]);
  }
  lds_barrier();
  {
    const int c = tid;
    if (c < 128) {
#pragma unroll 2
      for (int i0 = 0; i0 < 64; i0 += 16) {
        float x[16];
#pragma unroll
        for (int i = 0; i < 16; ++i) x[i] = bf2f(sV[(i0 + i) * 132 + c]) * sbeta[i0 + i];
#pragma unroll
        for (int i = 0; i < 16; i += 4) *(u32x2*)(sRv + c * 68 + i0 + i) = u32x2{pk2(x[i], x[i + 1]), pk2(x[i + 2], x[i + 3])};
      }
    } else {
      const int d = c - 128;
      bf16_t* Kt = (bf16_t*)(P.ws + OFF_KTT) + (size_t)item * 8192 + d * 64;
      const float gl = sg[63];
#pragma unroll 2
      for (int i = 0; i < 64; i += 8) {
        float y[8], kt[8];
#pragma unroll
        for (int e = 0; e < 8; ++e) {
          const float kv = bf2f(sK[(i + e) * 132 + d]), ge = seg[i + e];
          y[e] = kv * sbeta[i + e] * ge; kt[e] = kv * __expf(gl - sg[i + e]);
        }
        *(u32x2*)(sRk + d * 68 + i) = u32x2{pk2(y[0], y[1]), pk2(y[2], y[3])}; *(u32x2*)(sRk + d * 68 + i + 4) = u32x2{pk2(y[4], y[5]), pk2(y[6], y[7])};
        *(u32x4*)(Kt + i) = u32x4{pk2(kt[0], kt[1]), pk2(kt[2], kt[3]), pk2(kt[4], kt[5]), pk2(kt[6], kt[7])};
      }
    }
  }
  lds_barrier();
  {
    bf16_t* Ut = (bf16_t*)(P.ws + OFF_UT) + (size_t)item * 8192;
    bf16_t* Wc = (bf16_t*)(P.ws + OFF_WC) + (size_t)item * 8192;
#pragma unroll
    for (int mi = 0; mi < 2; ++mi) {
      f32x16 du, dw;
#pragma unroll
      for (int i = 0; i < 16; ++i) { du[i] = 0.f; dw[i] = 0.f; }
#pragma unroll
      for (int s = 0; s < 4; ++s) {
        if (mi == 0 && s >= 2) continue;
        const bf16x8 tf = ldfrag(sT, 32 * mi + r, 68, 16 * s + 4 * hh);
        du = MFMA32(tf, ldfrag(sRv, 32 * w + r, 68, 16 * s + 4 * hh), du);
        dw = MFMA32(ldfrag(sRk, 32 * w + r, 68, 16 * s + 4 * hh), tf, dw);
      }
#pragma unroll
      for (int g4 = 0; g4 < 4; ++g4) {
        for (int rep = 0; rep <= DUPST; ++rep) {
        *(u32x2*)(Ut + (32 * w + r) * 64 + 32 * mi + 8 * g4 + 4 * hh) = u32x2{pk2(du[4 * g4], du[4 * g4 + 1]), pk2(du[4 * g4 + 2], du[4 * g4 + 3])};
        *(u32x2*)(Wc + (32 * mi + r) * 128 + 32 * w + 8 * g4 + 4 * hh) = u32x2{pk2(dw[4 * g4], dw[4 * g4 + 1]), pk2(dw[4 * g4 + 2], dw[4 * g4 + 3])};
        asm volatile("" ::: "memory"); }
      }
    }
  }
  }
}
DI void phase4(const Params& P, char* smem) {
  const int tid = threadIdx.x;
  {
    const float* SC = P.out; bf16_t* U5 = (bf16_t*)(P.ws + OFF_U5); const f32x2* PW = (const f32x2*)(P.ws + OFF_PW);
    const int nrep0_ = (REP_PHASE == 40) ? P.p_hi - 7 : 1;
    for (int rep0_ = 0; rep0_ < nrep0_; ++rep0_)
    for (int it = blockIdx.x; it < 128; it += gridDim.x) {
      const int g = it >> 2, b = (it & 3) * 4 + (tid >> 7), dir = (tid >> 6) & 1, n = tid & 63;
      const f32x2 a = PW[((g * 2 + dir) * 65 + 64) * 64 + n];
      float xr = 0.f, xi = 0.f;
#pragma unroll 8
      for (int s = 0; s < 64; ++s) {
        const int c = dir ? 63 - s : s; const size_t nn = (size_t)g * 1024 + b * 64 + c;
        U5[nn * 1280 + 1024 + dir * 128 + n] = f2bf(xr); U5[nn * 1280 + 1024 + dir * 128 + 64 + n] = f2bf(xi);
        const float sr = SC[nn * 256 + dir * 128 + n], si = SC[nn * 256 + dir * 128 + 64 + n];
        const float nr = a[0] * xr - a[1] * xi + sr, ni = a[0] * xi + a[1] * xr + si;
        xr = nr; xi = ni;
      }
    }
  }
  const int hb = tid >> 8;
  dn_prep_loop(P, smem + hb * 78336, blockIdx.x * 2 + hb, (REP_PHASE == 41) ? gridDim.x * 2 / (P.p_hi - 7) : gridDim.x * 2, tid & 255);
}

constexpr int RB_BYTES = 60160;
struct DnLd { u64_t v[32]; float g; };
DI void dn_issue(const Params& P, DnLd& L, int seq, int cc, int lw, int lane) {
  const int b = seq >> 3, hd = seq & 7, dir = hd >> 2, h = hd & 3;
  const size_t item = (size_t)seq * 64 + cc;
  if (lw == 0) {
    const bf16_t* Wg = (const bf16_t*)(P.ws + OFF_WC) + item * 8192;
#pragma unroll
    for (int k = 0; k < 32; ++k) { const int idx = lane + 64 * k; L.v[k] = ld8_pinned(Wg + (idx >> 5) * 128 + (idx & 31) * 4); }
  } else if (lw == 1) {
    const bf16_t* Qn = (const bf16_t*)(P.ws + OFF_QN) + (size_t)(b * 4 + h) * SEQ * 128;
#pragma unroll
    for (int k = 0; k < 32; ++k) {
      const int idx = lane + 64 * k, row = idx >> 5, p = cc * 64 + row, l = dir ? (SEQ - 1 - p) : p;
      L.v[k] = ld8_pinned(Qn + (size_t)l * 128 + (idx & 31) * 4);
    }
  } else if (lw == 2) {
    const bf16_t* Kg = (const bf16_t*)(P.ws + OFF_KTT) + item * 8192;
#pragma unroll
    for (int k = 0; k < 32; ++k) { const int idx = lane + 64 * k; L.v[k] = ld8_pinned(Kg + (idx >> 4) * 64 + (idx & 15) * 4); }
  } else {
    const bf16_t* Ag = (const bf16_t*)(P.ws + OFF_ATT) + item * 4096;
#pragma unroll
    for (int k = 0; k < 16; ++k) { const int idx = lane + 64 * k; L.v[k] = ld8_pinned(Ag + (idx >> 4) * 64 + (idx & 15) * 4); }
    L.g = ld4_pinned((const float*)(P.ws + OFF_GC) + item * 64 + lane);
  }
}
DI void dn_commit(const DnLd& L, char* buf, int lw, int lane) {
  bf16_t* sW = (bf16_t*)buf; bf16_t* sQ = sW + 64 * 132; bf16_t* sA = sQ + 64 * 132; bf16_t* sKt = sA + 64 * 68;
  if (lw == 0) {
#pragma unroll
    for (int k = 0; k < 32; ++k) { const int idx = lane + 64 * k; *(u64_t*)(sW + (idx >> 5) * 132 + (idx & 31) * 4) = L.v[k]; }
  } else if (lw == 1) {
#pragma unroll
    for (int k = 0; k < 32; ++k) { const int idx = lane + 64 * k; *(u64_t*)(sQ + (idx >> 5) * 132 + (idx & 31) * 4) = L.v[k]; }
  } else if (lw == 2) {
#pragma unroll
    for (int k = 0; k < 32; ++k) { const int idx = lane + 64 * k; *(u64_t*)(sKt + (idx >> 4) * 68 + (idx & 15) * 4) = L.v[k]; }
  } else {
#pragma unroll
    for (int k = 0; k < 16; ++k) { const int idx = lane + 64 * k; *(u64_t*)(sA + (idx >> 4) * 68 + (idx & 15) * 4) = L.v[k]; }
    ((float*)(buf + 59904))[lane] = L.g;
  }
}
DI void dn_recur(const Params& P, char* smem, int seq) {
  const int tid = threadIdx.x, lane = tid & 63, w = __builtin_amdgcn_readfirstlane(tid >> 6), r = lane & 31, hh = lane >> 5;
  const int b = seq >> 3, hd = seq & 7, dir = hd >> 2, h = hd & 3;
  __syncthreads();
  if (w >= 4) {
    const int lw = w - 4;
    DnLd LA, LB;
    dn_issue(P, LA, seq, 0, lw, lane);
    dn_commit(LA, smem, lw, lane);
    dn_issue(P, LA, seq, 1, lw, lane);
    dn_issue(P, LB, seq, 2, lw, lane);
    lds_barrier();
    for (int cc = 0; cc < 64; cc += 2) {
      for (int rep = 0; rep <= DUPL; ++rep) { dn_commit(LA, smem + RB_BYTES, lw, lane); asm volatile("" ::: "memory"); }
      for (int rep = 0; rep <= DUPL; ++rep) { dn_issue(P, LA, seq, min(cc + 3, 63), lw, lane); asm volatile("" ::: "memory"); }
      lds_barrier();
      for (int rep = 0; rep <= DUPL; ++rep) { dn_commit(LB, smem, lw, lane); asm volatile("" ::: "memory"); }
      for (int rep = 0; rep <= DUPL; ++rep) { dn_issue(P, LB, seq, min(cc + 4, 63), lw, lane); asm volatile("" ::: "memory"); }
      lds_barrier();
    }
  } else {
    const int dv0 = 32 * w;
    const float* GC = (const float*)(P.ws + OFF_GC);
    bf16_t* O = (bf16_t*)P.out + (size_t)dir * NTOK * 512;
    f32x16 S[4];
#pragma unroll
    for (int t = 0; t < 4; ++t)
#pragma unroll
      for (int i = 0; i < 16; ++i) S[t][i] = 0.f;
    lds_barrier();
    for (int cc = 0; cc < 64; ++cc) {
      const size_t item = (size_t)seq * 64 + cc;
      const bf16_t* sW = (const bf16_t*)(smem + (cc & 1) * RB_BYTES); const bf16_t* sQ = sW + 64 * 132; const bf16_t* sA = sQ + 64 * 132; const bf16_t* sKt = sA + 64 * 68;
      const bf16_t* Ug = (const bf16_t*)(P.ws + OFF_UT) + item * 8192;
      f32x16 vn[2];
#pragma unroll
      for (int m = 0; m < 2; ++m)
#pragma unroll
        for (int g4 = 0; g4 < 4; ++g4) {
          const u32x2 u = *(const u32x2*)(Ug + (dv0 + r) * 64 + 32 * m + 8 * g4 + 4 * hh);
          vn[m][4 * g4 + 0] = bflo(u[0]); vn[m][4 * g4 + 1] = bfhi(u[0]); vn[m][4 * g4 + 2] = bflo(u[1]); vn[m][4 * g4 + 3] = bfhi(u[1]);
        }
      const float* sG = (const float*)(smem + (cc & 1) * RB_BYTES + 59904);
      const float egl = __expf(sG[63]);
      f32x16 aW[2], aQ[2];
#pragma unroll
      for (int m = 0; m < 2; ++m)
#pragma unroll
        for (int i = 0; i < 16; ++i) { aW[m][i] = 0.f; aQ[m][i] = 0.f; }
      bf16x8 fa[2][4];
      fa[0][0] = ldfrag(sW, r, 132, 4 * hh); fa[0][1] = ldfrag(sW, 32 + r, 132, 4 * hh);
      fa[0][2] = ldfrag(sQ, r, 132, 4 * hh); fa[0][3] = ldfrag(sQ, 32 + r, 132, 4 * hh);
#pragma unroll
      for (int ks = 0; ks < 8; ++ks) {
        const int cur = ks & 1, nxt = cur ^ 1;
        if (ks + 1 < 8) {
          fa[nxt][0] = ldfrag(sW, r, 132, 16 * (ks + 1) + 4 * hh); fa[nxt][1] = ldfrag(sW, 32 + r, 132, 16 * (ks + 1) + 4 * hh);
          fa[nxt][2] = ldfrag(sQ, r, 132, 16 * (ks + 1) + 4 * hh); fa[nxt][3] = ldfrag(sQ, 32 + r, 132, 16 * (ks + 1) + 4 * hh);
        }
        const bf16x8 sf = pack8(S[ks >> 1], ks & 1);
        aW[0] = MFMA32(fa[cur][0], sf, aW[0]); aW[1] = MFMA32(fa[cur][1], sf, aW[1]);
        aQ[0] = MFMA32(fa[cur][2], sf, aQ[0]); aQ[1] = MFMA32(fa[cur][3], sf, aQ[1]);
      }
      bf16x8 fA[4];
#pragma unroll
      for (int ks = 0; ks < 4; ++ks) fA[ks] = ldfrag(sA, r, 68, 16 * ks + 4 * hh);
#pragma unroll
      for (int m = 0; m < 2; ++m)
#pragma unroll
        for (int i = 0; i < 16; ++i) aQ[m][i] *= __expf(sG[32 * m + crow(i, hh)]);
#pragma unroll
      for (int m = 0; m < 2; ++m)
#pragma unroll
        for (int i = 0; i < 16; ++i) vn[m][i] -= aW[m][i];
      bf16x8 vf[4];
      vf[0] = pack8(vn[0], 0); vf[1] = pack8(vn[0], 1); vf[2] = pack8(vn[1], 0); vf[3] = pack8(vn[1], 1);
      bf16x8 fk[2][4];
#pragma unroll
      for (int ks = 0; ks < 4; ++ks) aQ[0] = MFMA32(fA[ks], vf[ks], aQ[0]);
#pragma unroll
      for (int ks = 0; ks < 4; ++ks) fA[ks] = ldfrag(sA, 32 + r, 68, 16 * ks + 4 * hh);
#pragma unroll
      for (int ks = 0; ks < 4; ++ks) fk[0][ks] = ldfrag(sKt, r, 68, 16 * ks + 4 * hh);
#pragma unroll
      for (int ks = 0; ks < 4; ++ks) aQ[1] = MFMA32(fA[ks], vf[ks], aQ[1]);
#pragma unroll
      for (int t = 0; t < 4; ++t) {
        const int cur = t & 1, nxt = cur ^ 1;
        if (t + 1 < 4) {
#pragma unroll
          for (int ks = 0; ks < 4; ++ks) fk[nxt][ks] = ldfrag(sKt, 32 * (t + 1) + r, 68, 16 * ks + 4 * hh);
        }
#pragma unroll
        for (int i = 0; i < 16; ++i) S[t][i] *= egl;
#pragma unroll
        for (int ks = 0; ks < 4; ++ks) S[t] = MFMA32(fk[cur][ks], vf[ks], S[t]);
      }
      {
        bf16_t* Ob = O + (size_t)b * SEQ * 512 + h * 128 + dv0 + r;
#pragma unroll
        for (int m = 0; m < 2; ++m)
#pragma unroll
          for (int i = 0; i < 16; ++i) {
            const int p = cc * 64 + 32 * m + crow(i, hh), l = dir ? (SEQ - 1 - p) : p;
            Ob[(size_t)l * 512] = f2bf(aQ[m][i]);
          }
      }
      lds_barrier();
    }
  }
}

DI void phase6(const Params& P, LAS unsigned char* lds, int ctr_off) {
  const int tid = threadIdx.x, lane = tid & 63, wid = tid >> 6, wr = wid >> 2, wc = wid & 3, fr = lane & 15, fq = lane >> 4;
  const bf16_t* MY = (const bf16_t*)(P.ws + OFF_MY); const bf16_t* U5 = (const bf16_t*)(P.ws + OFF_U5);
  bf16_t* Y5 = (bf16_t*)(P.ws + OFF_Y5);
  unsigned* ctr = (unsigned*)(P.ws + OFF_CTR) + ctr_off;
  LAS unsigned* sid = (LAS unsigned*)(lds + 131072);
  const int q0 = blockIdx.x & 7, pref = (blockIdx.x < 128 && gridDim.x > 128) ? 1 : 0;
  int step = 0;
  for (;;) {
    const int q = (q0 + (step >> 1)) & 7, part = pref ^ (step & 1), lim = part ? 16 : 48;
    __syncthreads();
    if (tid == 0) *sid = atomicAdd(ctr + part * 8 + q, 1u);
    __syncthreads();
    const int got = (int)*sid;
    if (got >= lim) { if (++step >= 16) break; continue; }
    const int idl = part ? 48 + got : got;
    const int g = q + 8 * (idl >> 4), tn = (idl >> 2) & 3, tm = idl & 3;
    f32x4 acc[2][2][4][2];
    gemm256<false>(MY + (size_t)(g * 1024 + tm * 256) * 1280, 1280, U5 + (size_t)(g * 1024 + tn * 256) * 1280, 1280, 1280, lds, acc);
#pragma unroll
    for (int ai = 0; ai < 2; ++ai)
#pragma unroll
      for (int bj = 0; bj < 2; ++bj)
#pragma unroll
        for (int m = 0; m < 4; ++m)
#pragma unroll
          for (int n = 0; n < 2; ++n) {
            const int row0 = tm * 256 + ai * 128 + wr * 64 + m * 16 + fq * 4, col = tn * 256 + bj * 128 + wc * 32 + n * 16 + fr;
            const int t = row0 >> 4, p = row0 & 15; const size_t tok = (size_t)col * 64 + t;
            const f32x4 v = acc[ai][bj][m][n];
            const u32x2 o = {pk2(gelu_tanh(v[0]), gelu_tanh(v[1])), pk2(gelu_tanh(v[2]), gelu_tanh(v[3]))};
            *(u32x2*)(Y5 + tok * 512 + g * 16 + p) = o;
          }
  }
}

DI void phase7(const Params& P, LAS unsigned char* lds) {
  const int tid = threadIdx.x, lane = tid & 63, wid = tid >> 6, wr = wid >> 2, wc = wid & 3, fr = lane & 15, fq = lane >> 4;
  const bf16_t* Y5 = (const bf16_t*)(P.ws + OFF_Y5); const bf16_t* GW = (const bf16_t*)(P.ws + OFF_GLUWT);
  const bf16_t* ZA = (const bf16_t*)(P.ws + OFF_ZA); const bf16_t* ZB = (const bf16_t*)(P.ws + OFF_ZB);
  bf16_t* YAB = (bf16_t*)(P.ws + OFF_YAB);
#pragma unroll 1
  for (int pass = 0; pass < 2; ++pass) {
  const bool gemm_now = (pass == 0) != (((blockIdx.x >> 3) & 1) != 0);
  if (gemm_now) {
  {
    const int bid = blockIdx.x, nbk = gridDim.x, nj = bid < 1024 ? (1024 - bid + nbk - 1) / nbk : 0;
    auto tile_of = [&](int j, int& tm, int& tn) { const int id = bid + j * nbk, grp = id >> 5, ig = id & 31; tm = grp * 8 + (ig & 7); tn = ig >> 3; };
    gemm256_stream<true, true>(nj, 8, 512, 512,
      [&](int j, const bf16_t*& A, const bf16_t*& Bt) { int tm, tn; tile_of(j, tm, tn); A = Y5 + (size_t)tm * 256 * 512; Bt = GW + (size_t)tn * 256 * 512; },
      [&](int j, f32x4 (&acc)[2][2][4][2]) {
        int tm, tn; tile_of(j, tm, tn);
        const int jc = tn * 128 + wc * 32 + fq * 8;
        f32x4 bv[2], bg[2];
#pragma unroll
        for (int n = 0; n < 2; ++n) { bv[n] = *(const f32x4*)(P.glu_b + jc + 4 * n); bg[n] = *(const f32x4*)(P.glu_b + 512 + jc + 4 * n); }
#pragma unroll
        for (int ai = 0; ai < 2; ++ai)
#pragma unroll
          for (int m = 0; m < 4; ++m) {
            const size_t t = (size_t)tm * 256 + ai * 128 + wr * 64 + m * 16 + fr;
            const u32x4 z = *(const u32x4*)(ZA + t * 512 + jc);
            float y[8];
#pragma unroll
            for (int n = 0; n < 2; ++n)
#pragma unroll
              for (int e = 0; e < 4; ++e) {
                const unsigned zz = z[2 * n + (e >> 1)]; const float zf = (e & 1) ? bfhi(zz) : bflo(zz);
                y[4 * n + e] = (acc[ai][0][m][n][e] + bv[n][e]) * sigmoidf_(acc[ai][1][m][n][e] + bg[n][e]) * siluf_(zf);
              }
            *(u32x4*)(YAB + t * 1024 + jc) = u32x4{pk2(y[0], y[1]), pk2(y[2], y[3]), pk2(y[4], y[5]), pk2(y[6], y[7])};
          }
      }, lds);
  }
  } else {
  const bf16_t* Of = (const bf16_t*)P.out; const bf16_t* Ob = Of + (size_t)NTOK * 512;
  float nw[8];
#pragma unroll
  for (int e = 0; e < 8; ++e) nw[e] = P.dn_norm_w[(lane & 15) * 8 + e];
  for (int t0 = (blockIdx.x * NWV + wid) * 4; t0 < NTOK; t0 += gridDim.x * NWV * 4) {
    u32x4 a[4], bq[4], z[4];
#pragma unroll
    for (int u = 0; u < 4; ++u) {
      const size_t off = (size_t)(t0 + u) * 512 + lane * 8;
      a[u] = *(const u32x4*)(Of + off); bq[u] = *(const u32x4*)(Ob + off); z[u] = *(const u32x4*)(ZB + off);
    }
#pragma unroll
    for (int u = 0; u < 4; ++u) {
      float o[8]; float ss = 0.f;
#pragma unroll
      for (int e = 0; e < 4; ++e) { o[2 * e] = bflo(a[u][e]) + bflo(bq[u][e]); o[2 * e + 1] = bfhi(a[u][e]) + bfhi(bq[u][e]); }
#pragma unroll
      for (int e = 0; e < 8; ++e) ss += o[e] * o[e];
#pragma unroll
      for (int sft = 1; sft < 16; sft <<= 1) ss += __shfl_xor(ss, sft);
      const float rs = rsqrtf(ss * (1.f / 128.f) + 1e-6f);
      float y[8];
#pragma unroll
      for (int e = 0; e < 4; ++e) { y[2 * e] = o[2 * e] * rs * nw[2 * e] * siluf_(bflo(z[u][e])); y[2 * e + 1] = o[2 * e + 1] * rs * nw[2 * e + 1] * siluf_(bfhi(z[u][e])); }
      *(u32x4*)(YAB + (size_t)(t0 + u) * 1024 + 512 + lane * 8) = u32x4{pk2(y[0], y[1]), pk2(y[2], y[3]), pk2(y[4], y[5]), pk2(y[6], y[7])};
    }
  }
  }
  }
}

DI void phase8_norm(const Params& P, const float* sss, int tm) {
  const int tid = threadIdx.x, lane = tid & 63, wid = tid >> 6;
  __syncthreads();
  for (int rr = 0; rr < 32; rr += 4) {
    f32x4 v[4][4];
#pragma unroll
    for (int u = 0; u < 4; ++u) {
      const f32x4* xr = (const f32x4*)(P.out + ((size_t)tm * 256 + wid * 32 + rr + u) * DM) + lane;
#pragma unroll
      for (int j = 0; j < 4; ++j) v[u][j] = xr[64 * j];
    }
#pragma unroll
    for (int u = 0; u < 4; ++u) {
      const int row = wid * 32 + rr + u;
      const f32x4 p4 = *(const f32x4*)(sss + row * 4);
      const float rstd = rsqrtf((p4[0] + p4[1] + p4[2] + p4[3]) * (1.f / DM) + 1e-6f);
      f32x4* xr = (f32x4*)(P.out + ((size_t)tm * 256 + row) * DM) + lane;
#pragma unroll
      for (int j = 0; j < 4; ++j) {
        const f32x4 fw = *(const f32x4*)(P.final_norm_w + lane * 4 + 256 * j);
        f32x4 o;
#pragma unroll
        for (int e = 0; e < 4; ++e) o[e] = v[u][j][e] * rstd * fw[e];
        xr[64 * j] = o;
      }
    }
  }
  __syncthreads();
}
DI void phase8(const Params& P, LAS unsigned char* lds) {
  const int tid = threadIdx.x, lane = tid & 63, wid = tid >> 6, wr = wid >> 2, wc = wid & 3, fr = lane & 15, fq = lane >> 4;
  const bf16_t* YAB = (const bf16_t*)(P.ws + OFF_YAB); const bf16_t* W = (const bf16_t*)(P.ws + OFF_WOUTT);
  const float* mod = (const float*)(P.ws + OFF_MOD);
  float* sss = (float*)((char*)lds + 131072 + 64);
  for (int id = blockIdx.x * 4; id < 1024; id = ((id & 3) == 3) ? id - 3 + gridDim.x * 4 : id + 1) {
    const int tm = id >> 2, tn = id & 3;
    if (tn == 0) { for (int e = tid; e < 1024; e += NTHR) sss[e] = 0.f; }
    {
      f32x4 acc[2][2][4][2];
      gemm256<true, true>(YAB + (size_t)tm * 256 * 1024, 1024, W + (size_t)tn * 256 * 1024, 1024, 1024, lds, acc);
      f32x4 gvv[2][2];
#pragma unroll
      for (int bj = 0; bj < 2; ++bj)
#pragma unroll
        for (int n = 0; n < 2; ++n) gvv[bj][n] = *(const f32x4*)(mod + ((tm * 256) >> 12) * 3072 + 2048 + tn * 256 + bj * 128 + wc * 32 + fq * 8 + 4 * n);
#pragma unroll
      for (int ai = 0; ai < 2; ++ai)
#pragma unroll
        for (int m = 0; m < 4; ++m) {
          const size_t t = (size_t)tm * 256 + ai * 128 + wr * 64 + m * 16 + fr;
          float ssv = 0.f;
#pragma unroll
          for (int bj = 0; bj < 2; ++bj)
#pragma unroll
            for (int n = 0; n < 2; ++n) {
              const int col = tn * 256 + bj * 128 + wc * 32 + fq * 8 + 4 * n;
              const f32x4 xv = *(const f32x4*)(P.x + t * DM + col), gv = gvv[bj][n];
              f32x4 o;
#pragma unroll
              for (int e = 0; e < 4; ++e) { o[e] = xv[e] + gv[e] * acc[ai][bj][m][n][e]; ssv += o[e] * o[e]; }
              *(f32x4*)(P.out + t * DM + col) = o;
            }
          ssv += __shfl_xor(ssv, 16); ssv += __shfl_xor(ssv, 32);
          if (fq == 0) sss[(ai * 128 + wr * 64 + m * 16 + fr) * 4 + wc] += ssv;
        }
    }
    if (tn == 3) phase8_norm(P, sss, tm);
  }
}
DI void phase9(const Params& P) {
  const int tid = threadIdx.x, lane = tid & 63, wid = tid >> 6;
  for (int row0 = (blockIdx.x * NWV + wid) * 4; row0 < NTOK; row0 += gridDim.x * NWV * 4) {
    f32x4 v[4][4];
#pragma unroll
    for (int u = 0; u < 4; ++u) {
      const f32x4* xr = (const f32x4*)(P.out + (size_t)(row0 + u) * DM) + lane;
#pragma unroll
      for (int j = 0; j < 4; ++j) v[u][j] = xr[64 * j];
    }
#pragma unroll
    for (int u = 0; u < 4; ++u) {
      f32x4* xr = (f32x4*)(P.out + (size_t)(row0 + u) * DM) + lane;
      float s = 0.f;
#pragma unroll
      for (int j = 0; j < 4; ++j) s += v[u][j][0] * v[u][j][0] + v[u][j][1] * v[u][j][1] + v[u][j][2] * v[u][j][2] + v[u][j][3] * v[u][j][3];
      const float rstd = rsqrtf(wave_sum(s) * (1.f / DM) + 1e-6f);
#pragma unroll
      for (int j = 0; j < 4; ++j) {
        const f32x4 fw = *(const f32x4*)(P.final_norm_w + lane * 4 + 256 * j);
        f32x4 o;
#pragma unroll
        for (int e = 0; e < 4; ++e) o[e] = v[u][j][e] * rstd * fw[e];
        xr[64 * j] = o;
      }
    }
  }
}

#ifndef SPLIT56
#define SPLIT56 0
#endif
DI void phase5(const Params& P, char* smem, LAS unsigned char* lds) {
  for (int seq = blockIdx.x; seq < 128; seq += gridDim.x) dn_recur(P, smem, seq);
  if (!SPLIT56) phase6(P, lds, 0);
}
constexpr int LDS_BYTES = 160 * 1024;
__global__ void __launch_bounds__(NTHR) hybrid_fwd(Params P) {
  extern __shared__ __attribute__((aligned(16))) unsigned char lds_raw[];
  LAS unsigned char* lds = (LAS unsigned char*)lds_raw;
  char* smem = (char*)lds_raw;
  cg::grid_group grid = cg::this_grid();
#define SEAM(p) if (P.p_lo < (p) && P.p_hi >= (p)) grid.sync()
#ifndef PH_MASK
#define PH_MASK 0x3ff
#endif
#define RUN(p, call) if (((PH_MASK >> (p)) & 1) && P.p_lo <= (p) && P.p_hi >= (p)) { const int nrep_ = (REP_PHASE == (p)) ? P.p_hi - 7 : 1; for (int rep_ = 0; rep_ < nrep_; ++rep_) { if (rep_) grid.sync(); call; } }
  RUN(0, phase0(P, smem));
  SEAM(1);
  RUN(1, phase1(P, smem));
  SEAM(2);
  RUN(2, phase2(P, lds));
  SEAM(3);
  RUN(3, phase3(P, lds));
  SEAM(4);
  RUN(4, phase4(P, smem));
  SEAM(5);
  RUN(5, phase5(P, smem, lds));
  if (SPLIT56) { SEAM(6); RUN(6, phase6(P, lds, 0)); }
  SEAM(7);
  RUN(7, phase7(P, lds));
  SEAM(8);
  RUN(8, phase8(P, lds));
}

extern "C" void kernel_launch(void* const* d_in, const int* in_sizes, int n_in, void* d_out, int out_size, void* d_ws, size_t ws_size, hipStream_t stream) {
  static int grid_blocks = 0;
  if (!grid_blocks) {
    int dev = 0, cus = 0, per_cu = 0;
    (void)hipGetDevice(&dev);
    (void)hipDeviceGetAttribute(&cus, hipDeviceAttributeMultiprocessorCount, dev);
    (void)hipFuncSetAttribute((const void*)hybrid_fwd, hipFuncAttributeMaxDynamicSharedMemorySize, LDS_BYTES);
    (void)hipOccupancyMaxActiveBlocksPerMultiprocessor(&per_cu, (const void*)hybrid_fwd, NTHR, LDS_BYTES);
    if (per_cu < 1) per_cu = 1;
    if (per_cu > 1) per_cu = 1;
    grid_blocks = cus * per_cu;
    if (ws_size < WS_END) fprintf(stderr, "workspace too small: %zu < %zu\n", ws_size, (size_t)WS_END);
  }
  Params p{};
  const float* const* in = (const float* const*)d_in;
  p.x = in[0]; p.c = in[1]; p.ada_w = in[2]; p.ada_b = in[3]; p.norm_w = in[4]; p.w_in = in[5]; p.conv_w = in[6];
  p.a_log[0] = in[7]; p.dt_bias[0] = in[8]; p.a_log[1] = in[9]; p.dt_bias[1] = in[10]; p.dn_norm_w = in[11];
  for (int d = 0; d < 2; ++d) {
    const int o = 12 + 7 * d;
    p.lam_re[d] = in[o]; p.lam_im[d] = in[o + 1]; p.log_step[d] = in[o + 2]; p.b_re[d] = in[o + 3]; p.b_im[d] = in[o + 4]; p.c_re[d] = in[o + 5]; p.c_im[d] = in[o + 6];
  }
  p.s5_d = in[26]; p.glu_w = in[27]; p.glu_b = in[28]; p.w_out = in[29]; p.final_norm_w = in[30];
  p.out = (float*)d_out; p.ws = (char*)d_ws;
#if N_LAUNCH_MODE == 1
  for (int ph = 0; ph <= 9; ++ph) {
    p.p_lo = ph; p.p_hi = ph;
    hipLaunchKernelGGL(hybrid_fwd, dim3(grid_blocks), dim3(NTHR), LDS_BYTES, stream, p);
  }
#else
  p.p_lo = 0; p.p_hi = 9;
  void* args[] = {&p};
  hipError_t e = hipLaunchCooperativeKernel((const void*)hybrid_fwd, dim3(grid_blocks), dim3(NTHR), args, LDS_BYTES, stream);
  if (e != hipSuccess) fprintf(stderr, "cooperative launch failed: %s (grid %d)\n", hipGetErrorString(e), grid_blocks);
#endif
}
```

```cpp
#include <hip/hip_runtime.h>
#include <hip/hip_cooperative_groups.h>
#include <cstdio>
#include <cstdint>
namespace cg = cooperative_groups;

#ifndef N_LAUNCH_MODE
#define N_LAUNCH_MODE 0
#endif
#ifndef REP_PHASE
#define REP_PHASE -1
#endif

#define DUPST 0
#ifndef DUPL
#define DUPL 0
#endif
#define DI __device__ __forceinline__
#define LAS __attribute__((address_space(3)))
constexpr int NTHR = 512, NWV = 8;
typedef unsigned short bf16_t;
typedef short bf16x8 __attribute__((ext_vector_type(8)));
typedef float f32x4 __attribute__((ext_vector_type(4)));
typedef float f32x2 __attribute__((ext_vector_type(2)));
typedef float f32x16 __attribute__((ext_vector_type(16)));
typedef unsigned u32x4 __attribute__((ext_vector_type(4)));
typedef unsigned u32x2 __attribute__((ext_vector_type(2)));
typedef __bf16 bf2_t __attribute__((ext_vector_type(2)));

constexpr int DM = 1024, NB = 16, SEQ = 4096, NTOK = NB * SEQ;
constexpr int INC = 3088, INP = 3328;
constexpr size_t MiB = 1u << 20;
constexpr size_t OFF_HB = 0;
constexpr size_t OFF_QKVRAW = 128 * MiB;
constexpr size_t OFF_WC = 0;
constexpr size_t OFF_UT = 128 * MiB;
constexpr size_t OFF_ATT = 256 * MiB;
constexpr size_t OFF_Y5 = 656 * MiB;
constexpr size_t OFF_U5 = 320 * MiB;
constexpr size_t OFF_ZA = 400 * MiB;
constexpr size_t OFF_ZB = 464 * MiB;
constexpr size_t OFF_QN = 528 * MiB;
constexpr size_t OFF_KN = 592 * MiB;
constexpr size_t OFF_VN = 656 * MiB;
constexpr size_t OFF_YAB = 528 * MiB;
constexpr size_t OFF_MY = 720 * MiB;
constexpr size_t OFF_MS = 800 * MiB;
constexpr size_t OFF_KTT = 816 * MiB;
constexpr size_t OFF_WINT = 944 * MiB;
constexpr size_t OFF_GLUWT = 952 * MiB;
constexpr size_t OFF_WOUTT = 953 * MiB;
constexpr size_t OFF_BA = 955 * MiB;
constexpr size_t OFF_GC = 959 * MiB;
constexpr size_t OFF_KTAB = 961 * MiB;
constexpr size_t OFF_PW = 965 * MiB;
constexpr size_t OFF_FB = 968 * MiB;
constexpr size_t OFF_MOD = 969 * MiB;
constexpr size_t OFF_CTR = 969 * MiB + 512 * 1024;
constexpr size_t WS_END = 970 * MiB;

struct Params {
  const float *x, *c, *ada_w, *ada_b, *norm_w, *w_in, *conv_w;
  const float *a_log[2], *dt_bias[2], *dn_norm_w;
  const float *lam_re[2], *lam_im[2], *log_step[2], *b_re[2], *b_im[2], *c_re[2], *c_im[2];
  const float *s5_d, *glu_w, *glu_b, *w_out, *final_norm_w;
  float* out;
  char* ws;
  int p_lo, p_hi;
};

DI unsigned pk2(float a, float b) { f32x2 v = {a, b}; bf2_t r = __builtin_convertvector(v, bf2_t); return __builtin_bit_cast(unsigned, r); }
DI bf16_t f2bf(float a) { return (bf16_t)(pk2(a, 0.f) & 0xffffu); }
DI float bf2f(bf16_t v) { return __uint_as_float(((unsigned)v) << 16); }
DI float bflo(unsigned u) { return __uint_as_float(u << 16); }
DI float bfhi(unsigned u) { return __uint_as_float(u & 0xffff0000u); }
DI float sigmoidf_(float x) { return 1.f / (1.f + __expf(-x)); }
DI float siluf_(float x) { return x / (1.f + __expf(-x)); }
DI float gelu_tanh(float x) { float u = 0.7978845608028654f * (x + 0.044715f * x * x * x); float e = __expf(2.f * u); float t = 1.f - 2.f / (e + 1.f); return 0.5f * x * (1.f + t); }
DI float softplusf_(float x) { return x > 15.f ? x : log1pf(expf(x)); }
DI float wave_sum(float v) {
#pragma unroll
  for (int o = 1; o < 64; o <<= 1) v += __shfl_xor(v, o);
  return v;
}
DI void lds_barrier() { asm volatile("s_waitcnt lgkmcnt(0)" ::: "memory"); __builtin_amdgcn_s_barrier(); asm volatile("" ::: "memory"); }
typedef unsigned long long u64_t;
DI u64_t ld8_pinned(const void* p) { return __hip_atomic_load((const u64_t*)p, __ATOMIC_RELAXED, __HIP_MEMORY_SCOPE_WORKGROUP); }
DI float ld4_pinned(const void* p) { return __builtin_bit_cast(float, __hip_atomic_load((const unsigned*)p, __ATOMIC_RELAXED, __HIP_MEMORY_SCOPE_WORKGROUP)); }
DI int crow(int reg, int h) { return (reg & 3) + 8 * (reg >> 2) + 4 * h; }
DI bf16x8 pack8(const f32x16& x, int s) {
  u32x4 p;
  p[0] = pk2(x[8 * s + 0], x[8 * s + 1]); p[1] = pk2(x[8 * s + 2], x[8 * s + 3]);
  p[2] = pk2(x[8 * s + 4], x[8 * s + 5]); p[3] = pk2(x[8 * s + 6], x[8 * s + 7]);
  return __builtin_bit_cast(bf16x8, p);
}
DI bf16x8 ldfrag(const bf16_t* base, int row, int stride, int col) {
  const bf16_t* p = base + row * stride + col;
  u32x2 lo = *(const u32x2*)p, hi = *(const u32x2*)(p + 8);
  u32x4 v = {lo[0], lo[1], hi[0], hi[1]};
  return __builtin_bit_cast(bf16x8, v);
}
#define MFMA32(a, b, c) __builtin_amdgcn_mfma_f32_32x32x16_bf16((a), (b), (c), 0, 0, 0)
#define MFMA16(a, b, c) __builtin_amdgcn_mfma_f32_16x16x32_bf16((a), (b), (c), 0, 0, 0)

constexpr int G_HTB = 128 * 64 * 2;
DI int lds_byte(int r, int c) { const int st = (r >> 4) * 2 + (c >> 5), rr = r & 15, cc = c & 31, ob = rr * 64 + cc * 2; return st * 1024 + (ob ^ (((ob >> 9) & 1) << 5)); }
DI void stage_rc(int b, int& R, int& C) { const int st = b / 1024, sb = b % 1024, swz = sb ^ (((sb >> 9) & 1) << 5); R = (st >> 1) * 16 + swz / 64; C = (st & 1) * 32 + (swz % 64) / 2; }
template <bool TRANS, bool PERM = false>
DI void gemm256(const bf16_t* __restrict__ A, int lda, const bf16_t* __restrict__ Bt, int ldb, int K, LAS unsigned char* lds, f32x4 (&acc)[2][2][4][2]) {
  const int tid = threadIdx.x, wid = __builtin_amdgcn_readfirstlane(tid >> 6), lane = tid & 63, wr = wid >> 2, wc = wid & 3, fr = lane & 15, fq = lane >> 4;
  unsigned voffA[2], voffB[2];
#pragma unroll
  for (int i = 0; i < 2; ++i) {
    int R, C; stage_rc(tid * 16 + i * 8192, R, C);
    const int Rb = PERM ? ((R & ~31) + 8 * ((R & 15) >> 2) + 4 * ((R >> 4) & 1) + (R & 3)) : R;
    voffA[i] = (unsigned)(R * lda + C) * 2u; voffB[i] = (unsigned)(Rb * ldb + C) * 2u;
  }
  const unsigned ldsw = (unsigned)wid * 1024u;
  const int aoff = lds_byte(wr * 64 + fr, fq * 8), boff = lds_byte(wc * 32 + fr, fq * 8);
  const char* cA0 = (const char*)A; const char* cA1 = cA0 + (size_t)128 * lda * 2;
  const char* cB0 = (const char*)Bt; const char* cB1 = cB0 + (size_t)128 * ldb * 2;
#define G_SA(b, h) (((b) * 2 + (h)) * G_HTB)
#define G_SB(b, h) ((4 + (b) * 2 + (h)) * G_HTB)
#define G_STAGE(bufoff, gbase, voff, kt) do { _Pragma("unroll") for (int _i = 0; _i < 2; ++_i) \
    __builtin_amdgcn_global_load_lds((const unsigned*)((gbase) + (size_t)(kt) * 128 + (voff)[_i]), (LAS unsigned*)(lds + (bufoff) + ldsw + _i * 8192), 16, 0, 0); } while (0)
#define G_LDA(dst, b, h) do { _Pragma("unroll") for (int m = 0; m < 4; ++m) _Pragma("unroll") for (int k = 0; k < 2; ++k) dst[m][k] = *(const LAS bf16x8*)(lds + G_SA(b, h) + aoff + m * 2048 + k * 1024); } while (0)
#define G_LDB(dst, b, h) do { _Pragma("unroll") for (int n = 0; n < 2; ++n) _Pragma("unroll") for (int k = 0; k < 2; ++k) dst[n][k] = *(const LAS bf16x8*)(lds + G_SB(b, h) + boff + n * 2048 + k * 1024); } while (0)
#define G_MMA(ai, bj, At_, Bt_) do { __builtin_amdgcn_s_setprio(1); _Pragma("unroll") for (int m = 0; m < 4; ++m) _Pragma("unroll") for (int n = 0; n < 2; ++n) _Pragma("unroll") for (int k = 0; k < 2; ++k) \
    acc[ai][bj][m][n] = TRANS ? MFMA16(Bt_[n][k], At_[m][k], acc[ai][bj][m][n]) : MFMA16(At_[m][k], Bt_[n][k], acc[ai][bj][m][n]); __builtin_amdgcn_s_setprio(0); } while (0)
#define G_WAIT_V(n) asm volatile("s_waitcnt vmcnt(" #n ")" ::: "memory")
#define G_WAIT_L(n) asm volatile("s_waitcnt lgkmcnt(" #n ")" ::: "memory")
#define G_BAR __builtin_amdgcn_s_barrier()
#define G_SCHED __builtin_amdgcn_sched_barrier(0)
#pragma unroll
  for (int a = 0; a < 2; ++a)
#pragma unroll
    for (int b = 0; b < 2; ++b)
#pragma unroll
      for (int m = 0; m < 4; ++m)
#pragma unroll
        for (int n = 0; n < 2; ++n) acc[a][b][m][n] = f32x4{0.f, 0.f, 0.f, 0.f};
  bf16x8 At[4][2], B0[2][2], B1[2][2];
  const int nt = K / 64;
  G_WAIT_V(0); G_WAIT_L(0); G_BAR;
  G_STAGE(G_SB(0, 0), cB0, voffB, 0); G_STAGE(G_SA(0, 0), cA0, voffA, 0);
  G_STAGE(G_SB(0, 1), cB1, voffB, 0); G_STAGE(G_SA(0, 1), cA1, voffA, 0);
  if (wr == 1) G_BAR;
  G_WAIT_V(4); G_BAR;
  G_STAGE(G_SB(1, 0), cB0, voffB, 1); G_STAGE(G_SA(1, 0), cA0, voffA, 1); G_STAGE(G_SB(1, 1), cB1, voffB, 1);
  G_WAIT_V(6); G_BAR;
  for (int t = 0; t < nt - 2; t += 2) {
    G_LDB(B0, 0, 0); G_SCHED; G_LDA(At, 0, 0); G_STAGE(G_SA(1, 1), cA1, voffA, t + 1);
    G_WAIT_L(8); G_BAR; G_WAIT_L(0); G_MMA(0, 0, At, B0); G_BAR; G_SCHED;
    G_LDB(B1, 0, 1); G_STAGE(G_SB(0, 0), cB0, voffB, t + 2);
    G_BAR; G_WAIT_L(0); G_MMA(0, 1, At, B1); G_BAR;
    G_LDA(At, 0, 1); G_STAGE(G_SA(0, 0), cA0, voffA, t + 2);
    G_BAR; G_WAIT_L(0); G_MMA(1, 0, At, B0); G_BAR; G_SCHED;
    G_STAGE(G_SB(0, 1), cB1, voffB, t + 2);
    G_WAIT_V(6); G_BAR; G_MMA(1, 1, At, B1); G_BAR;
    G_LDB(B0, 1, 0); G_SCHED; G_LDA(At, 1, 0); G_STAGE(G_SA(0, 1), cA1, voffA, t + 2);
    G_WAIT_L(8); G_BAR; G_WAIT_L(0); G_MMA(0, 0, At, B0); G_BAR; G_SCHED;
    G_LDB(B1, 1, 1); G_STAGE(G_SB(1, 0), cB0, voffB, t + 3);
    G_BAR; G_WAIT_L(0); G_MMA(0, 1, At, B1); G_BAR;
    G_LDA(At, 1, 1); G_STAGE(G_SA(1, 0), cA0, voffA, t + 3);
    G_BAR; G_WAIT_L(0); G_MMA(1, 0, At, B0); G_BAR; G_SCHED;
    G_STAGE(G_SB(1, 1), cB1, voffB, t + 3);
    G_WAIT_V(6); G_BAR; G_MMA(1, 1, At, B1); G_BAR;
  }
  { G_LDB(B0, 0, 0); G_LDA(At, 0, 0); G_STAGE(G_SA(1, 1), cA1, voffA, nt - 1);
    G_BAR; G_WAIT_L(0); G_MMA(0, 0, At, B0); G_BAR;
    G_LDB(B1, 0, 1); G_BAR; G_WAIT_L(0); G_MMA(0, 1, At, B1); G_BAR;
    G_LDA(At, 0, 1); G_WAIT_V(4); G_BAR; G_WAIT_L(0); G_MMA(1, 0, At, B0); G_MMA(1, 1, At, B1); G_BAR; }
  { G_LDB(B0, 1, 0); G_LDA(At, 1, 0); G_WAIT_V(2); G_BAR; G_WAIT_L(0); G_MMA(0, 0, At, B0); G_BAR;
    G_LDB(B1, 1, 1); G_WAIT_V(0); G_BAR; G_WAIT_L(0); G_MMA(0, 1, At, B1); G_BAR;
    G_LDA(At, 1, 1); G_BAR; G_WAIT_L(0); G_MMA(1, 0, At, B0); G_MMA(1, 1, At, B1); G_BAR; }
  if (wr == 0) G_BAR;
}

template <bool TRANS, bool PERM, class TileFn, class EpiFn>
DI void gemm256_stream(int nj, int nt, int lda, int ldb, TileFn tilefn, EpiFn epifn, LAS unsigned char* lds) {
  if (nj <= 0) return;
  const int tid = threadIdx.x, wid = __builtin_amdgcn_readfirstlane(tid >> 6), lane = tid & 63, wr = wid >> 2, wc = wid & 3, fr = lane & 15, fq = lane >> 4;
  unsigned voffA[2], voffB[2];
#pragma unroll
  for (int i = 0; i < 2; ++i) {
    int R, C; stage_rc(tid * 16 + i * 8192, R, C);
    const int Rb = PERM ? ((R & ~31) + 8 * ((R & 15) >> 2) + 4 * ((R >> 4) & 1) + (R & 3)) : R;
    voffA[i] = (unsigned)(R * lda + C) * 2u; voffB[i] = (unsigned)(Rb * ldb + C) * 2u;
  }
  const unsigned ldsw = (unsigned)wid * 1024u;
  const int aoff = lds_byte(wr * 64 + fr, fq * 8), boff = lds_byte(wc * 32 + fr, fq * 8);
  const size_t hA = (size_t)128 * lda * 2, hB = (size_t)128 * ldb * 2;
  const char *cA, *cB, *nA, *nB;
  { const bf16_t *a, *b; tilefn(0, a, b); cA = (const char*)a; cB = (const char*)b; nA = cA; nB = cB; if (nj > 1) { tilefn(1, a, b); nA = (const char*)a; nB = (const char*)b; } }
  int j = 0, tbeg = 0, tend = nt;
#define GS_A(g, h) (((g) < tend ? cA + (size_t)((g) - tbeg) * 128 : nA + (size_t)((g) - tend) * 128) + (h) * hA)
#define GS_B(g, h) (((g) < tend ? cB + (size_t)((g) - tbeg) * 128 : nB + (size_t)((g) - tend) * 128) + (h) * hB)
#define GS_STAGE(bufoff, gptr, voff) do { const char* _p = (gptr); _Pragma("unroll") for (int _i = 0; _i < 2; ++_i) \
    __builtin_amdgcn_global_load_lds((const unsigned*)(_p + (voff)[_i]), (LAS unsigned*)(lds + (bufoff) + ldsw + _i * 8192), 16, 0, 0); } while (0)
  f32x4 acc[2][2][4][2];
#pragma unroll
  for (int a = 0; a < 2; ++a)
#pragma unroll
    for (int b = 0; b < 2; ++b)
#pragma unroll
      for (int m = 0; m < 4; ++m)
#pragma unroll
        for (int n = 0; n < 2; ++n) acc[a][b][m][n] = f32x4{0.f, 0.f, 0.f, 0.f};
  bf16x8 At[4][2], B0[2][2], B1[2][2];
  const int total = nj * nt;
  G_WAIT_V(0); G_WAIT_L(0); G_BAR;
  GS_STAGE(G_SB(0, 0), GS_B(0, 0), voffB); GS_STAGE(G_SA(0, 0), GS_A(0, 0), voffA);
  GS_STAGE(G_SB(0, 1), GS_B(0, 1), voffB); GS_STAGE(G_SA(0, 1), GS_A(0, 1), voffA);
  if (wr == 1) G_BAR;
  G_WAIT_V(4); G_BAR;
  GS_STAGE(G_SB(1, 0), GS_B(1, 0), voffB); GS_STAGE(G_SA(1, 0), GS_A(1, 0), voffA); GS_STAGE(G_SB(1, 1), GS_B(1, 1), voffB);
  G_WAIT_V(6); G_BAR;
  for (int t = 0; t < total - 2; t += 2) {
    G_LDB(B0, 0, 0); G_SCHED; G_LDA(At, 0, 0); GS_STAGE(G_SA(1, 1), GS_A(t + 1, 1), voffA);
    G_WAIT_L(8); G_BAR; G_WAIT_L(0); G_MMA(0, 0, At, B0); G_BAR; G_SCHED;
    G_LDB(B1, 0, 1); GS_STAGE(G_SB(0, 0), GS_B(t + 2, 0), voffB);
    G_BAR; G_WAIT_L(0); G_MMA(0, 1, At, B1); G_BAR;
    G_LDA(At, 0, 1); GS_STAGE(G_SA(0, 0), GS_A(t + 2, 0), voffA);
    G_BAR; G_WAIT_L(0); G_MMA(1, 0, At, B0); G_BAR; G_SCHED;
    GS_STAGE(G_SB(0, 1), GS_B(t + 2, 1), voffB);
    G_WAIT_V(6); G_BAR; G_MMA(1, 1, At, B1); G_BAR;
    G_LDB(B0, 1, 0); G_SCHED; G_LDA(At, 1, 0); GS_STAGE(G_SA(0, 1), GS_A(t + 2, 1), voffA);
    G_WAIT_L(8); G_BAR; G_WAIT_L(0); G_MMA(0, 0, At, B0); G_BAR; G_SCHED;
    G_LDB(B1, 1, 1); GS_STAGE(G_SB(1, 0), GS_B(t + 3, 0), voffB);
    G_BAR; G_WAIT_L(0); G_MMA(0, 1, At, B1); G_BAR;
    G_LDA(At, 1, 1); GS_STAGE(G_SA(1, 0), GS_A(t + 3, 0), voffA);
    G_BAR; G_WAIT_L(0); G_MMA(1, 0, At, B0); G_BAR; G_SCHED;
    GS_STAGE(G_SB(1, 1), GS_B(t + 3, 1), voffB);
    G_WAIT_V(6); G_BAR; G_MMA(1, 1, At, B1); G_BAR;
    if (t + 2 == tend) {
      epifn(j, acc);
#pragma unroll
      for (int a = 0; a < 2; ++a)
#pragma unroll
        for (int b = 0; b < 2; ++b)
#pragma unroll
          for (int m = 0; m < 4; ++m)
#pragma unroll
            for (int n = 0; n < 2; ++n) acc[a][b][m][n] = f32x4{0.f, 0.f, 0.f, 0.f};
      ++j; tbeg = tend; tend += nt; cA = nA; cB = nB;
      if (j + 1 < nj) { const bf16_t *a, *b; tilefn(j + 1, a, b); nA = (const char*)a; nB = (const char*)b; }
    }
  }
  { G_LDB(B0, 0, 0); G_LDA(At, 0, 0); GS_STAGE(G_SA(1, 1), GS_A(total - 1, 1), voffA);
    G_BAR; G_WAIT_L(0); G_MMA(0, 0, At, B0); G_BAR;
    G_LDB(B1, 0, 1); G_BAR; G_WAIT_L(0); G_MMA(0, 1, At, B1); G_BAR;
    G_LDA(At, 0, 1); G_WAIT_V(4); G_BAR; G_WAIT_L(0); G_MMA(1, 0, At, B0); G_MMA(1, 1, At, B1); G_BAR; }
  { G_LDB(B0, 1, 0); G_LDA(At, 1, 0); G_WAIT_V(2); G_BAR; G_WAIT_L(0); G_MMA(0, 0, At, B0); G_BAR;
    G_LDB(B1, 1, 1); G_WAIT_V(0); G_BAR; G_WAIT_L(0); G_MMA(0, 1, At, B1); G_BAR;
    G_LDA(At, 1, 1); G_BAR; G_WAIT_L(0); G_MMA(1, 0, At, B0); G_MMA(1, 1, At, B1); G_BAR; }
  if (wr == 0) G_BAR;
  epifn(j, acc);
}

DI void p0_mod_item(const Params& P, char* smem, int it) {
  float* ssil = (float*)smem;
  float* sred = ssil + 16 * 1024;
  const int tid = threadIdx.x, cl = tid & 31, ks = tid >> 5, col = it * 32 + cl;
  __syncthreads();
  for (int e = tid; e < 16 * 1024; e += NTHR) ssil[e] = siluf_(P.c[e]);
  __syncthreads();
  float acc[16];
#pragma unroll
  for (int b = 0; b < 16; ++b) acc[b] = 0.f;
#pragma unroll 1
  for (int k0 = ks * 64; k0 < ks * 64 + 64; k0 += 16) {
    float w[16];
#pragma unroll
    for (int u = 0; u < 16; ++u) w[u] = P.ada_w[(size_t)(k0 + u) * 3072 + col];
#pragma unroll
    for (int u = 0; u < 16; ++u)
#pragma unroll
      for (int b = 0; b < 16; ++b) acc[b] += ssil[b * 1024 + k0 + u] * w[u];
  }
#pragma unroll
  for (int b = 0; b < 16; ++b) sred[(ks * 16 + b) * 32 + cl] = acc[b];
  __syncthreads();
  {
    const int b = tid >> 5;
    float s = P.ada_b[col];
#pragma unroll
    for (int k2 = 0; k2 < 16; ++k2) s += sred[(k2 * 16 + b) * 32 + cl];
    ((float*)(P.ws + OFF_MOD))[b * 3072 + col] = s;
  }
}
DI void p0_transpose_item(const float* __restrict__ src, int N, int K, int k0, int srcn0, int nvalid, bf16_t* __restrict__ dst, int dstn0, float* s, int tid) {
  const int n = tid & 31, kr = tid >> 5;
#pragma unroll
  for (int i = 0; i < 8; ++i) { const int k = kr + 8 * i; s[k * 33 + n] = (n < nvalid) ? src[(size_t)(k0 + k) * N + srcn0 + n] : 0.f; }
  __syncthreads();
  const int on = tid >> 3, kc = tid & 7;
  u32x4 o;
  o[0] = pk2(s[(kc * 8 + 0) * 33 + on], s[(kc * 8 + 1) * 33 + on]); o[1] = pk2(s[(kc * 8 + 2) * 33 + on], s[(kc * 8 + 3) * 33 + on]);
  o[2] = pk2(s[(kc * 8 + 4) * 33 + on], s[(kc * 8 + 5) * 33 + on]); o[3] = pk2(s[(kc * 8 + 6) * 33 + on], s[(kc * 8 + 7) * 33 + on]);
  *(u32x4*)(dst + (size_t)(dstn0 + on) * K + k0 + kc * 8) = o;
  __syncthreads();
}
DI void s5_lambda(const Params& P, int g, int dir, int n, float& dt, float& lr, float& li) {
  dt = expf(P.log_step[dir][g]); lr = P.lam_re[dir][g * 64 + n]; li = P.lam_im[dir][g * 64 + n];
}
DI void cpow(float dt, float lr, float li, float e, float& re, float& im) {
  const float mag = __expf(lr * dt * e), x = li * dt * e;
  const float n = rintf(x * 0.15915494309189535f);
  const float y = fmaf(n, -6.2831854820251465f, x) + n * 1.7484556000744883e-7f;
  re = mag * __cosf(y); im = mag * __sinf(y);
}
DI void s5_f(float dt, float lr, float li, float& fre, float& fim) {
  float ar, ai; cpow(dt, lr, li, 1.f, ar, ai);
  const float nr = ar - 1.f, ni = ai, den = lr * lr + li * li;
  fre = (nr * lr + ni * li) / den; fim = (ni * lr - nr * li) / den;
}
DI void p0_ktab_item(const Params& P, float* sm, int it, int tid) {
  const int tb = it & 7, dir = (it >> 3) & 1, g = it >> 4;
  float* sw = sm;
  float* sG = sw + 1024;
  float* sC = sG + 2048;
  for (int e = tid; e < 512; e += 256) {
    const int n = e & 63, tau = tb * 8 + (e >> 6);
    float dt, lr, li; s5_lambda(P, g, dir, n, dt, lr, li);
    float fr_, fi_, ar, ai; s5_f(dt, lr, li, fr_, fi_); cpow(dt, lr, li, (float)tau, ar, ai);
    sw[e * 2] = fr_ * ar - fi_ * ai; sw[e * 2 + 1] = fr_ * ai + fi_ * ar;
  }
  for (int e = tid; e < 1024; e += 256) { sC[e * 2] = P.c_re[dir][g * 1024 + e]; sC[e * 2 + 1] = P.c_im[dir][g * 1024 + e]; }
  float br[4], bi[4];
#pragma unroll
  for (int k = 0; k < 4; ++k) { const int e = tid + 256 * k; br[k] = P.b_re[dir][g * 1024 + e]; bi[k] = P.b_im[dir][g * 1024 + e]; }
  const int p = tid >> 4, q = tid & 15;
  for (int t8 = 0; t8 < 8; ++t8) {
    __syncthreads();
#pragma unroll
    for (int k = 0; k < 4; ++k) {
      const int e = tid + 256 * k, n = e >> 4;
      const float wr_ = sw[(t8 * 64 + n) * 2], wi_ = sw[(t8 * 64 + n) * 2 + 1];
      sG[e * 2] = wr_ * br[k] - wi_ * bi[k]; sG[e * 2 + 1] = wr_ * bi[k] + wi_ * br[k];
    }
    __syncthreads();
    float acc = 0.f;
#pragma unroll 8
    for (int n = 0; n < 64; ++n) acc += sC[(p * 64 + n) * 2] * sG[(n * 16 + q) * 2] - sC[(p * 64 + n) * 2 + 1] * sG[(n * 16 + q) * 2 + 1];
    ((float*)(P.ws + OFF_KTAB))[((size_t)(g * 2 + dir) * 64 + tb * 8 + t8) * 256 + tid] = acc;
  }
  __syncthreads();
}
DI void phase0(const Params& P, char* smem) {
  const int bid = blockIdx.x, nb = gridDim.x, tid = threadIdx.x, hb = tid >> 8, t2 = tid & 255;
  {
    f32x2* PW = (f32x2*)(P.ws + OFF_PW); f32x2* FB = (f32x2*)(P.ws + OFF_FB);
    const int total = 32 * 2 * 65 * 64;
    for (int e = bid * NTHR + tid; e < total; e += nb * NTHR) {
      const int n = e & 63, ex = (e >> 6) % 65, gd = (e >> 6) / 65, dir = gd & 1, g = gd >> 1;
      float dt, lr, li; s5_lambda(P, g, dir, n, dt, lr, li);
      float re, im; cpow(dt, lr, li, (float)ex, re, im);
      PW[e] = f32x2{re, im};
      if (ex == 0) { float fr_, fi_; s5_f(dt, lr, li, fr_, fi_); FB[gd * 64 + n] = f32x2{fr_, fi_}; }
    }
  }
  if (bid == 0 && tid < 16) ((unsigned*)(P.ws + OFF_CTR))[tid] = 0u;
  for (int it = bid; it < 96; it += nb) p0_mod_item(P, smem, it);
}
DI void p1_compute(const Params& P, char* smem) {
  const int bid = blockIdx.x, nb = gridDim.x, tid = threadIdx.x, hb = tid >> 8, t2 = tid & 255;
  __syncthreads();
  constexpr int I1 = 1664, I2 = 256, I3 = 512;
  float* str = (float*)smem + hb * (64 * 33);
  for (int it = bid * 2 + hb; it < I1 + I2 + I3; it += nb * 2) {
    int r = it;
    if (r < I1) {
      const int kb = r / 104, nt = r % 104, n0 = nt * 32; int nvalid = INC - n0; nvalid = nvalid < 0 ? 0 : (nvalid > 32 ? 32 : nvalid);
      p0_transpose_item(P.w_in, INC, DM, kb * 64, n0, nvalid, (bf16_t*)(P.ws + OFF_WINT), n0, str, t2); continue;
    } r -= I1;
    if (r < I2) {
      const int kb = r / 32, nt = r % 32, n0 = nt * 32, t = n0 >> 8, i = n0 & 255;
      const int src0 = (i < 128) ? t * 128 + i : 512 + t * 128 + (i - 128);
      p0_transpose_item(P.glu_w, 1024, 512, kb * 64, src0, 32, (bf16_t*)(P.ws + OFF_GLUWT), n0, str, t2); continue;
    } r -= I2;
    { const int kb = r / 32, nt = r % 32; p0_transpose_item(P.w_out, 1024, 1024, kb * 64, nt * 32, 32, (bf16_t*)(P.ws + OFF_WOUTT), nt * 32, str, t2); }
  }
  __syncthreads();
  float* skt = (float*)smem + hb * 5120;
  for (int it = bid * 2 + hb; it < 512; it += nb * 2) p0_ktab_item(P, skt, it, t2);
}
DI void phase1(const Params& P, char* smem) {
  const int bid = blockIdx.x, nb = gridDim.x, tid = threadIdx.x, lane = tid & 63, wid = tid >> 6;
  const float* mod = (const float*)(P.ws + OFF_MOD);
  bf16_t* hB = (bf16_t*)(P.ws + OFF_HB);
#pragma unroll 1
  for (int pass = 0; pass < 2; ++pass) {
  const bool rows_now = (pass == 0) != (((blockIdx.x >> 3) & 1) != 0);
  if (rows_now) {
  for (int row0 = (bid * NWV + wid) * 4; row0 < NTOK; row0 += nb * NWV * 4) {
    f32x4 v[4][4];
#pragma unroll
    for (int u = 0; u < 4; ++u) {
      const f32x4* xr = (const f32x4*)(P.x + (size_t)(row0 + u) * DM) + lane;
#pragma unroll
      for (int j = 0; j < 4; ++j) v[u][j] = xr[64 * j];
    }
#pragma unroll
    for (int u = 0; u < 4; ++u) {
      const int row = row0 + u, b = row >> 12;
      float s = 0.f;
#pragma unroll
      for (int j = 0; j < 4; ++j) s += v[u][j][0] * v[u][j][0] + v[u][j][1] * v[u][j][1] + v[u][j][2] * v[u][j][2] + v[u][j][3] * v[u][j][3];
      const float rstd = rsqrtf(wave_sum(s) * (1.f / DM) + 1e-6f);
#pragma unroll
      for (int j = 0; j < 4; ++j) {
        const int col = lane * 4 + 256 * j;
        const f32x4 nw = *(const f32x4*)(P.norm_w + col), sh = *(const f32x4*)(mod + b * 3072 + col), sc = *(const f32x4*)(mod + b * 3072 + 1024 + col);
        float h[4];
#pragma unroll
        for (int e = 0; e < 4; ++e) h[e] = v[u][j][e] * rstd * nw[e] * (1.f + sc[e]) + sh[e];
        u32x2 o = {pk2(h[0], h[1]), pk2(h[2], h[3])};
        *(u32x2*)(hB + (size_t)row * DM + col) = o;
      }
    }
  }
  } else {
  p1_compute(P, smem);
  __syncthreads();
  const float* KT = (const float*)(P.ws + OFF_KTAB);
  const f32x2* PW = (const f32x2*)(P.ws + OFF_PW); const f32x2* FB = (const f32x2*)(P.ws + OFF_FB);
  bf16_t* MY = (bf16_t*)(P.ws + OFF_MY); bf16_t* MS = (bf16_t*)(P.ws + OFF_MS);
  const int totalS = 32 * 256 * 128;
  for (int e = bid * NTHR + tid; e < totalS; e += nb * NTHR) {
    const int kc = e & 127, row = (e >> 7) & 255, g = e >> 15, dir = row >> 7, part = (row >> 6) & 1, n = row & 63;
    const int s = kc >> 1, q0 = (kc & 1) * 8, ex = dir == 0 ? 63 - s : s;
    const f32x2 a = PW[((g * 2 + dir) * 65 + ex) * 64 + n], f = FB[(g * 2 + dir) * 64 + n];
    const float wr_ = a[0] * f[0] - a[1] * f[1], wi_ = a[0] * f[1] + a[1] * f[0];
    float o[8];
#pragma unroll
    for (int j = 0; j < 8; ++j) {
      const float br = P.b_re[dir][(g * 64 + n) * 16 + q0 + j], bi = P.b_im[dir][(g * 64 + n) * 16 + q0 + j];
      o[j] = part == 0 ? (wr_ * br - wi_ * bi) : (wr_ * bi + wi_ * br);
    }
    u32x4 ov = {pk2(o[0], o[1]), pk2(o[2], o[3]), pk2(o[4], o[5]), pk2(o[6], o[7])};
    *(u32x4*)(MS + ((size_t)(g * 256 + row) * 1024 + kc * 8)) = ov;
  }
  }
  }
}
DI void p3_mygen(const Params& P) {
  const int bid = blockIdx.x, nb = gridDim.x, tid = threadIdx.x;
  const float* KT = (const float*)(P.ws + OFF_KTAB);
  const f32x2* PW = (const f32x2*)(P.ws + OFF_PW); const f32x2* FB = (const f32x2*)(P.ws + OFF_FB);
  bf16_t* MY = (bf16_t*)(P.ws + OFF_MY); bf16_t* MS = (bf16_t*)(P.ws + OFF_MS);
  const int totalY = 32 * 1024 * 160;
  const bool split = (nb == 256); const int ecut = 1572864;
  const int e0 = split ? (bid < 128 ? 0 : ecut) : 0, e1 = split ? (bid < 128 ? ecut : totalY) : totalY;
  const int estep = split ? 128 * NTHR : nb * NTHR, ebase = split ? (bid & 127) * NTHR : bid * NTHR;
  for (int e = e0 + ebase + tid; e < e1; e += estep) {
    const int kc = e % 160, row = (e / 160) & 1023, g = e / (160 * 1024), t = row >> 4, p = row & 15;
    float o[8];
    if (kc < 128) {
      const int s = kc >> 1, q0 = (kc & 1) * 8;
      if (t == s) {
        const float* k0 = KT + ((size_t)((g * 2 + 0) * 64 + 0) * 256 + p * 16 + q0); const float* k1 = KT + ((size_t)((g * 2 + 1) * 64 + 0) * 256 + p * 16 + q0);
#pragma unroll
        for (int j = 0; j < 8; ++j) o[j] = k0[j] + k1[j] + ((q0 + j == p) ? P.s5_d[g * 16 + p] : 0.f);
      } else {
        const int dir = t > s ? 0 : 1, tau = t > s ? t - s : s - t;
        const float* k0 = KT + ((size_t)((g * 2 + dir) * 64 + tau) * 256 + p * 16 + q0);
#pragma unroll
        for (int j = 0; j < 8; ++j) o[j] = k0[j];
      }
    } else {
      const int c2 = (kc - 128) * 8, dir = c2 >> 7, part = (c2 >> 6) & 1, n0 = c2 & 63;
      const int ex = dir == 0 ? t + 1 : 64 - t;
#pragma unroll
      for (int j = 0; j < 8; ++j) {
        const int n = n0 + j; const f32x2 a = PW[((g * 2 + dir) * 65 + ex) * 64 + n];
        const float cr = P.c_re[dir][(g * 16 + p) * 64 + n], ci = P.c_im[dir][(g * 16 + p) * 64 + n];
        o[j] = part == 0 ? (cr * a[0] - ci * a[1]) : -(cr * a[1] + ci * a[0]);
      }
    }
    u32x4 ov = {pk2(o[0], o[1]), pk2(o[2], o[3]), pk2(o[4], o[5]), pk2(o[6], o[7])};
    *(u32x4*)(MY + ((size_t)(g * 1024 + row) * 1280 + kc * 8)) = ov;
  }
}
DI void phase2(const Params& P, LAS unsigned char* lds) {
  const int tid = threadIdx.x, lane = tid & 63, wid = tid >> 6, wr = wid >> 2, wc = wid & 3, fr = lane & 15, fq = lane >> 4;
  const bf16_t* hB = (const bf16_t*)(P.ws + OFF_HB); const bf16_t* W = (const bf16_t*)(P.ws + OFF_WINT);
  bf16_t* U5 = (bf16_t*)(P.ws + OFF_U5); bf16_t* ZA = (bf16_t*)(P.ws + OFF_ZA); bf16_t* ZB = (bf16_t*)(P.ws + OFF_ZB);
  bf16_t* QKV = (bf16_t*)(P.ws + OFF_QKVRAW); float* BA = (float*)(P.ws + OFF_BA);
  constexpr int NT = 13, NTILES = 256 * NT;
  const int bid = blockIdx.x, nbk = gridDim.x, nj = bid < NTILES ? (NTILES - bid + nbk - 1) / nbk : 0;
  auto tile_of = [&](int j, int& tm, int& tn) { const int id = bid + j * nbk, grp = id / (8 * NT), ig = id % (8 * NT); tm = grp * 8 + (ig & 7); tn = ig >> 3; };
  gemm256_stream<true, true>(nj, DM / 64, DM, DM,
    [&](int j, const bf16_t*& A, const bf16_t*& Bt) { int tm, tn; tile_of(j, tm, tn); A = hB + (size_t)tm * 256 * DM; Bt = W + (size_t)tn * 256 * DM; },
    [&](int j, f32x4 (&acc)[2][2][4][2]) {
      int tm, tn; tile_of(j, tm, tn);
#pragma unroll
      for (int ai = 0; ai < 2; ++ai)
#pragma unroll
        for (int m = 0; m < 4; ++m) {
          const int t = tm * 256 + ai * 128 + wr * 64 + m * 16 + fr;
#pragma unroll
          for (int bj = 0; bj < 2; ++bj) {
            const int col = tn * 256 + bj * 128 + wc * 32 + fq * 8;
            const f32x4 v0 = acc[ai][bj][m][0], v1 = acc[ai][bj][m][1];
            if (tn == 12) { if (col < INC) { *(f32x4*)(BA + (size_t)t * 16 + (col - 3072)) = v0; *(f32x4*)(BA + (size_t)t * 16 + (col - 3072) + 4) = v1; } continue; }
            const u32x4 o = {pk2(v0[0], v0[1]), pk2(v0[2], v0[3]), pk2(v1[0], v1[1]), pk2(v1[2], v1[3])};
            if (tn < 2) { const int g = col >> 4, q = col & 15; *(u32x4*)(U5 + ((size_t)(g * 1024 + (t >> 6)) * 1280 + (t & 63) * 16 + q)) = o; }
            else if (tn < 4) *(u32x4*)(ZA + (size_t)t * 512 + (col - 512)) = o;
            else if (tn < 10) *(u32x4*)(QKV + (size_t)t * 1536 + (col - 1024)) = o;
            else *(u32x4*)(ZB + (size_t)t * 512 + (col - 2560)) = o;
          }
        }
    }, lds);
}

DI void phase3(const Params& P, LAS unsigned char* lds) {
  const int tid = threadIdx.x, lane = tid & 63, wid = tid >> 6, wr = wid >> 2, wc = wid & 3, fr = lane & 15, fq = lane >> 4;
  const bf16_t* MS = (const bf16_t*)(P.ws + OFF_MS); const bf16_t* U5 = (const bf16_t*)(P.ws + OFF_U5);
  float* SC = P.out;
  const int nrep3a_ = (REP_PHASE == 30) ? P.p_hi - 7 : 1;
  for (int rep3a_ = 0; rep3a_ < nrep3a_; ++rep3a_)
  for (int id = blockIdx.x; id < 128; id += gridDim.x) {
    const int g = id >> 2, tn = id & 3;
    f32x4 acc[2][2][4][2];
    gemm256<false>(MS + (size_t)(g * 256) * 1024, 1024, U5 + (size_t)(g * 1024 + tn * 256) * 1280, 1280, 1024, lds, acc);
#pragma unroll
    for (int ai = 0; ai < 2; ++ai)
#pragma unroll
      for (int bj = 0; bj < 2; ++bj)
#pragma unroll
        for (int m = 0; m < 4; ++m)
#pragma unroll
          for (int n = 0; n < 2; ++n) {
            const int row0 = ai * 128 + wr * 64 + m * 16 + fq * 4, col = tn * 256 + bj * 128 + wc * 32 + n * 16 + fr;
            *(f32x4*)(SC + ((size_t)(g * 1024 + col) * 256 + row0)) = acc[ai][bj][m][n];
          }
  }
  const bf16_t* QKV = (const bf16_t*)(P.ws + OFF_QKVRAW);
  const int nbk = gridDim.x, vb = (blockIdx.x + nbk - (128 % nbk)) % nbk;
  const int nrep3b_ = (REP_PHASE == 31) ? P.p_hi - 7 : 1;
  for (int rep3b_ = 0; rep3b_ < nrep3b_; ++rep3b_)
  for (int it = vb * NWV + wid; it < 16 * 128 * 3; it += nbk * NWV) {
    const int part = it % 3, c = (it / 3) & 127, b = it / (3 * 128), h = lane >> 4;
    const int colq = part * 512 + lane * 8;
    float wt[5][8];
#pragma unroll
    for (int k = 0; k < 5; ++k) {
      const f32x4 wa = *(const f32x4*)(P.conv_w + k * 1536 + colq), wb = *(const f32x4*)(P.conv_w + k * 1536 + colq + 4);
#pragma unroll
      for (int e = 0; e < 4; ++e) { wt[k][e] = wa[e]; wt[k][4 + e] = wb[e]; }
    }
    bf16_t* dst = (bf16_t*)(P.ws + (part == 0 ? OFF_QN : part == 1 ? OFF_KN : OFF_VN)) + (size_t)(b * 4 + h) * SEQ * 128 + (lane & 15) * 8;
    const int l0 = c * 32;
#pragma unroll 1
    for (int i0 = 0; i0 < 32; i0 += 8) {
      u32x4 u[12];
#pragma unroll
      for (int k = 0; k < 12; ++k) {
        const int l = l0 + i0 - 2 + k;
        u[k] = (l >= 0 && l < SEQ) ? *(const u32x4*)(QKV + (size_t)(b * SEQ + l) * 1536 + colq) : u32x4{0u, 0u, 0u, 0u};
      }
#pragma unroll
      for (int i = 0; i < 8; ++i) {
        float y[8];
#pragma unroll
        for (int e = 0; e < 8; ++e) y[e] = 0.f;
#pragma unroll
        for (int k = 0; k < 5; ++k)
#pragma unroll
          for (int e = 0; e < 4; ++e) { y[2 * e] += wt[k][2 * e] * bflo(u[i + k][e]); y[2 * e + 1] += wt[k][2 * e + 1] * bfhi(u[i + k][e]); }
        float ss = 0.f;
#pragma unroll
        for (int e = 0; e < 8; ++e) { y[e] = siluf_(y[e]); ss += y[e] * y[e]; }
        if (part < 2) {
#pragma unroll
          for (int o = 1; o < 16; o <<= 1) ss += __shfl_xor(ss, o);
          float sc = rsqrtf(ss + 1e-6f); if (part == 0) sc *= 0.08838834764831845f;
#pragma unroll
          for (int e = 0; e < 8; ++e) y[e] *= sc;
        }
        *(u32x4*)(dst + (size_t)(l0 + i0 + i) * 128) = u32x4{pk2(y[0], y[1]), pk2(y[2], y[3]), pk2(y[4], y[5]), pk2(y[6], y[7])};
      }
    }
  }
  p3_mygen(P);
}

struct PrepIn { u32x4 k[4], q[4], v[4]; float be, al; };
DI void dn_prep_issue(const Params& P, PrepIn& I, int item, int tid) {
  const int cc = item & 63, hd = (item >> 6) & 7, b = item >> 9, dir = hd >> 2, h = hd & 3;
  const size_t base = (size_t)(b * 4 + h) * SEQ * 128;
  const bf16_t* Qn = (const bf16_t*)(P.ws + OFF_QN) + base; const bf16_t* Kn = (const bf16_t*)(P.ws + OFF_KN) + base; const bf16_t* Vn = (const bf16_t*)(P.ws + OFF_VN) + base;
#pragma unroll
  for (int k = 0; k < 4; ++k) {
    const int idx = tid + 256 * k, row = idx >> 4, ch = idx & 15, p = cc * 64 + row, l = dir ? (SEQ - 1 - p) : p;
    I.k[k] = *(const u32x4*)(Kn + (size_t)l * 128 + ch * 8); I.q[k] = *(const u32x4*)(Qn + (size_t)l * 128 + ch * 8); I.v[k] = *(const u32x4*)(Vn + (size_t)l * 128 + ch * 8);
  }
  if (tid < 64) {
    const float* BA = (const float*)(P.ws + OFF_BA);
    const int p = cc * 64 + tid, l = dir ? (SEQ - 1 - p) : p; const size_t t = (size_t)b * SEQ + l;
    I.be = BA[t * 16 + dir * 4 + h]; I.al = BA[t * 16 + 8 + dir * 4 + h];
  }
}
DI void dn_prep_loop(const Params& P, char* sm, int first, int stride, int tid) {
  const int lane = tid & 63, w = tid >> 6, r = lane & 31, hh = lane >> 5;
  bf16_t* sK = (bf16_t*)sm;
  bf16_t* sQ = sK + 64 * 132;
  bf16_t* sRv = sQ;
  bf16_t* sLm = sQ + 128 * 68;
  bf16_t* sTt = sLm + 64 * 68;
  bf16_t* sRk = sLm;
  bf16_t* sT = sTt + 64 * 68;
  float* sg = (float*)(sT + 64 * 68);
  float* sbeta = sg + 64;
  float* seg = sbeta + 64;
  bf16_t* sV = (bf16_t*)(seg + 64);
  float* GC = (float*)(P.ws + OFF_GC);
  PrepIn I;
  if (first < 8192) dn_prep_issue(P, I, first, tid);
  for (int item = first; item < 8192; item += stride) {
  const int cc = item & 63, hd = (item >> 6) & 7, dir = hd >> 2, h = hd & 3;
  lds_barrier();
#pragma unroll
  for (int k = 0; k < 4; ++k) {
    const int idx = tid + 256 * k, row = idx >> 4, ch = idx & 15;
    *(u32x2*)(sK + row * 132 + ch * 8) = u32x2{I.k[k][0], I.k[k][1]}; *(u32x2*)(sK + row * 132 + ch * 8 + 4) = u32x2{I.k[k][2], I.k[k][3]};
    *(u32x2*)(sQ + row * 132 + ch * 8) = u32x2{I.q[k][0], I.q[k][1]}; *(u32x2*)(sQ + row * 132 + ch * 8 + 4) = u32x2{I.q[k][2], I.q[k][3]};
    *(u32x2*)(sV + row * 132 + ch * 8) = u32x2{I.v[k][0], I.v[k][1]}; *(u32x2*)(sV + row * 132 + ch * 8 + 4) = u32x2{I.v[k][2], I.v[k][3]};
  }
  for (int e = tid; e < 64 * 68 / 2; e += 256) { ((unsigned*)sT)[e] = 0u; ((unsigned*)sTt)[e] = 0u; }
  if (tid < 64) {
    const float be = sigmoidf_(I.be);
    const float g = -expf(P.a_log[dir][h]) * softplusf_(I.al + P.dt_bias[dir][h]);
    float gc = g;
#pragma unroll
    for (int o = 1; o < 64; o <<= 1) { const float v = __shfl_up(gc, o); if (lane >= o) gc += v; }
    sg[tid] = gc; sbeta[tid] = be; seg[tid] = expf(gc); GC[(size_t)item * 64 + tid] = gc;
  }
  if (item + stride < 8192) dn_prep_issue(P, I, item + stride, tid);
  lds_barrier();
  {
    const int mi = w >> 1, ni = w & 1;
    f32x16 kk, qk;
#pragma unroll
    for (int i = 0; i < 16; ++i) { kk[i] = 0.f; qk[i] = 0.f; }
#pragma unroll
    for (int ks = 0; ks < 8; ++ks) {
      const bf16x8 bf = ldfrag(sK, 32 * ni + r, 132, 16 * ks + 4 * hh);
      const bf16x8 ak = ldfrag(sK, 32 * mi + r, 132, 16 * ks + 4 * hh);
      const bf16x8 aq = ldfrag(sQ, 32 * mi + r, 132, 16 * ks + 4 * hh);
      kk = MFMA32(ak, bf, kk); qk = MFMA32(aq, bf, qk);
    }
    lds_barrier();
    bf16_t* ATT = (bf16_t*)(P.ws + OFF_ATT) + (size_t)item * 4096;
    const int j = 32 * ni + r; const float gj = sg[j];
#pragma unroll
    for (int reg = 0; reg < 16; ++reg) {
      const int i = 32 * mi + crow(reg, hh);
      const float d = __expf(i >= j ? sg[i] - gj : 0.f);
      sLm[i * 68 + j] = f2bf((i > j) ? sbeta[i] * kk[reg] * d : 0.f);
      for (int rep = 0; rep <= DUPST; ++rep) { ATT[i * 64 + j] = f2bf((i >= j) ? qk[reg] * d : 0.f); asm volatile("" ::: "memory"); }
    }
  }
  lds_barrier();
  if (tid < 64) {
    const int blk = tid >> 4, c = tid & 15;
    float x[16];
#pragma unroll
    for (int i = 0; i < 16; ++i) {
      float a = (i == c) ? 1.f : 0.f;
      const bf16_t* lrow = sLm + (16 * blk + i) * 68 + 16 * blk;
#pragma unroll
      for (int j = 0; j < i; ++j) a -= bf2f(lrow[j]) * x[j];
      x[i] = a;
    }
#pragma unroll
    for (int i = 0; i < 16; ++i) { const bf16_t v = f2bf(x[i]); sT[(16 * blk + i) * 68 + 16 * blk + c] = v; sTt[(16 * blk + c) * 68 + 16 * blk + i] = v; }
  }
  lds_barrier();
  if (w < 2) {
    const int a = w;
    f32x16 X, Y;
#pragma unroll
    for (int i = 0; i < 16; ++i) { X[i] = 0.f; Y[i] = 0.f; }
    {
      bf16x8 A = ldfrag(sLm, 32 * a + r, 68, 32 * a + 4 * hh);
      if (r < 16) A = bf16x8{0, 0, 0, 0, 0, 0, 0, 0};
      X = MFMA32(A, ldfrag(sTt, 32 * a + r, 68, 32 * a + 4 * hh), X);
    }
#pragma unroll
    for (int s = 0; s < 2; ++s) Y = MFMA32(ldfrag(sT, 32 * a + r, 68, 32 * a + 16 * s + 4 * hh), pack8(X, s), Y);
    if (r < 16) {
#pragma unroll
      for (int reg = 8; reg < 16; ++reg) {
        const int i = crow(reg, hh); const bf16_t v = f2bf(-Y[reg]);
        sT[(32 * a + i) * 68 + 32 * a + r] = v; sTt[(32 * a + r) * 68 + 32 * a + i] = v;
      }
    }
  }
  lds_barrier();
  if (w == 0) {
    f32x16 X, Y;
#pragma unroll
    for (int i = 0; i < 16; ++i) { X[i] = 0.f; Y[i] = 0.f; }
#pragma unroll
    for (int s = 0; s < 2; ++s) X = MFMA32(ldfrag(sLm, 32 + r, 68, 16 * s + 4 * hh), ldfrag(sTt, r, 68, 16 * s + 4 * hh), X);
#pragma unroll
    for (int s = 0; s < 2; ++s) Y = MFMA32(ldfrag(sT, 32 + r, 68, 32 + 16 * s + 4 * hh), pack8(X, s), Y);
#pragma unroll
    for (int reg = 0; reg < 16; ++reg) sT[(32 + crow(reg, hh)) * 68 + r] = f2bf(-Y[reg]);
  }
  lds_barrier();
  {
    const int c = tid;
    if (c < 128) {
#pragma unroll 2
      for (int i0 = 0; i0 < 64; i0 += 16) {
        float x[16];
#pragma unroll
        for (int i = 0; i < 16; ++i) x[i] = bf2f(sV[(i0 + i) * 132 + c]) * sbeta[i0 + i];
#pragma unroll
        for (int i = 0; i < 16; i += 4) *(u32x2*)(sRv + c * 68 + i0 + i) = u32x2{pk2(x[i], x[i + 1]), pk2(x[i + 2], x[i + 3])};
      }
    } else {
      const int d = c - 128;
      bf16_t* Kt = (bf16_t*)(P.ws + OFF_KTT) + (size_t)item * 8192 + d * 64;
      const float gl = sg[63];
#pragma unroll 2
      for (int i = 0; i < 64; i += 8) {
        float y[8], kt[8];
#pragma unroll
        for (int e = 0; e < 8; ++e) {
          const float kv = bf2f(sK[(i + e) * 132 + d]), ge = seg[i + e];
          y[e] = kv * sbeta[i + e] * ge; kt[e] = kv * __expf(gl - sg[i + e]);
        }
        *(u32x2*)(sRk + d * 68 + i) = u32x2{pk2(y[0], y[1]), pk2(y[2], y[3])}; *(u32x2*)(sRk + d * 68 + i + 4) = u32x2{pk2(y[4], y[5]), pk2(y[6], y[7])};
        *(u32x4*)(Kt + i) = u32x4{pk2(kt[0], kt[1]), pk2(kt[2], kt[3]), pk2(kt[4], kt[5]), pk2(kt[6], kt[7])};
      }
    }
  }
  lds_barrier();
  {
    bf16_t* Ut = (bf16_t*)(P.ws + OFF_UT) + (size_t)item * 8192;
    bf16_t* Wc = (bf16_t*)(P.ws + OFF_WC) + (size_t)item * 8192;
#pragma unroll
    for (int mi = 0; mi < 2; ++mi) {
      f32x16 du, dw;
#pragma unroll
      for (int i = 0; i < 16; ++i) { du[i] = 0.f; dw[i] = 0.f; }
#pragma unroll
      for (int s = 0; s < 4; ++s) {
        if (mi == 0 && s >= 2) continue;
        const bf16x8 tf = ldfrag(sT, 32 * mi + r, 68, 16 * s + 4 * hh);
        du = MFMA32(tf, ldfrag(sRv, 32 * w + r, 68, 16 * s + 4 * hh), du);
        dw = MFMA32(ldfrag(sRk, 32 * w + r, 68, 16 * s + 4 * hh), tf, dw);
      }
#pragma unroll
      for (int g4 = 0; g4 < 4; ++g4) {
        for (int rep = 0; rep <= DUPST; ++rep) {
        *(u32x2*)(Ut + (32 * w + r) * 64 + 32 * mi + 8 * g4 + 4 * hh) = u32x2{pk2(du[4 * g4], du[4 * g4 + 1]), pk2(du[4 * g4 + 2], du[4 * g4 + 3])};
        *(u32x2*)(Wc + (32 * mi + r) * 128 + 32 * w + 8 * g4 + 4 * hh) = u32x2{pk2(dw[4 * g4], dw[4 * g4 + 1]), pk2(dw[4 * g4 + 2], dw[4 * g4 + 3])};
        asm volatile("" ::: "memory"); }
      }
    }
  }
  }
}
DI void phase4(const Params& P, char* smem) {
  const int tid = threadIdx.x;
  {
    const float* SC = P.out; bf16_t* U5 = (bf16_t*)(P.ws + OFF_U5); const f32x2* PW = (const f32x2*)(P.ws + OFF_PW);
    const int nrep0_ = (REP_PHASE == 40) ? P.p_hi - 7 : 1;
    for (int rep0_ = 0; rep0_ < nrep0_; ++rep0_)
    for (int it = blockIdx.x; it < 128; it += gridDim.x) {
      const int g = it >> 2, b = (it & 3) * 4 + (tid >> 7), dir = (tid >> 6) & 1, n = tid & 63;
      const f32x2 a = PW[((g * 2 + dir) * 65 + 64) * 64 + n];
      float xr = 0.f, xi = 0.f;
#pragma unroll 8
      for (int s = 0; s < 64; ++s) {
        const int c = dir ? 63 - s : s; const size_t nn = (size_t)g * 1024 + b * 64 + c;
        U5[nn * 1280 + 1024 + dir * 128 + n] = f2bf(xr); U5[nn * 1280 + 1024 + dir * 128 + 64 + n] = f2bf(xi);
        const float sr = SC[nn * 256 + dir * 128 + n], si = SC[nn * 256 + dir * 128 + 64 + n];
        const float nr = a[0] * xr - a[1] * xi + sr, ni = a[0] * xi + a[1] * xr + si;
        xr = nr; xi = ni;
      }
    }
  }
  const int hb = tid >> 8;
  dn_prep_loop(P, smem + hb * 78336, blockIdx.x * 2 + hb, (REP_PHASE == 41) ? gridDim.x * 2 / (P.p_hi - 7) : gridDim.x * 2, tid & 255);
}

constexpr int RB_BYTES = 60160;
struct DnLd { u64_t v[32]; float g; };
DI void dn_issue(const Params& P, DnLd& L, int seq, int cc, int lw, int lane) {
  const int b = seq >> 3, hd = seq & 7, dir = hd >> 2, h = hd & 3;
  const size_t item = (size_t)seq * 64 + cc;
  if (lw == 0) {
    const bf16_t* Wg = (const bf16_t*)(P.ws + OFF_WC) + item * 8192;
#pragma unroll
    for (int k = 0; k < 32; ++k) { const int idx = lane + 64 * k; L.v[k] = ld8_pinned(Wg + (idx >> 5) * 128 + (idx & 31) * 4); }
  } else if (lw == 1) {
    const bf16_t* Qn = (const bf16_t*)(P.ws + OFF_QN) + (size_t)(b * 4 + h) * SEQ * 128;
#pragma unroll
    for (int k = 0; k < 32; ++k) {
      const int idx = lane + 64 * k, row = idx >> 5, p = cc * 64 + row, l = dir ? (SEQ - 1 - p) : p;
      L.v[k] = ld8_pinned(Qn + (size_t)l * 128 + (idx & 31) * 4);
    }
  } else if (lw == 2) {
    const bf16_t* Kg = (const bf16_t*)(P.ws + OFF_KTT) + item * 8192;
#pragma unroll
    for (int k = 0; k < 32; ++k) { const int idx = lane + 64 * k; L.v[k] = ld8_pinned(Kg + (idx >> 4) * 64 + (idx & 15) * 4); }
  } else {
    const bf16_t* Ag = (const bf16_t*)(P.ws + OFF_ATT) + item * 4096;
#pragma unroll
    for (int k = 0; k < 16; ++k) { const int idx = lane + 64 * k; L.v[k] = ld8_pinned(Ag + (idx >> 4) * 64 + (idx & 15) * 4); }
    L.g = ld4_pinned((const float*)(P.ws + OFF_GC) + item * 64 + lane);
  }
}
DI void dn_commit(const DnLd& L, char* buf, int lw, int lane) {
  bf16_t* sW = (bf16_t*)buf; bf16_t* sQ = sW + 64 * 132; bf16_t* sA = sQ + 64 * 132; bf16_t* sKt = sA + 64 * 68;
  if (lw == 0) {
#pragma unroll
    for (int k = 0; k < 32; ++k) { const int idx = lane + 64 * k; *(u64_t*)(sW + (idx >> 5) * 132 + (idx & 31) * 4) = L.v[k]; }
  } else if (lw == 1) {
#pragma unroll
    for (int k = 0; k < 32; ++k) { const int idx = lane + 64 * k; *(u64_t*)(sQ + (idx >> 5) * 132 + (idx & 31) * 4) = L.v[k]; }
  } else if (lw == 2) {
#pragma unroll
    for (int k = 0; k < 32; ++k) { const int idx = lane + 64 * k; *(u64_t*)(sKt + (idx >> 4) * 68 + (idx & 15) * 4) = L.v[k]; }
  } else {
#pragma unroll
    for (int k = 0; k < 16; ++k) { const int idx = lane + 64 * k; *(u64_t*)(sA + (idx >> 4) * 68 + (idx & 15) * 4) = L.v[k]; }
    ((float*)(buf + 59904))[lane] = L.g;
  }
}
DI void dn_recur(const Params& P, char* smem, int seq) {
  const int tid = threadIdx.x, lane = tid & 63, w = __builtin_amdgcn_readfirstlane(tid >> 6), r = lane & 31, hh = lane >> 5;
  const int b = seq >> 3, hd = seq & 7, dir = hd >> 2, h = hd & 3;
  __syncthreads();
  if (w >= 4) {
    const int lw = w - 4;
    DnLd LA, LB;
    dn_issue(P, LA, seq, 0, lw, lane);
    dn_commit(LA, smem, lw, lane);
    dn_issue(P, LA, seq, 1, lw, lane);
    dn_issue(P, LB, seq, 2, lw, lane);
    lds_barrier();
    for (int cc = 0; cc < 64; cc += 2) {
      for (int rep = 0; rep <= DUPL; ++rep) { dn_commit(LA, smem + RB_BYTES, lw, lane); asm volatile("" ::: "memory"); }
      for (int rep = 0; rep <= DUPL; ++rep) { dn_issue(P, LA, seq, min(cc + 3, 63), lw, lane); asm volatile("" ::: "memory"); }
      lds_barrier();
      for (int rep = 0; rep <= DUPL; ++rep) { dn_commit(LB, smem, lw, lane); asm volatile("" ::: "memory"); }
      for (int rep = 0; rep <= DUPL; ++rep) { dn_issue(P, LB, seq, min(cc + 4, 63), lw, lane); asm volatile("" ::: "memory"); }
      lds_barrier();
    }
  } else {
    const int dv0 = 32 * w;
    const float* GC = (const float*)(P.ws + OFF_GC);
    bf16_t* O = (bf16_t*)P.out + (size_t)dir * NTOK * 512;
    f32x16 S[4];
#pragma unroll
    for (int t = 0; t < 4; ++t)
#pragma unroll
      for (int i = 0; i < 16; ++i) S[t][i] = 0.f;
    lds_barrier();
    for (int cc = 0; cc < 64; ++cc) {
      const size_t item = (size_t)seq * 64 + cc;
      const bf16_t* sW = (const bf16_t*)(smem + (cc & 1) * RB_BYTES); const bf16_t* sQ = sW + 64 * 132; const bf16_t* sA = sQ + 64 * 132; const bf16_t* sKt = sA + 64 * 68;
      const bf16_t* Ug = (const bf16_t*)(P.ws + OFF_UT) + item * 8192;
      f32x16 vn[2];
#pragma unroll
      for (int m = 0; m < 2; ++m)
#pragma unroll
        for (int g4 = 0; g4 < 4; ++g4) {
          const u32x2 u = *(const u32x2*)(Ug + (dv0 + r) * 64 + 32 * m + 8 * g4 + 4 * hh);
          vn[m][4 * g4 + 0] = bflo(u[0]); vn[m][4 * g4 + 1] = bfhi(u[0]); vn[m][4 * g4 + 2] = bflo(u[1]); vn[m][4 * g4 + 3] = bfhi(u[1]);
        }
      const float* sG = (const float*)(smem + (cc & 1) * RB_BYTES + 59904);
      const float egl = __expf(sG[63]);
      f32x16 aW[2], aQ[2];
#pragma unroll
      for (int m = 0; m < 2; ++m)
#pragma unroll
        for (int i = 0; i < 16; ++i) { aW[m][i] = 0.f; aQ[m][i] = 0.f; }
      bf16x8 fa[2][4];
      fa[0][0] = ldfrag(sW, r, 132, 4 * hh); fa[0][1] = ldfrag(sW, 32 + r, 132, 4 * hh);
      fa[0][2] = ldfrag(sQ, r, 132, 4 * hh); fa[0][3] = ldfrag(sQ, 32 + r, 132, 4 * hh);
#pragma unroll
      for (int ks = 0; ks < 8; ++ks) {
        const int cur = ks & 1, nxt = cur ^ 1;
        if (ks + 1 < 8) {
          fa[nxt][0] = ldfrag(sW, r, 132, 16 * (ks + 1) + 4 * hh); fa[nxt][1] = ldfrag(sW, 32 + r, 132, 16 * (ks + 1) + 4 * hh);
          fa[nxt][2] = ldfrag(sQ, r, 132, 16 * (ks + 1) + 4 * hh); fa[nxt][3] = ldfrag(sQ, 32 + r, 132, 16 * (ks + 1) + 4 * hh);
        }
        const bf16x8 sf = pack8(S[ks >> 1], ks & 1);
        aW[0] = MFMA32(fa[cur][0], sf, aW[0]); aW[1] = MFMA32(fa[cur][1], sf, aW[1]);
        aQ[0] = MFMA32(fa[cur][2], sf, aQ[0]); aQ[1] = MFMA32(fa[cur][3], sf, aQ[1]);
      }
      bf16x8 fA[4];
#pragma unroll
      for (int ks = 0; ks < 4; ++ks) fA[ks] = ldfrag(sA, r, 68, 16 * ks + 4 * hh);
#pragma unroll
      for (int m = 0; m < 2; ++m)
#pragma unroll
        for (int i = 0; i < 16; ++i) aQ[m][i] *= __expf(sG[32 * m + crow(i, hh)]);
#pragma unroll
      for (int m = 0; m < 2; ++m)
#pragma unroll
        for (int i = 0; i < 16; ++i) vn[m][i] -= aW[m][i];
      bf16x8 vf[4];
      vf[0] = pack8(vn[0], 0); vf[1] = pack8(vn[0], 1); vf[2] = pack8(vn[1], 0); vf[3] = pack8(vn[1], 1);
      bf16x8 fk[2][4];
#pragma unroll
      for (int ks = 0; ks < 4; ++ks) aQ[0] = MFMA32(fA[ks], vf[ks], aQ[0]);
#pragma unroll
      for (int ks = 0; ks < 4; ++ks) fA[ks] = ldfrag(sA, 32 + r, 68, 16 * ks + 4 * hh);
#pragma unroll
      for (int ks = 0; ks < 4; ++ks) fk[0][ks] = ldfrag(sKt, r, 68, 16 * ks + 4 * hh);
#pragma unroll
      for (int ks = 0; ks < 4; ++ks) aQ[1] = MFMA32(fA[ks], vf[ks], aQ[1]);
#pragma unroll
      for (int t = 0; t < 4; ++t) {
        const int cur = t & 1, nxt = cur ^ 1;
        if (t + 1 < 4) {
#pragma unroll
          for (int ks = 0; ks < 4; ++ks) fk[nxt][ks] = ldfrag(sKt, 32 * (t + 1) + r, 68, 16 * ks + 4 * hh);
        }
#pragma unroll
        for (int i = 0; i < 16; ++i) S[t][i] *= egl;
#pragma unroll
        for (int ks = 0; ks < 4; ++ks) S[t] = MFMA32(fk[cur][ks], vf[ks], S[t]);
      }
      {
        bf16_t* Ob = O + (size_t)b * SEQ * 512 + h * 128 + dv0 + r;
#pragma unroll
        for (int m = 0; m < 2; ++m)
#pragma unroll
          for (int i = 0; i < 16; ++i) {
            const int p = cc * 64 + 32 * m + crow(i, hh), l = dir ? (SEQ - 1 - p) : p;
            Ob[(size_t)l * 512] = f2bf(aQ[m][i]);
          }
      }
      lds_barrier();
    }
  }
}

DI void phase6(const Params& P, LAS unsigned char* lds, int ctr_off) {
  const int tid = threadIdx.x, lane = tid & 63, wid = tid >> 6, wr = wid >> 2, wc = wid & 3, fr = lane & 15, fq = lane >> 4;
  const bf16_t* MY = (const bf16_t*)(P.ws + OFF_MY); const bf16_t* U5 = (const bf16_t*)(P.ws + OFF_U5);
  bf16_t* Y5 = (bf16_t*)(P.ws + OFF_Y5);
  unsigned* ctr = (unsigned*)(P.ws + OFF_CTR) + ctr_off;
  LAS unsigned* sid = (LAS unsigned*)(lds + 131072);
  const int q0 = blockIdx.x & 7, pref = (blockIdx.x < 128 && gridDim.x > 128) ? 1 : 0;
  int step = 0;
  for (;;) {
    const int q = (q0 + (step >> 1)) & 7, part = pref ^ (step & 1), lim = part ? 16 : 48;
    __syncthreads();
    if (tid == 0) *sid = atomicAdd(ctr + part * 8 + q, 1u);
    __syncthreads();
    const int got = (int)*sid;
    if (got >= lim) { if (++step >= 16) break; continue; }
    const int idl = part ? 48 + got : got;
    const int g = q + 8 * (idl >> 4), tn = (idl >> 2) & 3, tm = idl & 3;
    f32x4 acc[2][2][4][2];
    gemm256<false>(MY + (size_t)(g * 1024 + tm * 256) * 1280, 1280, U5 + (size_t)(g * 1024 + tn * 256) * 1280, 1280, 1280, lds, acc);
#pragma unroll
    for (int ai = 0; ai < 2; ++ai)
#pragma unroll
      for (int bj = 0; bj < 2; ++bj)
#pragma unroll
        for (int m = 0; m < 4; ++m)
#pragma unroll
          for (int n = 0; n < 2; ++n) {
            const int row0 = tm * 256 + ai * 128 + wr * 64 + m * 16 + fq * 4, col = tn * 256 + bj * 128 + wc * 32 + n * 16 + fr;
            const int t = row0 >> 4, p = row0 & 15; const size_t tok = (size_t)col * 64 + t;
            const f32x4 v = acc[ai][bj][m][n];
            const u32x2 o = {pk2(gelu_tanh(v[0]), gelu_tanh(v[1])), pk2(gelu_tanh(v[2]), gelu_tanh(v[3]))};
            *(u32x2*)(Y5 + tok * 512 + g * 16 + p) = o;
          }
  }
}

DI void phase7(const Params& P, LAS unsigned char* lds) {
  const int tid = threadIdx.x, lane = tid & 63, wid = tid >> 6, wr = wid >> 2, wc = wid & 3, fr = lane & 15, fq = lane >> 4;
  const bf16_t* Y5 = (const bf16_t*)(P.ws + OFF_Y5); const bf16_t* GW = (const bf16_t*)(P.ws + OFF_GLUWT);
  const bf16_t* ZA = (const bf16_t*)(P.ws + OFF_ZA); const bf16_t* ZB = (const bf16_t*)(P.ws + OFF_ZB);
  bf16_t* YAB = (bf16_t*)(P.ws + OFF_YAB);
#pragma unroll 1
  for (int pass = 0; pass < 2; ++pass) {
  const bool gemm_now = (pass == 0) != (((blockIdx.x >> 3) & 1) != 0);
  if (gemm_now) {
  {
    const int bid = blockIdx.x, nbk = gridDim.x, nj = bid < 1024 ? (1024 - bid + nbk - 1) / nbk : 0;
    auto tile_of = [&](int j, int& tm, int& tn) { const int id = bid + j * nbk, grp = id >> 5, ig = id & 31; tm = grp * 8 + (ig & 7); tn = ig >> 3; };
    gemm256_stream<true, true>(nj, 8, 512, 512,
      [&](int j, const bf16_t*& A, const bf16_t*& Bt) { int tm, tn; tile_of(j, tm, tn); A = Y5 + (size_t)tm * 256 * 512; Bt = GW + (size_t)tn * 256 * 512; },
      [&](int j, f32x4 (&acc)[2][2][4][2]) {
        int tm, tn; tile_of(j, tm, tn);
        const int jc = tn * 128 + wc * 32 + fq * 8;
        f32x4 bv[2], bg[2];
#pragma unroll
        for (int n = 0; n < 2; ++n) { bv[n] = *(const f32x4*)(P.glu_b + jc + 4 * n); bg[n] = *(const f32x4*)(P.glu_b + 512 + jc + 4 * n); }
#pragma unroll
        for (int ai = 0; ai < 2; ++ai)
#pragma unroll
          for (int m = 0; m < 4; ++m) {
            const size_t t = (size_t)tm * 256 + ai * 128 + wr * 64 + m * 16 + fr;
            const u32x4 z = *(const u32x4*)(ZA + t * 512 + jc);
            float y[8];
#pragma unroll
            for (int n = 0; n < 2; ++n)
#pragma unroll
              for (int e = 0; e < 4; ++e) {
                const unsigned zz = z[2 * n + (e >> 1)]; const float zf = (e & 1) ? bfhi(zz) : bflo(zz);
                y[4 * n + e] = (acc[ai][0][m][n][e] + bv[n][e]) * sigmoidf_(acc[ai][1][m][n][e] + bg[n][e]) * siluf_(zf);
              }
            *(u32x4*)(YAB + t * 1024 + jc) = u32x4{pk2(y[0], y[1]), pk2(y[2], y[3]), pk2(y[4], y[5]), pk2(y[6], y[7])};
          }
      }, lds);
  }
  } else {
  const bf16_t* Of = (const bf16_t*)P.out; const bf16_t* Ob = Of + (size_t)NTOK * 512;
  float nw[8];
#pragma unroll
  for (int e = 0; e < 8; ++e) nw[e] = P.dn_norm_w[(lane & 15) * 8 + e];
  for (int t0 = (blockIdx.x * NWV + wid) * 4; t0 < NTOK; t0 += gridDim.x * NWV * 4) {
    u32x4 a[4], bq[4], z[4];
#pragma unroll
    for (int u = 0; u < 4; ++u) {
      const size_t off = (size_t)(t0 + u) * 512 + lane * 8;
      a[u] = *(const u32x4*)(Of + off); bq[u] = *(const u32x4*)(Ob + off); z[u] = *(const u32x4*)(ZB + off);
    }
#pragma unroll
    for (int u = 0; u < 4; ++u) {
      float o[8]; float ss = 0.f;
#pragma unroll
      for (int e = 0; e < 4; ++e) { o[2 * e] = bflo(a[u][e]) + bflo(bq[u][e]); o[2 * e + 1] = bfhi(a[u][e]) + bfhi(bq[u][e]); }
#pragma unroll
      for (int e = 0; e < 8; ++e) ss += o[e] * o[e];
#pragma unroll
      for (int sft = 1; sft < 16; sft <<= 1) ss += __shfl_xor(ss, sft);
      const float rs = rsqrtf(ss * (1.f / 128.f) + 1e-6f);
      float y[8];
#pragma unroll
      for (int e = 0; e < 4; ++e) { y[2 * e] = o[2 * e] * rs * nw[2 * e] * siluf_(bflo(z[u][e])); y[2 * e + 1] = o[2 * e + 1] * rs * nw[2 * e + 1] * siluf_(bfhi(z[u][e])); }
      *(u32x4*)(YAB + (size_t)(t0 + u) * 1024 + 512 + lane * 8) = u32x4{pk2(y[0], y[1]), pk2(y[2], y[3]), pk2(y[4], y[5]), pk2(y[6], y[7])};
    }
  }
  }
  }
}

DI void phase8_norm(const Params& P, const float* sss, int tm) {
  const int tid = threadIdx.x, lane = tid & 63, wid = tid >> 6;
  __syncthreads();
  for (int rr = 0; rr < 32; rr += 4) {
    f32x4 v[4][4];
#pragma unroll
    for (int u = 0; u < 4; ++u) {
      const f32x4* xr = (const f32x4*)(P.out + ((size_t)tm * 256 + wid * 32 + rr + u) * DM) + lane;
#pragma unroll
      for (int j = 0; j < 4; ++j) v[u][j] = xr[64 * j];
    }
#pragma unroll
    for (int u = 0; u < 4; ++u) {
      const int row = wid * 32 + rr + u;
      const f32x4 p4 = *(const f32x4*)(sss + row * 4);
      const float rstd = rsqrtf((p4[0] + p4[1] + p4[2] + p4[3]) * (1.f / DM) + 1e-6f);
      f32x4* xr = (f32x4*)(P.out + ((size_t)tm * 256 + row) * DM) + lane;
#pragma unroll
      for (int j = 0; j < 4; ++j) {
        const f32x4 fw = *(const f32x4*)(P.final_norm_w + lane * 4 + 256 * j);
        f32x4 o;
#pragma unroll
        for (int e = 0; e < 4; ++e) o[e] = v[u][j][e] * rstd * fw[e];
        xr[64 * j] = o;
      }
    }
  }
  __syncthreads();
}
DI void phase8(const Params& P, LAS unsigned char* lds) {
  const int tid = threadIdx.x, lane = tid & 63, wid = tid >> 6, wr = wid >> 2, wc = wid & 3, fr = lane & 15, fq = lane >> 4;
  const bf16_t* YAB = (const bf16_t*)(P.ws + OFF_YAB); const bf16_t* W = (const bf16_t*)(P.ws + OFF_WOUTT);
  const float* mod = (const float*)(P.ws + OFF_MOD);
  float* sss = (float*)((char*)lds + 131072 + 64);
  for (int id = blockIdx.x * 4; id < 1024; id = ((id & 3) == 3) ? id - 3 + gridDim.x * 4 : id + 1) {
    const int tm = id >> 2, tn = id & 3;
    if (tn == 0) { for (int e = tid; e < 1024; e += NTHR) sss[e] = 0.f; }
    {
      f32x4 acc[2][2][4][2];
      gemm256<true, true>(YAB + (size_t)tm * 256 * 1024, 1024, W + (size_t)tn * 256 * 1024, 1024, 1024, lds, acc);
      f32x4 gvv[2][2];
#pragma unroll
      for (int bj = 0; bj < 2; ++bj)
#pragma unroll
        for (int n = 0; n < 2; ++n) gvv[bj][n] = *(const f32x4*)(mod + ((tm * 256) >> 12) * 3072 + 2048 + tn * 256 + bj * 128 + wc * 32 + fq * 8 + 4 * n);
#pragma unroll
      for (int ai = 0; ai < 2; ++ai)
#pragma unroll
        for (int m = 0; m < 4; ++m) {
          const size_t t = (size_t)tm * 256 + ai * 128 + wr * 64 + m * 16 + fr;
          float ssv = 0.f;
#pragma unroll
          for (int bj = 0; bj < 2; ++bj)
#pragma unroll
            for (int n = 0; n < 2; ++n) {
              const int col = tn * 256 + bj * 128 + wc * 32 + fq * 8 + 4 * n;
              const f32x4 xv = *(const f32x4*)(P.x + t * DM + col), gv = gvv[bj][n];
              f32x4 o;
#pragma unroll
              for (int e = 0; e < 4; ++e) { o[e] = xv[e] + gv[e] * acc[ai][bj][m][n][e]; ssv += o[e] * o[e]; }
              *(f32x4*)(P.out + t * DM + col) = o;
            }
          ssv += __shfl_xor(ssv, 16); ssv += __shfl_xor(ssv, 32);
          if (fq == 0) sss[(ai * 128 + wr * 64 + m * 16 + fr) * 4 + wc] += ssv;
        }
    }
    if (tn == 3) phase8_norm(P, sss, tm);
  }
}
DI void phase9(const Params& P) {
  const int tid = threadIdx.x, lane = tid & 63, wid = tid >> 6;
  for (int row0 = (blockIdx.x * NWV + wid) * 4; row0 < NTOK; row0 += gridDim.x * NWV * 4) {
    f32x4 v[4][4];
#pragma unroll
    for (int u = 0; u < 4; ++u) {
      const f32x4* xr = (const f32x4*)(P.out + (size_t)(row0 + u) * DM) + lane;
#pragma unroll
      for (int j = 0; j < 4; ++j) v[u][j] = xr[64 * j];
    }
#pragma unroll
    for (int u = 0; u < 4; ++u) {
      f32x4* xr = (f32x4*)(P.out + (size_t)(row0 + u) * DM) + lane;
      float s = 0.f;
#pragma unroll
      for (int j = 0; j < 4; ++j) s += v[u][j][0] * v[u][j][0] + v[u][j][1] * v[u][j][1] + v[u][j][2] * v[u][j][2] + v[u][j][3] * v[u][j][3];
      const float rstd = rsqrtf(wave_sum(s) * (1.f / DM) + 1e-6f);
#pragma unroll
      for (int j = 0; j < 4; ++j) {
        const f32x4 fw = *(const f32x4*)(P.final_norm_w + lane * 4 + 256 * j);
        f32x4 o;
#pragma unroll
        for (int e = 0; e < 4; ++e) o[e] = v[u][j][e] * rstd * fw[e];
        xr[64 * j] = o;
      }
    }
  }
}

#ifndef SPLIT56
#define SPLIT56 0
#endif
DI void phase5(const Params& P, char* smem, LAS unsigned char* lds) {
  for (int seq = blockIdx.x; seq < 128; seq += gridDim.x) dn_recur(P, smem, seq);
  if (!SPLIT56) phase6(P, lds, 0);
}
constexpr int LDS_BYTES = 160 * 1024;
__global__ void __launch_bounds__(NTHR) hybrid_fwd(Params P) {
  extern __shared__ __attribute__((aligned(16))) unsigned char lds_raw[];
  LAS unsigned char* lds = (LAS unsigned char*)lds_raw;
  char* smem = (char*)lds_raw;
  cg::grid_group grid = cg::this_grid();
#define SEAM(p) if (P.p_lo < (p) && P.p_hi >= (p)) grid.sync()
#ifndef PH_MASK
#define PH_MASK 0x3ff
#endif
#define RUN(p, call) if (((PH_MASK >> (p)) & 1) && P.p_lo <= (p) && P.p_hi >= (p)) { const int nrep_ = (REP_PHASE == (p)) ? P.p_hi - 7 : 1; for (int rep_ = 0; rep_ < nrep_; ++rep_) { if (rep_) grid.sync(); call; } }
  RUN(0, phase0(P, smem));
  SEAM(1);
  RUN(1, phase1(P, smem));
  SEAM(2);
  RUN(2, phase2(P, lds));
  SEAM(3);
  RUN(3, phase3(P, lds));
  SEAM(4);
  RUN(4, phase4(P, smem));
  SEAM(5);
  RUN(5, phase5(P, smem, lds));
  if (SPLIT56) { SEAM(6); RUN(6, phase6(P, lds, 0)); }
  SEAM(7);
  RUN(7, phase7(P, lds));
  SEAM(8);
  RUN(8, phase8(P, lds));
}

extern "C" void kernel_launch(void* const* d_in, const int* in_sizes, int n_in, void* d_out, int out_size, void* d_ws, size_t ws_size, hipStream_t stream) {
  static int grid_blocks = 0;
  if (!grid_blocks) {
    int dev = 0, cus = 0, per_cu = 0;
    (void)hipGetDevice(&dev);
    (void)hipDeviceGetAttribute(&cus, hipDeviceAttributeMultiprocessorCount, dev);
    (void)hipFuncSetAttribute((const void*)hybrid_fwd, hipFuncAttributeMaxDynamicSharedMemorySize, LDS_BYTES);
    (void)hipOccupancyMaxActiveBlocksPerMultiprocessor(&per_cu, (const void*)hybrid_fwd, NTHR, LDS_BYTES);
    if (per_cu < 1) per_cu = 1;
    if (per_cu > 1) per_cu = 1;
    grid_blocks = cus * per_cu;
    if (ws_size < WS_END) fprintf(stderr, "workspace too small: %zu < %zu\n", ws_size, (size_t)WS_END);
  }
  Params p{};
  const float* const* in = (const float* const*)d_in;
  p.x = in[0]; p.c = in[1]; p.ada_w = in[2]; p.ada_b = in[3]; p.norm_w = in[4]; p.w_in = in[5]; p.conv_w = in[6];
  p.a_log[0] = in[7]; p.dt_bias[0] = in[8]; p.a_log[1] = in[9]; p.dt_bias[1] = in[10]; p.dn_norm_w = in[11];
  for (int d = 0; d < 2; ++d) {
    const int o = 12 + 7 * d;
    p.lam_re[d] = in[o]; p.lam_im[d] = in[o + 1]; p.log_step[d] = in[o + 2]; p.b_re[d] = in[o + 3]; p.b_im[d] = in[o + 4]; p.c_re[d] = in[o + 5]; p.c_im[d] = in[o + 6];
  }
  p.s5_d = in[26]; p.glu_w = in[27]; p.glu_b = in[28]; p.w_out = in[29]; p.final_norm_w = in[30];
  p.out = (float*)d_out; p.ws = (char*)d_ws;
#if N_LAUNCH_MODE == 1
  for (int ph = 0; ph <= 9; ++ph) {
    p.p_lo = ph; p.p_hi = ph;
    hipLaunchKernelGGL(hybrid_fwd, dim3(grid_blocks), dim3(NTHR), LDS_BYTES, stream, p);
  }
#else
  p.p_lo = 0; p.p_hi = 9;
  void* args[] = {&p};
  hipError_t e = hipLaunchCooperativeKernel((const void*)hybrid_fwd, dim3(grid_blocks), dim3(NTHR), args, LDS_BYTES, stream);
  if (e != hipSuccess) fprintf(stderr, "cooperative launch failed: %s (grid %d)\n", hipGetErrorString(e), grid_blocks);
#endif
}
```
